# Optimizing an MI355X kernel written in HIP

```python
import jax, jax.numpy as jnp
from jax import lax
import numpy as np

D_MODEL = 2048
BATCH = 16
SEQ = 256
DEPTH = 2
DEC_BATCH = 4
DEC_SEQ = 2048
PAST_LEN = 512

GRID_W = 64
HEAD_DIM = 64
GROUP_W = D_MODEL // 4
NA_HEADS = GROUP_W // HEAD_DIM
NA_KH = 8
NA_KW = 16
NA_QCOLS = 16
NA_KCOLS = NA_QCOLS + NA_KW
MLA_HEADS = 4
MLA_NOPE = 128
MLA_ROPE = 64
MLA_V = GROUP_W // MLA_HEADS
MLA_Q_LORA = 384
MLA_KV_LORA = 128
WIN_HEADS = GROUP_W // HEAD_DIM
WIN_KV_HEADS = 2
WIN_GROUPS = WIN_HEADS // WIN_KV_HEADS
WINDOW = 128
FN_GROUPS = 4
FN_CH = GROUP_W // FN_GROUPS
D_FF = 5632
MOD_CHUNKS = 6
Q_BLOCK = 128
ROPE_BASE = 10000.0
EPS = 1e-6
IN_COLS = 3 * GROUP_W + MLA_Q_LORA + MLA_KV_LORA + MLA_ROPE + WIN_HEADS * HEAD_DIM + 2 * WIN_KV_HEADS * HEAD_DIM + GROUP_W

kernel_name = 'hybrid_diffusion_prefix_trunk_step'

F32 = jnp.float32


def rms_norm(x, g):
    xf = x.astype(F32)
    y = xf * lax.rsqrt(jnp.mean(xf * xf, axis=-1, keepdims=True) + EPS)
    return (y * g.astype(F32)).astype(x.dtype)


def axial_rope(x, row, col):
    d = x.shape[-1]
    half = d // 2
    quarter = half // 2
    inv = ROPE_BASE ** (-jnp.arange(quarter, dtype=F32) / quarter)
    lead = (1, x.shape[1]) + (1,) * (x.ndim - 3)

    def rot(xh, pos):
        ang = (pos.astype(F32)[:, None] * inv[None, :]).reshape(lead + (quarter,))
        c, s = jnp.cos(ang), jnp.sin(ang)
        x1, x2 = xh[..., :quarter], xh[..., quarter:]
        return jnp.concatenate([x1 * c - x2 * s, x1 * s + x2 * c], -1)

    xf = x.astype(F32)
    return jnp.concatenate([rot(xf[..., :half], row), rot(xf[..., half:], col)], -1).astype(x.dtype)


def rope_tail(t, row, col):
    return jnp.concatenate([t[..., :MLA_NOPE], axial_rope(t[..., MLA_NOPE:], row, col)], -1)


def block_attention(q, k, v, sink=None):
    B, Sq, Hk, G, dk = q.shape
    nb = Sq // Q_BLOCK
    scale = dk ** -0.5
    qb = jnp.moveaxis(q.reshape(B, nb, Q_BLOCK, Hk, G, dk), 1, 0)

    def one(qi):
        s = jnp.einsum('bqhgd,bkhd->bhgqk', qi, k).astype(F32) * scale
        if sink is not None:
            s = jnp.concatenate([s, jnp.broadcast_to(sink.astype(F32)[None, :, :, None, None], s.shape[:-1] + (1,))], -1)
        p = jax.nn.softmax(s, axis=-1)
        if sink is not None:
            p = p[..., :-1]
        return jnp.einsum('bhgqk,bkhd->bqhgd', p.astype(v.dtype), v)

    o = lax.map(one, qb)
    return jnp.moveaxis(o, 0, 1).reshape(B, Sq, Hk, G, v.shape[-1])


def neighborhood_attention(q, k, v, k_ctx, v_ctx, rpb):
    B, S, H, d = q.shape
    rows = S // GRID_W
    kh = min(NA_KH, rows)
    ncb = GRID_W // NA_QCOLS
    r = jnp.arange(rows)
    ridx = jnp.clip(r - kh // 2, 0, rows - kh)[:, None] + jnp.arange(kh)[None, :]
    qcol = jnp.arange(ncb)[:, None] * NA_QCOLS + jnp.arange(NA_QCOLS)[None, :]
    cidx = jnp.clip(jnp.arange(ncb) * NA_QCOLS - NA_KW // 2, 0, GRID_W - NA_KCOLS)[:, None] + jnp.arange(NA_KCOLS)[None, :]
    cs = jnp.clip(qcol - NA_KW // 2, 0, GRID_W - NA_KW)
    kcol = cidx[:, None, :]
    col_ok = (kcol >= cs[..., None]) & (kcol < cs[..., None] + NA_KW)
    dc = jnp.clip(kcol - qcol[..., None], 1 - NA_KW, NA_KW - 1) + NA_KW - 1
    dr = ridx - r[:, None] + NA_KH - 1
    bias = rpb[:, dr[:, None, None, :, None], dc[None, :, :, None, :]].astype(F32)

    def gather(t):
        return t.reshape(B, rows, GRID_W, H, d)[:, ridx[:, None, :, None], cidx[None, :, None, :]]

    kg, vg = gather(k), gather(v)
    qb = q.reshape(B, rows, ncb, NA_QCOLS, H, d)
    scale = d ** -0.5
    s_loc = jnp.einsum('brjqhd,brjakhd->bhrjqak', qb, kg).astype(F32) * scale + bias[None]
    n_loc = kh * NA_KCOLS
    s_loc = jnp.where(col_ok[:, :, None, :], s_loc, -jnp.inf).reshape(B, H, rows, ncb, NA_QCOLS, n_loc)
    s_ctx = jnp.einsum('brjqhd,blhd->bhrjql', qb, k_ctx).astype(F32) * scale
    p = jax.nn.softmax(jnp.concatenate([s_loc, s_ctx], -1), axis=-1).astype(v.dtype)
    o = (jnp.einsum('bhrjqn,brjnhd->brjqhd', p[..., :n_loc], vg.reshape(B, rows, ncb, n_loc, H, d))
         + jnp.einsum('bhrjql,blhd->brjqhd', p[..., n_loc:], v_ctx))
    return o.reshape(B, S, H, d)


def window_attention(q, k, v, k_ctx, v_ctx, sink):
    B, S, Hk, G, d = q.shape
    nb = S // WINDOW

    def band(t):
        tb = jnp.pad(t, ((0, 0), (WINDOW, WINDOW), (0, 0), (0, 0))).reshape(B, nb + 2, WINDOW, Hk, d)
        return jnp.concatenate([tb[:, :-2], tb[:, 1:-1], tb[:, 2:]], axis=2)

    kb, vb = band(k), band(v)
    qb = q.reshape(B, nb, WINDOW, Hk, G, d)
    scale = d ** -0.5
    qpos = jnp.arange(nb)[:, None, None] * WINDOW + jnp.arange(WINDOW)[None, :, None]
    kpos = jnp.arange(nb)[:, None, None] * WINDOW - WINDOW + jnp.arange(3 * WINDOW)[None, None, :]
    ok = (jnp.abs(kpos - qpos) <= WINDOW) & (kpos >= 0) & (kpos < S)
    s_loc = jnp.where(ok, jnp.einsum('bnqhgd,bnkhd->bhgnqk', qb, kb).astype(F32) * scale, -jnp.inf)
    s_ctx = jnp.einsum('bnqhgd,blhd->bhgnql', qb, k_ctx).astype(F32) * scale
    s_sink = jnp.broadcast_to(sink.astype(F32)[None, :, :, None, None, None], s_ctx.shape[:-1] + (1,))
    p = jax.nn.softmax(jnp.concatenate([s_loc, s_ctx, s_sink], -1), axis=-1).astype(v.dtype)
    nl = 3 * WINDOW
    lc = k_ctx.shape[1]
    o = (jnp.einsum('bhgnqk,bnkhd->bnqhgd', p[..., :nl], vb)
         + jnp.einsum('bhgnql,blhd->bnqhgd', p[..., nl:nl + lc], v_ctx))
    return o.reshape(B, S, Hk, G, d)


def fourier_mix(t):
    B, S, _ = t.shape
    tf = t.astype(F32).reshape(B, S, FN_GROUPS, FN_CH)
    y = jnp.fft.fft2(tf, axes=(1, 3), norm='ortho').real
    return y.reshape(B, S, GROUP_W).astype(t.dtype)


def conv_ffn(h, p):
    g = h @ p['w_gate']
    gp = jnp.pad(g, ((0, 0), (1, 1), (0, 0)))
    wc = p['w_conv']
    g = gp[:, :-2] * wc[0] + gp[:, 1:-1] * wc[1] + gp[:, 2:] * wc[2]
    return (jax.nn.silu(g) * (h @ p['w_up'])) @ p['w_down']


def mixer_heads(h, p):
    B, S, _ = h.shape
    sizes = (GROUP_W, GROUP_W, GROUP_W, MLA_Q_LORA, MLA_KV_LORA + MLA_ROPE,
             WIN_HEADS * HEAD_DIM, WIN_KV_HEADS * HEAD_DIM, WIN_KV_HEADS * HEAD_DIM, GROUP_W)
    idx = np.cumsum(sizes)[:-1].tolist()
    a_q, a_k, a_v, m_q, m_kv, c_q, c_k, c_v, f_v = jnp.split(h @ p['w_in'], idx, axis=-1)
    cq = rms_norm(m_q, p['g_q_lora'])
    return dict(
        q_na=rms_norm(a_q.reshape(B, S, NA_HEADS, HEAD_DIM), p['g_qn_na']),
        k_na=rms_norm(a_k.reshape(B, S, NA_HEADS, HEAD_DIM), p['g_kn_na']),
        v_na=a_v.reshape(B, S, NA_HEADS, HEAD_DIM),
        q_mla=rms_norm((cq @ p['w_q_up']).reshape(B, S, MLA_HEADS, MLA_NOPE + MLA_ROPE), p['g_qn_mla']),
        ckv=rms_norm(m_kv[..., :MLA_KV_LORA], p['g_kv_lora']),
        krope=m_kv[..., MLA_KV_LORA:],
        q_win=rms_norm(c_q.reshape(B, S, WIN_KV_HEADS, WIN_GROUPS, HEAD_DIM), p['g_qn_win']),
        k_win=rms_norm(c_k.reshape(B, S, WIN_KV_HEADS, HEAD_DIM), p['g_kn_win']),
        v_win=c_v.reshape(B, S, WIN_KV_HEADS, HEAD_DIM),
        v_fn=f_v,
    )


def mla_kv(ckv, krope, p):
    B, L, _ = ckv.shape
    kv = (ckv @ p['w_kv_up']).reshape(B, L, MLA_HEADS, MLA_NOPE + MLA_V)
    k = jnp.concatenate([kv[..., :MLA_NOPE], jnp.broadcast_to(krope[:, :, None, :], (B, L, MLA_HEADS, MLA_ROPE))], -1)
    return rms_norm(k, p['g_kn_mla']), kv[..., MLA_NOPE:]


def modulate(x, g, shift, scale):
    return rms_norm(x, g) * (1 + scale) + shift


def context_layer(x, c_ctx, p):
    B, L, _ = x.shape
    mod = jax.nn.silu(c_ctx) @ p['w_mod'] + p['b_mod']
    sh1, sc1, gt1, sh2, sc2, gt2 = jnp.split(mod, MOD_CHUNKS, axis=-1)
    hd = mixer_heads(modulate(x, p['g_mix'], sh1, sc1), p)
    k_m, v_m = mla_kv(hd['ckv'], hd['krope'], p)
    o_a = block_attention(hd['q_na'][:, :, :, None], hd['k_na'], hd['v_na'])
    o_b = block_attention(hd['q_mla'][:, :, :, None], k_m, v_m)
    o_c = block_attention(hd['q_win'], hd['k_win'], hd['v_win'], p['sink_win'].reshape(WIN_KV_HEADS, WIN_GROUPS))
    o_d = fourier_mix(hd['v_fn'])
    o = jnp.concatenate([o_a.reshape(B, L, GROUP_W), o_b.reshape(B, L, GROUP_W), o_c.reshape(B, L, GROUP_W), o_d], -1)
    x = x + gt1 * (o @ p['w_out'])
    x = x + gt2 * conv_ffn(modulate(x, p['g_ffn'], sh2, sc2), p)
    return x, (hd['k_na'], hd['v_na'], hd['ckv'], hd['krope'], hd['k_win'], hd['v_win'])


def latent_layer(x, c, ctx, p):
    B, S, _ = x.shape
    na_k, na_v, m_ckv, m_krope, w_k, w_v = ctx
    t = jnp.arange(S)
    row, col = t // GRID_W, t % GRID_W
    mod = jax.nn.silu(c) @ p['w_mod'] + p['b_mod']
    sh1, sc1, gt1, sh2, sc2, gt2 = [m[:, None, :] for m in jnp.split(mod, MOD_CHUNKS, axis=-1)]
    hd = mixer_heads(modulate(x, p['g_mix'], sh1, sc1), p)
    o_a = neighborhood_attention(hd['q_na'], hd['k_na'], hd['v_na'], na_k, na_v, p['rpb_na'])
    q_m = rope_tail(hd['q_mla'], row, col)
    k_l, v_l = mla_kv(hd['ckv'], hd['krope'], p)
    k_l = rope_tail(k_l, row, col)
    k_c, v_c = mla_kv(m_ckv, m_krope, p)
    o_b = block_attention(q_m[:, :, :, None], jnp.concatenate([k_l, k_c], 1), jnp.concatenate([v_l, v_c], 1))
    o_c = window_attention(axial_rope(hd['q_win'], row, col), axial_rope(hd['k_win'], row, col), hd['v_win'],
                           w_k, w_v, p['sink_win'].reshape(WIN_KV_HEADS, WIN_GROUPS))
    o_d = fourier_mix(hd['v_fn'])
    o = jnp.concatenate([o_a.reshape(B, S, GROUP_W), o_b.reshape(B, S, GROUP_W), o_c.reshape(B, S, GROUP_W), o_d], -1)
    x = x + gt1 * (o @ p['w_out'])
    x = x + gt2 * conv_ffn(modulate(x, p['g_ffn'], sh2, sc2), p)
    return x


def setup_inputs(seed: int = 0) -> dict:
    key = jax.random.key(seed)
    ks = iter(jax.random.split(key, 40))

    def nrm(shape, s=1.0):
        return jax.random.normal(next(ks), shape, F32) * s

    def gain(shape):
        return 1.0 + 0.05 * nrm(shape)

    D = D_MODEL
    return {
        'x_prompt': nrm((BATCH, SEQ, D)),
        'x_sample': nrm((DEC_BATCH, DEC_SEQ, D)),
        'cache_na_k': nrm((DEC_BATCH, DEPTH, PAST_LEN, NA_HEADS, HEAD_DIM)),
        'cache_na_v': nrm((DEC_BATCH, DEPTH, PAST_LEN, NA_HEADS, HEAD_DIM)),
        'cache_mla_ckv': nrm((DEC_BATCH, DEPTH, PAST_LEN, MLA_KV_LORA)),
        'cache_mla_krope': nrm((DEC_BATCH, DEPTH, PAST_LEN, MLA_ROPE)),
        'cache_win_k': nrm((DEC_BATCH, DEPTH, PAST_LEN, WIN_KV_HEADS, HEAD_DIM)),
        'cache_win_v': nrm((DEC_BATCH, DEPTH, PAST_LEN, WIN_KV_HEADS, HEAD_DIM)),
        'c': nrm((DEC_BATCH, D)),
        'c_ctx': nrm((D,)),
        'w_mod': nrm((DEPTH, D, MOD_CHUNKS * D), 0.5 * D ** -0.5),
        'b_mod': nrm((DEPTH, MOD_CHUNKS * D), 0.02),
        'g_mix': gain((DEPTH, D)),
        'g_ffn': gain((DEPTH, D)),
        'w_in': nrm((DEPTH, D, IN_COLS), D ** -0.5),
        'g_qn_na': gain((DEPTH, HEAD_DIM)),
        'g_kn_na': gain((DEPTH, HEAD_DIM)),
        'rpb_na': nrm((DEPTH, NA_HEADS, 2 * NA_KH - 1, 2 * NA_KW - 1), 0.1),
        'g_q_lora': gain((DEPTH, MLA_Q_LORA)),
        'w_q_up': nrm((DEPTH, MLA_Q_LORA, MLA_HEADS * (MLA_NOPE + MLA_ROPE)), MLA_Q_LORA ** -0.5),
        'g_kv_lora': gain((DEPTH, MLA_KV_LORA)),
        'w_kv_up': nrm((DEPTH, MLA_KV_LORA, MLA_HEADS * (MLA_NOPE + MLA_V)), MLA_KV_LORA ** -0.5),
        'g_qn_mla': gain((DEPTH, MLA_NOPE + MLA_ROPE)),
        'g_kn_mla': gain((DEPTH, MLA_NOPE + MLA_ROPE)),
        'g_qn_win': gain((DEPTH, HEAD_DIM)),
        'g_kn_win': gain((DEPTH, HEAD_DIM)),
        'sink_win': nrm((DEPTH, WIN_HEADS), 0.5),
        'w_out': nrm((DEPTH, D, D), D ** -0.5),
        'w_gate': nrm((DEPTH, D, D_FF), D ** -0.5),
        'w_up': nrm((DEPTH, D, D_FF), D ** -0.5),
        'w_conv': nrm((DEPTH, 3, D_FF), 3 ** -0.5),
        'w_down': nrm((DEPTH, D_FF, D), D_FF ** -0.5),
    }


def reference(x_prompt, x_sample, cache_na_k, cache_na_v, cache_mla_ckv, cache_mla_krope, cache_win_k, cache_win_v,
              c, c_ctx, w_mod, b_mod, g_mix, g_ffn, w_in, g_qn_na, g_kn_na, rpb_na, g_q_lora, w_q_up, g_kv_lora,
              w_kv_up, g_qn_mla, g_kn_mla, g_qn_win, g_kn_win, sink_win, w_out, w_gate, w_up, w_conv, w_down):
    params = [dict(w_mod=w_mod[l], b_mod=b_mod[l], g_mix=g_mix[l], g_ffn=g_ffn[l], w_in=w_in[l],
                   g_qn_na=g_qn_na[l], g_kn_na=g_kn_na[l], rpb_na=rpb_na[l], g_q_lora=g_q_lora[l],
                   w_q_up=w_q_up[l], g_kv_lora=g_kv_lora[l], w_kv_up=w_kv_up[l], g_qn_mla=g_qn_mla[l],
                   g_kn_mla=g_kn_mla[l], g_qn_win=g_qn_win[l], g_kn_win=g_kn_win[l], sink_win=sink_win[l],
                   w_out=w_out[l], w_gate=w_gate[l], w_up=w_up[l], w_conv=w_conv[l], w_down=w_down[l])
              for l in range(DEPTH)]

    xp = x_prompt
    per_layer = []
    for l in range(DEPTH):
        xp, st = context_layer(xp, c_ctx, params[l])
        per_layer.append(st)
    new_na_k = jnp.stack([s[0] for s in per_layer], axis=1)
    new_na_v = jnp.stack([s[1] for s in per_layer], axis=1)
    new_mla_ckv = jnp.stack([s[2] for s in per_layer], axis=1)
    new_mla_krope = jnp.stack([s[3] for s in per_layer], axis=1)
    new_win_k = jnp.stack([s[4] for s in per_layer], axis=1)
    new_win_v = jnp.stack([s[5] for s in per_layer], axis=1)

    xs = x_sample
    for l in range(DEPTH):
        ctx = (cache_na_k[:, l], cache_na_v[:, l], cache_mla_ckv[:, l], cache_mla_krope[:, l],
               cache_win_k[:, l], cache_win_v[:, l])
        xs = latent_layer(xs, c, ctx, params[l])

    return (xp, xs, new_na_k, new_na_v, new_mla_ckv, new_mla_krope, new_win_k, new_win_v)
```

```cpp
#include <hip/hip_runtime.h>
#include <hip/hip_cooperative_groups.h>
#include <cstdio>
#include <cstdint>
namespace cg = cooperative_groups;

#ifndef MEGA
#define MEGA 0
#endif

typedef unsigned short u16;
using bf16x8 = __attribute__((ext_vector_type(8))) short;
using bf16x4 = __attribute__((ext_vector_type(4))) short;
using f32x4 = __attribute__((ext_vector_type(4))) float;
using f32x16 = __attribute__((ext_vector_type(16))) float;

#define DI __device__ __forceinline__
#define LOG2E 1.4426950408889634f
#define EPSV 1e-6f

constexpr int NT = 12288;
constexpr int NTC = 4096;
constexpr int NTA = 14336;
constexpr int DM = 2048;
constexpr int INC = 3392;
constexpr int DFF = 5632;
constexpr int C_AQ = 0, C_AK = 512, C_AV = 1024, C_MQ = 1536, C_CKV = 1920, C_KR = 2048, C_CQ = 2112, C_CK = 2624, C_CV = 2752, C_FV = 2880;

struct Params {
  const float *x_prompt, *x_sample, *cache_na_k, *cache_na_v, *cache_mla_ckv, *cache_mla_krope, *cache_win_k, *cache_win_v,
      *c, *c_ctx, *w_mod, *b_mod, *g_mix, *g_ffn, *w_in, *g_qn_na, *g_kn_na, *rpb_na, *g_q_lora, *w_q_up, *g_kv_lora,
      *w_kv_up, *g_qn_mla, *g_kn_mla, *g_qn_win, *g_kn_win, *sink_win, *w_out, *w_gate, *w_up, *w_conv, *w_down;
  float* out;
  u16 *WinT, *WqupT, *WkvupT, *WoutT, *WgateT, *WupT, *WdownT;
  u16 *trig128, *W2048, *W256;
  float* mod;
  u16 *h, *raw, *Qa, *Ka, *VaT, *Qw, *Kw, *VwT, *cq, *ckv, *krope, *qmraw, *kvraw, *Qm, *Km, *VmT, *ZtC, *ZtL, *o, *g, *a;
  float* x1;
};

DI u16 f2bf(float x) { unsigned u = __float_as_uint(x); u += 0x7fffu + ((u >> 16) & 1u); return (u16)(u >> 16); }
DI float bf2f(u16 b) { return __uint_as_float(((unsigned)b) << 16); }
DI unsigned pack2(float a, float b) { return (unsigned)f2bf(a) | ((unsigned)f2bf(b) << 16); }
DI float wave_sum(float v) {
#pragma unroll
  for (int o = 32; o > 0; o >>= 1) v += __shfl_xor(v, o);
  return v;
}
DI int mod_index(int row) { return row < NTC ? 0 : 1 + ((row - NTC) >> 11); }
DI const float* xin_row(const Params& p, int l, int row) {
  if (l == 0) return row < NTC ? p.x_prompt + (size_t)row * DM : p.x_sample + (size_t)(row - NTC) * DM;
  return p.out + (size_t)row * DM;
}

template <class Epi>
DI void gemm_tile(u16* smem, const u16* __restrict__ A, int lda, const u16* __restrict__ Bt, int ldb, int K, int m0,
                  int n0, int N, Epi epi) {
  const int tid = threadIdx.x, lane = tid & 63, wid = tid >> 6;
  const int wr = wid >> 1, wc = wid & 1, fr = lane & 15, fq = lane >> 4;
  const int lr = tid >> 3, lc = tid & 7;
  u16* As = smem;
  u16* Bs = smem + 16384;
  f32x4 acc[4][4];
#pragma unroll
  for (int i = 0; i < 4; ++i)
#pragma unroll
    for (int j = 0; j < 4; ++j) acc[i][j] = (f32x4){0.f, 0.f, 0.f, 0.f};
  const u16* ap = A + (size_t)(m0 + lr) * lda + lc * 8;
  const size_t a32 = (size_t)32 * lda;
  const int rn0 = min(n0 + lr, N - 1), rn1 = min(n0 + lr + 32, N - 1), rn2 = min(n0 + lr + 64, N - 1), rn3 = min(n0 + lr + 96, N - 1);
  const u16* bp0 = Bt + (size_t)rn0 * ldb + lc * 8;
  const u16* bp1 = Bt + (size_t)rn1 * ldb + lc * 8;
  const u16* bp2 = Bt + (size_t)rn2 * ldb + lc * 8;
  const u16* bp3 = Bt + (size_t)rn3 * ldb + lc * 8;
  const int nt = K >> 6;
  uint4 ra0 = *(const uint4*)(ap), ra1 = *(const uint4*)(ap + a32), ra2 = *(const uint4*)(ap + 2 * a32), ra3 = *(const uint4*)(ap + 3 * a32);
  uint4 rb0 = *(const uint4*)(bp0), rb1 = *(const uint4*)(bp1), rb2 = *(const uint4*)(bp2), rb3 = *(const uint4*)(bp3);
  const int st_off = lr * 64 + ((lc ^ ((lr >> 1) & 7)) << 3);
  const int sw = (fr >> 1) & 7;
  for (int t = 0; t < nt; ++t) {
    const int buf = t & 1;
    u16* as = As + buf * 8192;
    u16* bs = Bs + buf * 8192;
    *(uint4*)(as + st_off) = ra0;
    *(uint4*)(as + st_off + 2048) = ra1;
    *(uint4*)(as + st_off + 4096) = ra2;
    *(uint4*)(as + st_off + 6144) = ra3;
    *(uint4*)(bs + st_off) = rb0;
    *(uint4*)(bs + st_off + 2048) = rb1;
    *(uint4*)(bs + st_off + 4096) = rb2;
    *(uint4*)(bs + st_off + 6144) = rb3;
    __syncthreads();
    if (t + 1 < nt) {
      const int ko = (t + 1) << 6;
      ra0 = *(const uint4*)(ap + ko);
      ra1 = *(const uint4*)(ap + a32 + ko);
      ra2 = *(const uint4*)(ap + 2 * a32 + ko);
      ra3 = *(const uint4*)(ap + 3 * a32 + ko);
      rb0 = *(const uint4*)(bp0 + ko);
      rb1 = *(const uint4*)(bp1 + ko);
      rb2 = *(const uint4*)(bp2 + ko);
      rb3 = *(const uint4*)(bp3 + ko);
    }
#pragma unroll
    for (int ks = 0; ks < 2; ++ks) {
      bf16x8 af[4], bfv[4];
      const int pc = ((ks * 4 + fq) ^ sw) << 3;
#pragma unroll
      for (int mi = 0; mi < 4; ++mi) af[mi] = *(const bf16x8*)(as + (wr * 64 + mi * 16 + fr) * 64 + pc);
#pragma unroll
      for (int ni = 0; ni < 4; ++ni) bfv[ni] = *(const bf16x8*)(bs + (wc * 64 + ni * 16 + fr) * 64 + pc);
#pragma unroll
      for (int mi = 0; mi < 4; ++mi)
#pragma unroll
        for (int ni = 0; ni < 4; ++ni)
          acc[mi][ni] = __builtin_amdgcn_mfma_f32_16x16x32_bf16(bfv[ni], af[mi], acc[mi][ni], 0, 0, 0);
    }
  }
#pragma unroll
  for (int mi = 0; mi < 4; ++mi)
#pragma unroll
    for (int ni = 0; ni < 4; ++ni) {
      const int m = m0 + wr * 64 + mi * 16 + fr;
      const int n = n0 + wc * 64 + ni * 16 + fq * 4;
      if (n < N) epi(m, n, acc[mi][ni]);
    }
}

struct EpiBf16 {
  u16* C;
  int ldc;
  float scale;
  DI void operator()(int m, int n, f32x4 v) const {
    uint2 r;
    r.x = pack2(v[0] * scale, v[1] * scale);
    r.y = pack2(v[2] * scale, v[3] * scale);
    *(uint2*)(C + (size_t)m * ldc + n) = r;
  }
};

DI void tile_decode(int t, int tilesN, int& tm, int& tn) {
  const int per = 8 * tilesN;
  const int grp = t / per, r = t - grp * per;
  tm = grp * 8 + (r & 7);
  tn = r >> 3;
}

DI void prep_mod_item(const Params& p, u16* smem_u, int it) {
  float* sm = (float*)smem_u;
  float* red = sm + 5 * 2048;
  const int tid = threadIdx.x;
  const int l = it / 192, n0 = (it % 192) * 64;
  for (int e = tid; e < 5 * 2048; e += 256) {
    const int j = e >> 11, k = e & 2047;
    const float v = j == 0 ? p.c_ctx[k] : p.c[(j - 1) * DM + k];
    sm[e] = v / (1.f + __expf(-v));
  }
  __syncthreads();
  const int cgp = tid & 15, kg = tid >> 4;
  float acc[5][4];
#pragma unroll
  for (int j = 0; j < 5; ++j)
#pragma unroll
    for (int q = 0; q < 4; ++q) acc[j][q] = 0.f;
  const float* wp = p.w_mod + (size_t)l * DM * (6 * DM) + (size_t)(kg * 128) * (6 * DM) + n0 + cgp * 4;
#pragma unroll 4
  for (int k = 0; k < 128; ++k) {
    const float4 w = *(const float4*)(wp + (size_t)k * (6 * DM));
#pragma unroll
    for (int j = 0; j < 5; ++j) {
      const float s = sm[j * 2048 + kg * 128 + k];
      acc[j][0] += s * w.x; acc[j][1] += s * w.y; acc[j][2] += s * w.z; acc[j][3] += s * w.w;
    }
  }
#pragma unroll
  for (int j = 0; j < 5; ++j)
#pragma unroll
    for (int q = 0; q < 4; ++q) red[(kg * 16 + cgp) * 20 + j * 4 + q] = acc[j][q];
  __syncthreads();
  for (int e = tid; e < 320; e += 256) {
    const int j = e >> 6, n = e & 63;
    float s = p.b_mod[l * (6 * DM) + n0 + n];
#pragma unroll
    for (int g = 0; g < 16; ++g) s += red[(g * 16 + (n >> 2)) * 20 + j * 4 + (n & 3)];
    p.mod[((size_t)l * 5 + j) * (6 * DM) + n0 + n] = s;
  }
}

DI void transpose_tile(u16* smem_u, const float* __restrict__ src, int K, int N, u16* __restrict__ dst, int k0, int n0) {
  float* tile = (float*)smem_u;
  const int tid = threadIdx.x;
  const int r = tid >> 4, c4 = tid & 15;
#pragma unroll
  for (int ps = 0; ps < 4; ++ps) {
    const int k = r + 16 * ps;
    const float4 v = *(const float4*)(src + (size_t)(k0 + k) * N + n0 + c4 * 4);
    tile[k * 65 + c4 * 4 + 0] = v.x; tile[k * 65 + c4 * 4 + 1] = v.y;
    tile[k * 65 + c4 * 4 + 2] = v.z; tile[k * 65 + c4 * 4 + 3] = v.w;
  }
  __syncthreads();
  const int n = tid >> 2, kq = tid & 3;
  unsigned w[8];
#pragma unroll
  for (int i = 0; i < 8; ++i) w[i] = pack2(tile[(kq * 16 + 2 * i) * 65 + n], tile[(kq * 16 + 2 * i + 1) * 65 + n]);
  uint4* d = (uint4*)(dst + (size_t)(n0 + n) * K + k0 + kq * 16);
  d[0] = make_uint4(w[0], w[1], w[2], w[3]);
  d[1] = make_uint4(w[4], w[5], w[6], w[7]);
}

DI void phase_prep(const Params& p, u16* smem) {
  constexpr int N_MOD = 384;
  constexpr int T_IN = 32 * 53, T_QUP = 6 * 12, T_KVUP = 2 * 16, T_OUT = 32 * 32, T_G = 32 * 88, T_D = 88 * 32;
  constexpr int T_LAYER = T_IN + T_QUP + T_KVUP + T_OUT + 2 * T_G + T_D;
  constexpr int N_TR = 2 * T_LAYER;
  constexpr int N_TRIG = 2088;
  const int total = N_MOD + N_TR + N_TRIG;
  for (int it = blockIdx.x; it < total; it += gridDim.x) {
    __syncthreads();
    if (it < N_MOD) {
      prep_mod_item(p, smem, it);
    } else if (it < N_MOD + N_TR) {
      int t = it - N_MOD;
      const int l = t / T_LAYER;
      t -= l * T_LAYER;
      const float* src; u16* dst; int K, N;
      if (t < T_IN) { src = p.w_in + (size_t)l * DM * INC; dst = p.WinT + (size_t)l * INC * DM; K = DM; N = INC; }
      else if ((t -= T_IN) < T_QUP) { src = p.w_q_up + (size_t)l * 384 * 768; dst = p.WqupT + (size_t)l * 768 * 384; K = 384; N = 768; }
      else if ((t -= T_QUP) < T_KVUP) { src = p.w_kv_up + (size_t)l * 128 * 1024; dst = p.WkvupT + (size_t)l * 1024 * 128; K = 128; N = 1024; }
      else if ((t -= T_KVUP) < T_OUT) { src = p.w_out + (size_t)l * DM * DM; dst = p.WoutT + (size_t)l * DM * DM; K = DM; N = DM; }
      else if ((t -= T_OUT) < T_G) { src = p.w_gate + (size_t)l * DM * DFF; dst = p.WgateT + (size_t)l * DFF * DM; K = DM; N = DFF; }
      else if ((t -= T_G) < T_G) { src = p.w_up + (size_t)l * DM * DFF; dst = p.WupT + (size_t)l * DFF * DM; K = DM; N = DFF; }
      else { t -= T_G; src = p.w_down + (size_t)l * DFF * DM; dst = p.WdownT + (size_t)l * DM * DFF; K = DFF; N = DM; }
      const int tilesN = N >> 6;
      const int tk = t / tilesN, tn = t - tk * tilesN;
      transpose_tile(smem, src, K, N, dst, tk * 64, tn * 64);
    } else {
      const int t = it - N_MOD - N_TR;
#pragma unroll 1
      for (int q = 0; q < 16; ++q) {
        int e = t * 4096 + q * 256 + threadIdx.x;
        if (e < 32768) {
          const int j = e >> 7, c = e & 127;
          const int jj = j & 127;
          const float x = (float)((jj * c) & 127) * (1.f / 64.f);
          float sn, cs;
          sincospif(x, &sn, &cs);
          p.trig128[e] = f2bf(j < 128 ? cs : sn);
        } else if ((e -= 32768) < 131072) {
          const int k = e >> 9, s2 = e & 511, s = s2 & 255;
          const float x = (float)((k * s) & 255) * (1.f / 128.f);
          float sn, cs;
          sincospif(x, &sn, &cs);
          p.W256[e] = f2bf(s2 < 256 ? cs : -sn);
        } else {
          e -= 131072;
          const int k = e >> 12, s2 = e & 4095, s = s2 & 2047;
          const float x = (float)((k * s) & 2047) * (1.f / 1024.f);
          float sn, cs;
          sincospif(x, &sn, &cs);
          p.W2048[e] = f2bf(s2 < 2048 ? cs : -sn);
        }
      }
    }
  }
}

DI void phase_modulate(const Params& p, int l, int which) {
  const int lane = threadIdx.x & 63, wid = threadIdx.x >> 6;
  const float* gain = (which ? p.g_ffn : p.g_mix) + l * DM;
  for (int it = blockIdx.x; it < NT / 4; it += gridDim.x) {
    const int row = it * 4 + wid;
    const float* x = which ? p.x1 + (size_t)row * DM : xin_row(p, l, row);
    const float* md = p.mod + ((size_t)l * 5 + mod_index(row)) * (6 * DM);
    const float* sh = md + (which ? 3 : 0) * DM;
    const float* sc = md + (which ? 4 : 1) * DM;
    float4 v[8];
    float ss = 0.f;
#pragma unroll
    for (int i = 0; i < 8; ++i) {
      v[i] = *(const float4*)(x + i * 256 + lane * 4);
      ss += v[i].x * v[i].x + v[i].y * v[i].y + v[i].z * v[i].z + v[i].w * v[i].w;
    }
    ss = wave_sum(ss);
    const float rs = rsqrtf(ss * (1.f / DM) + EPSV);
#pragma unroll
    for (int i = 0; i < 8; ++i) {
      const int c = i * 256 + lane * 4;
      const float4 g = *(const float4*)(gain + c), s1 = *(const float4*)(sc + c), s0 = *(const float4*)(sh + c);
      uint2 r;
      r.x = pack2(v[i].x * rs * g.x * (1.f + s1.x) + s0.x, v[i].y * rs * g.y * (1.f + s1.y) + s0.y);
      r.y = pack2(v[i].z * rs * g.z * (1.f + s1.z) + s0.z, v[i].w * rs * g.w * (1.f + s1.w) + s0.w);
      *(uint2*)(p.h + (size_t)row * DM + c) = r;
    }
  }
}

DI void phase_qkv(const Params& p, u16* smem, int l) {
  constexpr int T1 = 96 * 27, T2 = 4 * 96, T3 = 96;
  const u16* W = p.WinT + (size_t)l * INC * DM;
  for (int it = blockIdx.x; it < T1 + T2 + T3; it += gridDim.x) {
    __syncthreads();
    if (it < T1) {
      int tm, tn;
      tile_decode(it, 27, tm, tn);
      gemm_tile(smem, p.h, DM, W, DM, DM, tm * 128, tn * 128, INC, EpiBf16{p.raw, INC, 1.f});
    } else if (it < T1 + T2) {
      const int t = it - T1, tm = t & 3, tn = t >> 2;
      gemm_tile(smem, W + (size_t)C_AV * DM, DM, p.h, DM, DM, tm * 128, tn * 128, NT, EpiBf16{p.VaT, NTA, 1.f});
    } else {
      const int tn = it - T1 - T2;
      gemm_tile(smem, W + (size_t)C_CV * DM, DM, p.h, DM, DM, 0, tn * 128, NT, EpiBf16{p.VwT, NTA, 1.f});
    }
  }
}

DI float rope_apply(float y, float sn, float cs, int lane) {
  const float pr = __shfl_xor(y, 16);
  return (lane & 16) ? (pr * sn + y * cs) : (y * cs - pr * sn);
}
DI void rope_trig(int lane, int pos_row, int pos_col, float& sn, float& cs) {
  const int i = lane & 15;
  const float inv = exp2f(-(float)i * (13.287712379549449f / 16.f));
  const float ang = (float)((lane < 32) ? pos_row : pos_col) * inv;
  sincosf(ang, &sn, &cs);
}

DI void phase_post1(const Params& p, int l) {
  const int lane = threadIdx.x & 63, wid = threadIdx.x >> 6;
  float* o_nak = p.out + 25165824;
  float* o_nav = o_nak + 4194304;
  float* o_ckv = o_nav + 4194304;
  float* o_kr = o_ckv + 1048576;
  float* o_wk = o_kr + 524288;
  float* o_wv = o_wk + 1048576;
  for (int it = blockIdx.x; it < NTA / 4; it += gridDim.x) {
    const int tok = it * 4 + wid;
    if (tok < NT) {
      const u16* r = p.raw + (size_t)tok * INC;
      const bool ctx = tok < NTC;
      size_t ob = 0;
      float sn = 0.f, cs = 1.f;
      if (ctx) {
        const int b = tok >> 8, s = tok & 255;
        ob = (size_t)(b * 2 + l) * 256 + s;
      } else {
        const int pos = (tok - NTC) & 2047;
        rope_trig(lane, pos >> 6, pos & 63, sn, cs);
      }
      const float gq = p.g_qn_na[l * 64 + lane], gk = p.g_kn_na[l * 64 + lane];
#pragma unroll 2
      for (int h = 0; h < 8; ++h) {
        float v = bf2f(r[C_AQ + h * 64 + lane]);
        float ss = wave_sum(v * v);
        p.Qa[(size_t)tok * 512 + h * 64 + lane] = f2bf(v * rsqrtf(ss * (1.f / 64.f) + EPSV) * gq * (0.125f * LOG2E));
        v = bf2f(r[C_AK + h * 64 + lane]);
        ss = wave_sum(v * v);
        const float y = v * rsqrtf(ss * (1.f / 64.f) + EPSV) * gk;
        p.Ka[(size_t)tok * 512 + h * 64 + lane] = f2bf(y);
        if (ctx) {
          o_nak[(ob * 8 + h) * 64 + lane] = y;
          o_nav[(ob * 8 + h) * 64 + lane] = bf2f(r[C_AV + h * 64 + lane]);
        }
      }
      {
        float v[6], ss = 0.f;
#pragma unroll
        for (int i = 0; i < 6; ++i) { v[i] = bf2f(r[C_MQ + i * 64 + lane]); ss += v[i] * v[i]; }
        ss = wave_sum(ss);
        const float rs = rsqrtf(ss * (1.f / 384.f) + EPSV);
#pragma unroll
        for (int i = 0; i < 6; ++i) p.cq[(size_t)tok * 384 + i * 64 + lane] = f2bf(v[i] * rs * p.g_q_lora[l * 384 + i * 64 + lane]);
      }
      {
        const float v0 = bf2f(r[C_CKV + lane]), v1 = bf2f(r[C_CKV + 64 + lane]);
        const float ss = wave_sum(v0 * v0 + v1 * v1);
        const float rs = rsqrtf(ss * (1.f / 128.f) + EPSV);
        const float y0 = v0 * rs * p.g_kv_lora[l * 128 + lane], y1 = v1 * rs * p.g_kv_lora[l * 128 + 64 + lane];
        p.ckv[(size_t)tok * 128 + lane] = f2bf(y0);
        p.ckv[(size_t)tok * 128 + 64 + lane] = f2bf(y1);
        if (ctx) { o_ckv[ob * 128 + lane] = y0; o_ckv[ob * 128 + 64 + lane] = y1; }
      }
      {
        const u16 kr = r[C_KR + lane];
        p.krope[(size_t)tok * 64 + lane] = kr;
        if (ctx) o_kr[ob * 64 + lane] = bf2f(kr);
      }
      const float gqw = p.g_qn_win[l * 64 + lane], gkw = p.g_kn_win[l * 64 + lane];
#pragma unroll 2
      for (int hq = 0; hq < 8; ++hq) {
        const float v = bf2f(r[C_CQ + hq * 64 + lane]);
        const float ss = wave_sum(v * v);
        float y = v * rsqrtf(ss * (1.f / 64.f) + EPSV) * gqw;
        if (!ctx) y = rope_apply(y, sn, cs, lane);
        p.Qw[(size_t)tok * 512 + hq * 64 + lane] = f2bf(y * (0.125f * LOG2E));
      }
#pragma unroll
      for (int kh = 0; kh < 2; ++kh) {
        const float v = bf2f(r[C_CK + kh * 64 + lane]);
        const float ss = wave_sum(v * v);
        float y = v * rsqrtf(ss * (1.f / 64.f) + EPSV) * gkw;
        if (ctx) {
          o_wk[(ob * 2 + kh) * 64 + lane] = y;
          o_wv[(ob * 2 + kh) * 64 + lane] = bf2f(r[C_CV + kh * 64 + lane]);
        } else {
          y = rope_apply(y, sn, cs, lane);
        }
        p.Kw[(size_t)tok * 128 + kh * 64 + lane] = f2bf(y);
      }
    } else {
      const int cr = tok - NT, b = cr >> 9, key = cr & 511;
      const size_t cb = (size_t)(b * 2 + l) * 512 + key;
#pragma unroll 2
      for (int h = 0; h < 8; ++h) {
        p.Ka[(size_t)tok * 512 + h * 64 + lane] = f2bf(p.cache_na_k[(cb * 8 + h) * 64 + lane]);
        p.VaT[(size_t)(h * 64 + lane) * NTA + tok] = f2bf(p.cache_na_v[(cb * 8 + h) * 64 + lane]);
      }
      p.ckv[(size_t)tok * 128 + lane] = f2bf(p.cache_mla_ckv[cb * 128 + lane]);
      p.ckv[(size_t)tok * 128 + 64 + lane] = f2bf(p.cache_mla_ckv[cb * 128 + 64 + lane]);
      p.krope[(size_t)tok * 64 + lane] = f2bf(p.cache_mla_krope[cb * 64 + lane]);
#pragma unroll
      for (int kh = 0; kh < 2; ++kh) {
        p.Kw[(size_t)tok * 128 + kh * 64 + lane] = f2bf(p.cache_win_k[(cb * 2 + kh) * 64 + lane]);
        p.VwT[(size_t)(kh * 64 + lane) * NTA + tok] = f2bf(p.cache_win_v[(cb * 2 + kh) * 64 + lane]);
      }
    }
  }
}

DI void phase_up(const Params& p, u16* smem, int l) {
  constexpr int T1 = 96 * 6, T2 = 112 * 4, T3 = 4 * 112, T4 = 256, T5 = 512;
  const u16* Wq = p.WqupT + (size_t)l * 768 * 384;
  const u16* Wkv = p.WkvupT + (size_t)l * 1024 * 128;
  for (int it = blockIdx.x; it < T1 + T2 + T3 + T4 + T5; it += gridDim.x) {
    __syncthreads();
    int t = it;
    if (t < T1) {
      const int tm = t / 6, tn = t - tm * 6;
      gemm_tile(smem, p.cq, 384, Wq, 384, 384, tm * 128, tn * 128, 768, EpiBf16{p.qmraw, 768, 1.f});
    } else if ((t -= T1) < T2) {
      const int tm = t >> 2, hd = t & 3;
      gemm_tile(smem, p.ckv, 128, Wkv, 128, 128, tm * 128, hd * 256, 1024, EpiBf16{p.kvraw, 1024, 1.f});
    } else if ((t -= T2) < T3) {
      const int hd = t & 3, tn = t >> 2;
      gemm_tile(smem, Wkv + (size_t)(hd * 256 + 128) * 128, 128, p.ckv, 128, 128, 0, tn * 128, NTA,
                EpiBf16{p.VmT + (size_t)hd * 128 * NTA, NTA, 1.f});
    } else if ((t -= T3) < T4) {
      const int tn = t & 1, pr = t >> 1, csn = pr & 1, bg = pr >> 1, b = bg >> 2, g = bg & 3;
      gemm_tile(smem, p.trig128 + csn * 128 * 128, 128, p.raw + (size_t)(b * 256) * INC + C_FV + g * 128, INC, 128, 0,
                tn * 128, 256, EpiBf16{p.ZtC + (size_t)bg * 128 * 512 + csn * 256, 512, 1.f});
    } else {
      t -= T4;
      const int tn = t & 15, pr = t >> 4, csn = pr & 1, bg = pr >> 1, b = bg >> 2, g = bg & 3;
      gemm_tile(smem, p.trig128 + csn * 128 * 128, 128, p.raw + (size_t)(NTC + b * 2048) * INC + C_FV + g * 128, INC, 128,
                0, tn * 128, 2048, EpiBf16{p.ZtL + (size_t)bg * 128 * 4096 + csn * 2048, 4096, 1.f});
    }
  }
}

DI void phase_post2(const Params& p, int l) {
  const int lane = threadIdx.x & 63, wid = threadIdx.x >> 6;
  const float SCM = 0.07216878364870322f * LOG2E;
  for (int it = blockIdx.x; it < NTA / 4; it += gridDim.x) {
    const int tok = it * 4 + wid;
    const bool lat = tok >= NTC && tok < NT;
    float sn = 0.f, cs = 1.f;
    if (lat) {
      const int pos = (tok - NTC) & 2047;
      rope_trig(lane, pos >> 6, pos & 63, sn, cs);
    }
    if (tok < NT) {
      const float g0 = p.g_qn_mla[l * 192 + lane], g1 = p.g_qn_mla[l * 192 + 64 + lane], g2 = p.g_qn_mla[l * 192 + 128 + lane];
#pragma unroll
      for (int h = 0; h < 4; ++h) {
        const u16* r = p.qmraw + (size_t)tok * 768 + h * 192;
        const float v0 = bf2f(r[lane]), v1 = bf2f(r[64 + lane]), v2 = bf2f(r[128 + lane]);
        const float ss = wave_sum(v0 * v0 + v1 * v1 + v2 * v2);
        const float rs = rsqrtf(ss * (1.f / 192.f) + EPSV);
        float y2 = v2 * rs * g2;
        if (lat) y2 = rope_apply(y2, sn, cs, lane);
        u16* q = p.Qm + (size_t)tok * 768 + h * 192;
        q[lane] = f2bf(v0 * rs * g0 * SCM);
        q[64 + lane] = f2bf(v1 * rs * g1 * SCM);
        q[128 + lane] = f2bf(y2 * SCM);
      }
    }
    {
      const float g0 = p.g_kn_mla[l * 192 + lane], g1 = p.g_kn_mla[l * 192 + 64 + lane], g2 = p.g_kn_mla[l * 192 + 128 + lane];
      const float v2 = bf2f(p.krope[(size_t)tok * 64 + lane]);
#pragma unroll
      for (int h = 0; h < 4; ++h) {
        const u16* r = p.kvraw + (size_t)tok * 1024 + h * 256;
        const float v0 = bf2f(r[lane]), v1 = bf2f(r[64 + lane]);
        const float ss = wave_sum(v0 * v0 + v1 * v1 + v2 * v2);
        const float rs = rsqrtf(ss * (1.f / 192.f) + EPSV);
        float y2 = v2 * rs * g2;
        if (lat) y2 = rope_apply(y2, sn, cs, lane);
        u16* k = p.Km + (size_t)tok * 768 + h * 192;
        k[lane] = f2bf(v0 * rs * g0);
        k[64 + lane] = f2bf(v1 * rs * g1);
        k[128 + lane] = f2bf(y2);
      }
    }
  }
}

template <int DK, int DV>
DI void attn_wave(const u16* __restrict__ Qp, int ldq, const u16* __restrict__ Kp, int ldk, const u16* __restrict__ Vt,
                  int ldv, u16* __restrict__ Op, int ldo, int lk0, int lk1, int ck0, int ck1, int mode, int qpos0,
                  int seq0, const float* rpb, float sink2, bool has_sink) {
  const int lane = threadIdx.x & 63, qi = lane & 31, hh = lane >> 5;
  bf16x8 qf[DK / 16];
#pragma unroll
  for (int kk = 0; kk < DK / 16; ++kk) qf[kk] = *(const bf16x8*)(Qp + (size_t)qi * ldq + kk * 16 + hh * 8);
  f32x16 o[DV / 32];
#pragma unroll
  for (int mt = 0; mt < DV / 32; ++mt)
#pragma unroll
    for (int i = 0; i < 16; ++i) o[mt][i] = 0.f;
  float m = -1e30f, lsum = 0.f;
  const int qp = qpos0 + qi, qr = qp >> 6, qc = qp & 63;
  const int cs = min(max(qc - 8, 0), 48);
  const float NINF = -__builtin_inff();
#pragma unroll 1
  for (int seg = 0; seg < 2; ++seg) {
    const int k0 = seg ? ck0 : lk0, k1 = seg ? ck1 : lk1;
    const int md = seg ? 0 : mode;
#pragma unroll 1
    for (int kt = k0; kt < k1; kt += 32) {
      f32x16 s;
#pragma unroll
      for (int i = 0; i < 16; ++i) s[i] = 0.f;
      const u16* kp = Kp + (size_t)(kt + qi) * ldk + hh * 8;
#pragma unroll
      for (int kk = 0; kk < DK / 16; ++kk) {
        const bf16x8 kf = *(const bf16x8*)(kp + kk * 16);
        s = __builtin_amdgcn_mfma_f32_32x32x16_bf16(kf, qf[kk], s, 0, 0, 0);
      }
      if (md == 1) {
#pragma unroll
        for (int i = 0; i < 16; ++i) {
          const int key = kt - seq0 + (i & 3) + 8 * (i >> 2) + 4 * hh;
          const int kr = key >> 6, kc = key & 63;
          const bool ok = (kc >= cs) && (kc < cs + 16);
          const int dc = min(max(kc - qc, -15), 15) + 15;
          const float bias = rpb[(kr - qr + 7) * 31 + dc];
          s[i] = ok ? s[i] + bias : NINF;
        }
      } else if (md == 2) {
#pragma unroll
        for (int i = 0; i < 16; ++i) {
          const int d = kt - seq0 + (i & 3) + 8 * (i >> 2) + 4 * hh - qp;
          if (d > 128 || d < -128) s[i] = NINF;
        }
      }
      float mx = s[0];
#pragma unroll
      for (int i = 1; i < 16; ++i) mx = fmaxf(mx, s[i]);
      mx = fmaxf(mx, __shfl_xor(mx, 32));
      const float mn = fmaxf(m, mx);
      const float alpha = __builtin_amdgcn_exp2f(m - mn);
      m = mn;
      float rs = 0.f;
#pragma unroll
      for (int i = 0; i < 16; ++i) {
        s[i] = __builtin_amdgcn_exp2f(s[i] - mn);
        rs += s[i];
      }
      rs += __shfl_xor(rs, 32);
      lsum = lsum * alpha + rs;
#pragma unroll
      for (int mt = 0; mt < DV / 32; ++mt)
#pragma unroll
        for (int i = 0; i < 16; ++i) o[mt][i] *= alpha;
      union { bf16x8 v; unsigned u[4]; } p0, p1;
#pragma unroll
      for (int j = 0; j < 4; ++j) {
        p0.u[j] = pack2(s[2 * j], s[2 * j + 1]);
        p1.u[j] = pack2(s[8 + 2 * j], s[8 + 2 * j + 1]);
      }
#pragma unroll
      for (int mt = 0; mt < DV / 32; ++mt) {
        const u16* vp = Vt + (size_t)(mt * 32 + qi) * ldv + kt + hh * 4;
        union { bf16x8 v; uint2 u[2]; } v0, v1;
        v0.u[0] = *(const uint2*)(vp);
        v0.u[1] = *(const uint2*)(vp + 8);
        v1.u[0] = *(const uint2*)(vp + 16);
        v1.u[1] = *(const uint2*)(vp + 24);
        o[mt] = __builtin_amdgcn_mfma_f32_32x32x16_bf16(v0.v, p0.v, o[mt], 0, 0, 0);
        o[mt] = __builtin_amdgcn_mfma_f32_32x32x16_bf16(v1.v, p1.v, o[mt], 0, 0, 0);
      }
    }
  }
  if (has_sink) lsum += __builtin_amdgcn_exp2f(sink2 - m);
  const float inv = 1.f / lsum;
#pragma unroll
  for (int mt = 0; mt < DV / 32; ++mt)
#pragma unroll
    for (int g = 0; g < 4; ++g) {
      uint2 r;
      r.x = pack2(o[mt][4 * g] * inv, o[mt][4 * g + 1] * inv);
      r.y = pack2(o[mt][4 * g + 2] * inv, o[mt][4 * g + 3] * inv);
      *(uint2*)(Op + (size_t)qi * ldo + mt * 32 + 8 * g + 4 * hh) = r;
    }
}

DI void phase_attn(const Params& p, u16* smem, int l) {
  constexpr int D_L = 256, D_C = 128;
  constexpr int S0 = 256, S1 = 512, S2 = 512, S3 = 256, S4 = 128, S5 = 256;
  const int wid = threadIdx.x >> 6, lane = threadIdx.x & 63;
  float* rpb_l = (float*)smem + wid * 512;
  for (int it = blockIdx.x; it < D_L + D_C + S0 + S1 + S2 + S3 + S4 + S5; it += gridDim.x) {
    __syncthreads();
    int t = it;
    if (t < D_L) {
      const int tm = t & 15, bg = t >> 4, b = bg >> 2, g = bg & 3;
      gemm_tile(smem, p.W2048, 4096, p.ZtL + (size_t)bg * 128 * 4096, 4096, 4096, tm * 128, 0, 128,
                EpiBf16{p.o + (size_t)(NTC + b * 2048) * DM + 1536 + g * 128, DM, 1.f / 512.f});
    } else if ((t -= D_L) < D_C) {
      const int tm = t & 1, bg = t >> 1, b = bg >> 2, g = bg & 3;
      gemm_tile(smem, p.W256, 512, p.ZtC + (size_t)bg * 128 * 512, 512, 512, tm * 128, 0, 128,
                EpiBf16{p.o + (size_t)(b * 256) * DM + 1536 + g * 128, DM, 0.005524271728019903f});
    } else if ((t -= D_C) < S0) {
      const int head = t & 3, qt = (t >> 2) * 4 + wid, b = qt >> 6;
      const int tok0 = NTC + qt * 32, seq0 = NTC + b * 2048;
      attn_wave<192, 128>(p.Qm + (size_t)tok0 * 768 + head * 192, 768, p.Km + head * 192, 768,
                          p.VmT + (size_t)head * 128 * NTA, NTA, p.o + (size_t)tok0 * DM + 512 + head * 128, DM, seq0,
                          seq0 + 2048, NT + b * 512, NT + b * 512 + 512, 0, (qt & 63) * 32, seq0, nullptr, 0.f, false);
    } else if ((t -= S0) < S1) {
      const int head = t & 7, qt = (t >> 3) * 4 + wid, b = qt >> 6;
      const int tok0 = NTC + qt * 32, seq0 = NTC + b * 2048, qpos0 = (qt & 63) * 32;
      const float* rp = p.rpb_na + ((size_t)l * 8 + head) * 465;
      for (int e = lane; e < 465; e += 64) rpb_l[e] = rp[e] * LOG2E;
      const int rs = min(max((qpos0 >> 6) - 4, 0), 24);
      attn_wave<64, 64>(p.Qa + (size_t)tok0 * 512 + head * 64, 512, p.Ka + head * 64, 512, p.VaT + (size_t)head * 64 * NTA,
                        NTA, p.o + (size_t)tok0 * DM + head * 64, DM, seq0 + rs * 64, seq0 + rs * 64 + 512, NT + b * 512,
                        NT + b * 512 + 512, 1, qpos0, seq0, rpb_l, 0.f, false);
    } else if ((t -= S1) < S2) {
      const int kvh = t & 1, qt = t >> 1, b = qt >> 6, hq = kvh * 4 + wid;
      const int tok0 = NTC + qt * 32, seq0 = NTC + b * 2048, qpos0 = (qt & 63) * 32;
      const int k0 = max(qpos0 - 128, 0), k1 = min(qpos0 + 160, 2048);
      attn_wave<64, 64>(p.Qw + (size_t)tok0 * 512 + hq * 64, 512, p.Kw + kvh * 64, 128, p.VwT + (size_t)kvh * 64 * NTA, NTA,
                        p.o + (size_t)tok0 * DM + 1024 + hq * 64, DM, seq0 + k0, seq0 + k1, NT + b * 512, NT + b * 512 + 512,
                        2, qpos0, seq0, nullptr, p.sink_win[l * 8 + hq] * LOG2E, true);
    } else if ((t -= S2) < S3) {
      const int head = t & 7, qt = (t >> 3) * 4 + wid, b = qt >> 3;
      const int tok0 = qt * 32, seq0 = b * 256;
      attn_wave<64, 64>(p.Qa + (size_t)tok0 * 512 + head * 64, 512, p.Ka + head * 64, 512, p.VaT + (size_t)head * 64 * NTA,
                        NTA, p.o + (size_t)tok0 * DM + head * 64, DM, seq0, seq0 + 256, 0, 0, 0, 0, seq0, nullptr, 0.f, false);
    } else if ((t -= S3) < S4) {
      const int head = t & 3, qt = (t >> 2) * 4 + wid, b = qt >> 3;
      const int tok0 = qt * 32, seq0 = b * 256;
      attn_wave<192, 128>(p.Qm + (size_t)tok0 * 768 + head * 192, 768, p.Km + head * 192, 768,
                          p.VmT + (size_t)head * 128 * NTA, NTA, p.o + (size_t)tok0 * DM + 512 + head * 128, DM, seq0,
                          seq0 + 256, 0, 0, 0, 0, seq0, nullptr, 0.f, false);
    } else {
      t -= S4;
      const int kvh = t & 1, qt = t >> 1, b = qt >> 3, hq = kvh * 4 + wid;
      const int tok0 = qt * 32, seq0 = b * 256;
      attn_wave<64, 64>(p.Qw + (size_t)tok0 * 512 + hq * 64, 512, p.Kw + kvh * 64, 128, p.VwT + (size_t)kvh * 64 * NTA, NTA,
                        p.o + (size_t)tok0 * DM + 1024 + hq * 64, DM, seq0, seq0 + 256, 0, 0, 0, 0, seq0, nullptr,
                        p.sink_win[l * 8 + hq] * LOG2E, true);
    }
  }
}

struct EpiResid {
  const float* mod_l;
  const float* res_c;
  const float* res_l;
  float* dstp;
  DI void operator()(int m, int n, f32x4 v) const {
    const float4 g = *(const float4*)(mod_l + (size_t)mod_index(m) * (6 * DM) + n);
    const float* xr = m < NTC ? res_c + (size_t)m * DM : res_l + (size_t)(m - NTC) * DM;
    const float4 x = *(const float4*)(xr + n);
    float4 r;
    r.x = x.x + g.x * v[0]; r.y = x.y + g.y * v[1]; r.z = x.z + g.z * v[2]; r.w = x.w + g.w * v[3];
    *(float4*)(dstp + (size_t)m * DM + n) = r;
  }
};
DI void phase_outproj(const Params& p, u16* smem, int l) {
  const u16* W = p.WoutT + (size_t)l * DM * DM;
  for (int it = blockIdx.x; it < 96 * 16; it += gridDim.x) {
    __syncthreads();
    int tm, tn;
    tile_decode(it, 16, tm, tn);
    gemm_tile(smem, p.o, DM, W, DM, DM, tm * 128, tn * 128, DM, EpiResid{p.mod + (size_t)l * 5 * 6 * DM + 2 * DM, l == 0 ? p.x_prompt : p.out, l == 0 ? p.x_sample : p.out + (size_t)NTC * DM, p.x1});
  }
}
DI void phase_gate(const Params& p, u16* smem, int l) {
  const u16* W = p.WgateT + (size_t)l * DFF * DM;
  for (int it = blockIdx.x; it < 96 * 44; it += gridDim.x) {
    __syncthreads();
    int tm, tn;
    tile_decode(it, 44, tm, tn);
    gemm_tile(smem, p.h, DM, W, DM, DM, tm * 128, tn * 128, DFF, EpiBf16{p.g, DFF, 1.f});
  }
}
struct EpiUp {
  const float* wconv;
  const u16* gbuf;
  u16* abuf;
  DI void operator()(int m, int n, f32x4 v) const {
    const float* wc = wconv + n;
    const float4 w0 = *(const float4*)wc, w1 = *(const float4*)(wc + DFF), w2 = *(const float4*)(wc + 2 * DFF);
    const int pos = m < NTC ? (m & 255) : ((m - NTC) & 2047);
    const int last = m < NTC ? 255 : 2047;
    const u16* gp = gbuf + (size_t)m * DFF + n;
    const uint2 c1 = *(const uint2*)gp;
    uint2 c0 = make_uint2(0u, 0u), c2 = make_uint2(0u, 0u);
    if (pos > 0) c0 = *(const uint2*)(gp - DFF);
    if (pos < last) c2 = *(const uint2*)(gp + DFF);
    float gg[4];
    gg[0] = bf2f((u16)(c0.x & 0xffff)) * w0.x + bf2f((u16)(c1.x & 0xffff)) * w1.x + bf2f((u16)(c2.x & 0xffff)) * w2.x;
    gg[1] = bf2f((u16)(c0.x >> 16)) * w0.y + bf2f((u16)(c1.x >> 16)) * w1.y + bf2f((u16)(c2.x >> 16)) * w2.y;
    gg[2] = bf2f((u16)(c0.y & 0xffff)) * w0.z + bf2f((u16)(c1.y & 0xffff)) * w1.z + bf2f((u16)(c2.y & 0xffff)) * w2.z;
    gg[3] = bf2f((u16)(c0.y >> 16)) * w0.w + bf2f((u16)(c1.y >> 16)) * w1.w + bf2f((u16)(c2.y >> 16)) * w2.w;
    float r[4];
#pragma unroll
    for (int i = 0; i < 4; ++i) r[i] = gg[i] / (1.f + __expf(-gg[i])) * v[i];
    uint2 o;
    o.x = pack2(r[0], r[1]);
    o.y = pack2(r[2], r[3]);
    *(uint2*)(abuf + (size_t)m * DFF + n) = o;
  }
};
DI void phase_up_ffn(const Params& p, u16* smem, int l) {
  const u16* W = p.WupT + (size_t)l * DFF * DM;
  for (int it = blockIdx.x; it < 96 * 44; it += gridDim.x) {
    __syncthreads();
    int tm, tn;
    tile_decode(it, 44, tm, tn);
    gemm_tile(smem, p.h, DM, W, DM, DM, tm * 128, tn * 128, DFF, EpiUp{p.w_conv + (size_t)l * 3 * DFF, p.g, p.a});
  }
}
DI void phase_down(const Params& p, u16* smem, int l) {
  const u16* W = p.WdownT + (size_t)l * DM * DFF;
  for (int it = blockIdx.x; it < 96 * 16; it += gridDim.x) {
    __syncthreads();
    int tm, tn;
    tile_decode(it, 16, tm, tn);
    gemm_tile(smem, p.a, DFF, W, DFF, DFF, tm * 128, tn * 128, DM, EpiResid{p.mod + (size_t)l * 5 * 6 * DM + 5 * DM, p.x1, p.x1 + (size_t)NTC * DM, p.out});
  }
}

constexpr int N_PHASES = 1 + 2 * 11;
DI void run_phase(const Params& p, u16* smem, int ph) {
#ifdef ONLY
  { const int l = ph & 1; const int s = ONLY; if (s == 11) { phase_prep(p, smem); return; }
  switch (s) {
    case 0: phase_modulate(p, l, 0); break;
    case 1: phase_qkv(p, smem, l); break;
    case 2: phase_post1(p, l); break;
    case 3: phase_up(p, smem, l); break;
    case 4: phase_post2(p, l); break;
    case 5: phase_attn(p, smem, l); break;
    case 6: phase_outproj(p, smem, l); break;
    case 7: phase_modulate(p, l, 1); break;
    case 8: phase_gate(p, smem, l); break;
    case 9: phase_up_ffn(p, smem, l); break;
    default: phase_down(p, smem, l); break;
  } return; }
#endif
  if (ph == 0) { phase_prep(p, smem); return; }
  const int l = (ph - 1) / 11, s = (ph - 1) % 11;
  switch (s) {
    case 0: phase_modulate(p, l, 0); break;
    case 1: phase_qkv(p, smem, l); break;
    case 2: phase_post1(p, l); break;
    case 3: phase_up(p, smem, l); break;
    case 4: phase_post2(p, l); break;
    case 5: phase_attn(p, smem, l); break;
    case 6: phase_outproj(p, smem, l); break;
    case 7: phase_modulate(p, l, 1); break;
    case 8: phase_gate(p, smem, l); break;
    case 9: phase_up_ffn(p, smem, l); break;
    default: phase_down(p, smem, l); break;
  }
}

#if MEGA
__global__ void __launch_bounds__(256) mega_kernel(Params p) {
  __shared__ __attribute__((aligned(16))) u16 smem[32768];
  cg::grid_group grid = cg::this_grid();
#pragma unroll 1
  for (int ph = 0; ph < N_PHASES; ++ph) {
    run_phase(p, smem, ph);
    if (ph + 1 < N_PHASES) grid.sync();
  }
}
#else
__global__ void __launch_bounds__(256) phase_kernel(Params p, int ph) {
  __shared__ __attribute__((aligned(16))) u16 smem[32768];
  run_phase(p, smem, ph);
}
#endif

extern "C" void kernel_launch(void* const* d_in, const int* in_sizes, int n_in, void* d_out, int out_size, void* d_ws,
                              size_t ws_size, hipStream_t stream) {
  Params p{};
  const float** pi = (const float**)&p;
  for (int i = 0; i < 32; ++i) pi[i] = (const float*)d_in[i];
  p.out = (float*)d_out;
  char* w = (char*)d_ws;
  size_t off = 0;
  auto take = [&](size_t bytes) { char* r = w + off; off += (bytes + 255) & ~(size_t)255; return r; };
  p.WinT = (u16*)take((size_t)2 * INC * DM * 2);
  p.WqupT = (u16*)take((size_t)2 * 768 * 384 * 2);
  p.WkvupT = (u16*)take((size_t)2 * 1024 * 128 * 2);
  p.WoutT = (u16*)take((size_t)2 * DM * DM * 2);
  p.WgateT = (u16*)take((size_t)2 * DFF * DM * 2);
  p.WupT = (u16*)take((size_t)2 * DFF * DM * 2);
  p.WdownT = (u16*)take((size_t)2 * DM * DFF * 2);
  p.trig128 = (u16*)take(256 * 128 * 2);
  p.W256 = (u16*)take(256 * 512 * 2);
  p.W2048 = (u16*)take((size_t)2048 * 4096 * 2);
  p.mod = (float*)take((size_t)2 * 5 * 6 * DM * 4);
  p.x1 = (float*)take((size_t)NT * DM * 4);
  p.h = (u16*)take((size_t)NT * DM * 2);
  const size_t att0 = off;
  p.raw = (u16*)take((size_t)NT * INC * 2);
  p.Qa = (u16*)take((size_t)NT * 512 * 2);
  p.Ka = (u16*)take((size_t)NTA * 512 * 2);
  p.VaT = (u16*)take((size_t)512 * NTA * 2);
  p.Qw = (u16*)take((size_t)NT * 512 * 2);
  p.Kw = (u16*)take((size_t)NTA * 128 * 2);
  p.VwT = (u16*)take((size_t)128 * NTA * 2);
  p.cq = (u16*)take((size_t)NT * 384 * 2);
  p.ckv = (u16*)take((size_t)NTA * 128 * 2);
  p.krope = (u16*)take((size_t)NTA * 64 * 2);
  p.qmraw = (u16*)take((size_t)NT * 768 * 2);
  p.kvraw = (u16*)take((size_t)NTA * 1024 * 2);
  p.Qm = (u16*)take((size_t)NT * 768 * 2);
  p.Km = (u16*)take((size_t)NTA * 768 * 2);
  p.VmT = (u16*)take((size_t)512 * NTA * 2);
  p.ZtC = (u16*)take((size_t)64 * 128 * 512 * 2);
  p.ZtL = (u16*)take((size_t)16 * 128 * 4096 * 2);
  p.o = (u16*)take((size_t)NT * DM * 2);
  const size_t att1 = off;
  off = att0;
  p.g = (u16*)take((size_t)NT * DFF * 2);
  p.a = (u16*)take((size_t)NT * DFF * 2);
  if (off < att1) off = att1;
  if (off > ws_size) fprintf(stderr, "workspace too small: need %zu have %zu\n", off, ws_size);

#if MEGA
  static int grid_blocks = 0;
  if (!grid_blocks) {
    int dev = 0, cus = 0, per_cu = 0;
    hipGetDevice(&dev);
    hipDeviceGetAttribute(&cus, hipDeviceAttributeMultiprocessorCount, dev);
    hipOccupancyMaxActiveBlocksPerMultiprocessor(&per_cu, mega_kernel, 256, 0);
    grid_blocks = cus * per_cu;
  }
  void* args[] = {&p};
  hipError_t e = hipLaunchCooperativeKernel((void*)mega_kernel, dim3(grid_blocks), dim3(256), args, 0, stream);
  if (e != hipSuccess) fprintf(stderr, "cooperative launch failed: %s (grid %d)\n", hipGetErrorString(e), grid_blocks);
#else
  for (int ph = 0; ph < N_PHASES; ++ph) phase_kernel<<<dim3(1024), dim3(256), 0, stream>>>(p, ph);
#endif
}
```

```cpp
#include <hip/hip_runtime.h>
#include <hip/hip_cooperative_groups.h>
#include <cstdio>
#include <cstdint>
namespace cg = cooperative_groups;

#ifndef MEGA
#define MEGA 1
#endif

typedef unsigned short u16;
using bf16x8 = __attribute__((ext_vector_type(8))) short;
using bf16x4 = __attribute__((ext_vector_type(4))) short;
using f32x4 = __attribute__((ext_vector_type(4))) float;
using f32x16 = __attribute__((ext_vector_type(16))) float;

#define DI __device__ __forceinline__
typedef __attribute__((address_space(3))) unsigned lds_uint;
#define LOG2E 1.4426950408889634f
#define EPSV 1e-6f

constexpr int NT = 12288;
constexpr int NTC = 4096;
constexpr int NTA = 14336;
constexpr int DM = 2048;
constexpr int INC = 3392;
constexpr int RLD = 3584;
constexpr int NTHR = 512;
constexpr int DFF = 5632;
constexpr int C_AQ = 0, C_AK = 512, C_AV = 1024, C_MQ = 1536, C_CKV = 1920, C_KR = 2048, C_CQ = 2112, C_CK = 2624, C_CV = 2752, C_FV = 2880;

struct Params {
  const float *x_prompt, *x_sample, *cache_na_k, *cache_na_v, *cache_mla_ckv, *cache_mla_krope, *cache_win_k, *cache_win_v,
      *c, *c_ctx, *w_mod, *b_mod, *g_mix, *g_ffn, *w_in, *g_qn_na, *g_kn_na, *rpb_na, *g_q_lora, *w_q_up, *g_kv_lora,
      *w_kv_up, *g_qn_mla, *g_kn_mla, *g_qn_win, *g_kn_win, *sink_win, *w_out, *w_gate, *w_up, *w_conv, *w_down;
  float* out;
  u16 *WinT, *WqupT, *WkvupT, *WoutT, *WgateT, *WupT, *WdownT;
  u16 *trig128, *W2048, *W256;
  float* mod;
  u16 *h, *raw, *Qa, *Ka, *VaT, *Qw, *Kw, *VwT, *cq, *ckv, *krope, *qmraw, *kvraw, *Qm, *Km, *VmT, *ZtC, *ZtL, *o, *g, *a;
  u16* x1b;
  u16* x2b;
  int* ctr;
  unsigned* flags;
  float* part;
  unsigned* barw;
};

typedef __bf16 bf16n2 __attribute__((ext_vector_type(2)));
typedef float f32n2 __attribute__((ext_vector_type(2)));
DI unsigned pack2(float a, float b) {
  const f32n2 v = {a, b};
  return __builtin_bit_cast(unsigned, __builtin_convertvector(v, bf16n2));
}
DI u16 f2bf(float x) { return (u16)(pack2(x, 0.f) & 0xffffu); }
DI float bf2f(u16 b) { return __uint_as_float(((unsigned)b) << 16); }
#define DPP_F(v, ctrl, row_mask) \
  __builtin_bit_cast(float, __builtin_amdgcn_update_dpp(0, __builtin_bit_cast(int, (v)), (ctrl), (row_mask), 0xF, false))
DI float wave_sum(float v) {
  v += DPP_F(v, 0xB1, 0xF);
  v += DPP_F(v, 0x4E, 0xF);
  v += DPP_F(v, 0x141, 0xF);
  v += DPP_F(v, 0x140, 0xF);
  v += DPP_F(v, 0x142, 0xA);
  v += DPP_F(v, 0x143, 0xC);
  return __builtin_bit_cast(float, __builtin_amdgcn_readlane(__builtin_bit_cast(int, v), 63));
}
DI int tid_opaque() { int t = threadIdx.x; asm volatile("" : "+v"(t)); return t; }
DI int mod_index(int row) { return row < NTC ? 0 : 1 + ((row - NTC) >> 11); }
DI const float* xin_row(const Params& p, int l, int row) {
  if (l == 0) return row < NTC ? p.x_prompt + (size_t)row * DM : p.x_sample + (size_t)(row - NTC) * DM;
  return p.out + (size_t)row * DM;
}

template <class Epi>
DI void gemm_tile(u16* smem, const u16* __restrict__ A, int lda, const u16* __restrict__ Bt, int ldb, int K, int m0,
                  int n0, int N, Epi epi) {
  const int TIDX = tid_opaque();
  const int tid = TIDX, lane = tid & 63, wid = tid >> 6;
  const int wr = wid >> 2, wc = wid & 3, fr = lane & 15, fq = lane >> 4;
  const int lr = tid >> 3, lc = tid & 7;
  u16* As = smem;
  u16* Bs = smem + 16384;
  f32x4 acc[4][2];
#pragma unroll
  for (int i = 0; i < 4; ++i)
#pragma unroll
    for (int j = 0; j < 2; ++j) acc[i][j] = (f32x4){0.f, 0.f, 0.f, 0.f};
  const u16* ap = A + (size_t)(m0 + lr) * lda + lc * 8;
  const size_t a64 = (size_t)64 * lda;
  const int rn0 = min(n0 + lr, N - 1), rn1 = min(n0 + lr + 64, N - 1);
  const u16* bp0 = Bt + (size_t)rn0 * ldb + lc * 8;
  const u16* bp1 = Bt + (size_t)rn1 * ldb + lc * 8;
  const int nt = K >> 6;
  uint4 ra0 = *(const uint4*)(ap), ra1 = *(const uint4*)(ap + a64);
  uint4 rb0 = *(const uint4*)(bp0), rb1 = *(const uint4*)(bp1);
  uint4 sa0 = ra0, sa1 = ra1, sb0 = rb0, sb1 = rb1;
  if (nt > 1) {
    sa0 = *(const uint4*)(ap + 64); sa1 = *(const uint4*)(ap + a64 + 64);
    sb0 = *(const uint4*)(bp0 + 64); sb1 = *(const uint4*)(bp1 + 64);
  }
  const int st_off = lr * 64 + ((lc ^ ((lr >> 1) & 7)) << 3);
  const int sw = (fr >> 1) & 7;
#define GT_COMPUTE(as, bs)                                                                              \
  _Pragma("unroll") for (int ks = 0; ks < 2; ++ks) {                                                    \
    bf16x8 af[4], bfv[2];                                                                               \
    const int pc = ((ks * 4 + fq) ^ sw) << 3;                                                           \
    _Pragma("unroll") for (int mi = 0; mi < 4; ++mi) af[mi] = *(const bf16x8*)((as) + (wr * 64 + mi * 16 + fr) * 64 + pc); \
    _Pragma("unroll") for (int ni = 0; ni < 2; ++ni) bfv[ni] = *(const bf16x8*)((bs) + (wc * 32 + ni * 16 + fr) * 64 + pc); \
    _Pragma("unroll") for (int mi = 0; mi < 4; ++mi)                                                    \
      _Pragma("unroll") for (int ni = 0; ni < 2; ++ni)                                                  \
        acc[mi][ni] = __builtin_amdgcn_mfma_f32_16x16x32_bf16(bfv[ni], af[mi], acc[mi][ni], 0, 0, 0);   \
  }
  for (int t = 0; t < nt; t += 2) {
    {
      u16* as = As;
      u16* bs = Bs;
      *(uint4*)(as + st_off) = ra0;
      *(uint4*)(as + st_off + 4096) = ra1;
      *(uint4*)(bs + st_off) = rb0;
      *(uint4*)(bs + st_off + 4096) = rb1;
      __syncthreads();
      if (t + 2 < nt) {
        const int ko = (t + 2) << 6;
        ra0 = *(const uint4*)(ap + ko);
        ra1 = *(const uint4*)(ap + a64 + ko);
        rb0 = *(const uint4*)(bp0 + ko);
        rb1 = *(const uint4*)(bp1 + ko);
      }
      GT_COMPUTE(as, bs)
    }
    if (t + 1 < nt) {
      u16* as = As + 8192;
      u16* bs = Bs + 8192;
      *(uint4*)(as + st_off) = sa0;
      *(uint4*)(as + st_off + 4096) = sa1;
      *(uint4*)(bs + st_off) = sb0;
      *(uint4*)(bs + st_off + 4096) = sb1;
      __syncthreads();
      if (t + 3 < nt) {
        const int ko = (t + 3) << 6;
        sa0 = *(const uint4*)(ap + ko);
        sa1 = *(const uint4*)(ap + a64 + ko);
        sb0 = *(const uint4*)(bp0 + ko);
        sb1 = *(const uint4*)(bp1 + ko);
      }
      GT_COMPUTE(as, bs)
    }
  }
#undef GT_COMPUTE
  epi.begin();
  {
    typename Epi::Pre pre[4][2];
#pragma unroll
    for (int mi = 0; mi < 4; ++mi)
#pragma unroll
      for (int ni = 0; ni < 2; ++ni) {
        const int m = m0 + wr * 64 + mi * 16 + fr;
        const int n = n0 + wc * 32 + ni * 16 + fq * 4;
        if (n < N) pre[mi][ni] = epi.load(m, n);
      }
#pragma unroll
    for (int mi = 0; mi < 4; ++mi)
#pragma unroll
      for (int ni = 0; ni < 2; ++ni) {
        const int m = m0 + wr * 64 + mi * 16 + fr;
        const int n = n0 + wc * 32 + ni * 16 + fq * 4;
        if (n < N) epi.store(m, n, acc[mi][ni], pre[mi][ni]);
      }
  }
  epi.end();
}

constexpr int G_HT = 128 * 64;
DI int lds_byte(int r, int c) {
  const int st = (r >> 4) * 2 + (c >> 5), rr = r & 15, cc = c & 31, ob = rr * 64 + cc * 2;
  return st * 1024 + (ob ^ (((ob >> 9) & 1) << 5));
}
DI void stage_rc(int b, int& R, int& C) {
  const int st = b / 1024, sb = b % 1024, swz = sb ^ (((sb >> 9) & 1) << 5);
  R = (st >> 1) * 16 + swz / 64;
  C = (st & 1) * 32 + (swz % 64) / 2;
}
template <bool HALF = false, class Epi>
DI void gemm256_tile(u16* shm, const u16* __restrict__ A, const u16* __restrict__ Bt, int K, int ld, int brow, int bcol, Epi epi) {
  const int TIDX = tid_opaque();
#define SA(b, h) (shm + ((b) * 2 + (h)) * G_HT)
#define SB(b, h) (shm + (4 + (b) * 2 + (h)) * G_HT)
#define STAGE(P, BASE, br, kt)                                                                          \
  do {                                                                                                  \
    const char* _ub = (const char*)((BASE) + (long)(br) * ld + (long)(kt) * 64);                         \
    __builtin_amdgcn_global_load_lds((const unsigned*)(_ub + voff0),                                    \
                                     (__attribute__((address_space(3))) unsigned*)((char*)(P) + TIDX * 16), 16, 0, 0); \
    __builtin_amdgcn_global_load_lds((const unsigned*)(_ub + voff1),                                    \
                                     (__attribute__((address_space(3))) unsigned*)((char*)(P) + TIDX * 16 + 8192), 16, 0, 0); \
  } while (0)
#define LDA(dst, b, h)                                                                                  \
  for (int m = 0; m < 4; ++m)                                                                           \
    for (int k = 0; k < 2; ++k)                                                                         \
      dst[m][k] = *reinterpret_cast<const bf16x8*>(lds_a + (((b) * 2 + (h)) * 16384 + m * 2048 + k * 1024))
#define LDB(dst, b, h)                                                                                  \
  for (int n = 0; n < 2; ++n)                                                                           \
    for (int k = 0; k < 2; ++k)                                                                         \
      dst[n][k] = *reinterpret_cast<const bf16x8*>(lds_b + (((b) * 2 + (h)) * 16384 + n * 2048 + k * 1024))
#define MMA(ai, bj, At, Bv)                                                                             \
  if (!(HALF && (bj) == 1)) do {                                                                        \
    __builtin_amdgcn_s_setprio(1);                                                                      \
    for (int m = 0; m < 4; ++m)                                                                         \
      for (int n = 0; n < 2; ++n)                                                                       \
        for (int k = 0; k < 2; ++k)                                                                     \
          acc[ai][bj][m][n] = __builtin_amdgcn_mfma_f32_16x16x32_bf16(Bv[n][k], At[m][k], acc[ai][bj][m][n], 0, 0, 0); \
    __builtin_amdgcn_s_setprio(0);                                                                      \
  } while (0)
#define WAIT_V(n) asm volatile("s_waitcnt vmcnt(" #n ")" ::: "memory")
#define WAIT_L(n) asm volatile("s_waitcnt lgkmcnt(" #n ")" ::: "memory")
#define BAR __builtin_amdgcn_s_barrier()
#define SCHED __builtin_amdgcn_sched_barrier(0)
  const int wid = TIDX >> 6, lane = TIDX & 63, wr = wid >> 2, wc = wid & 3, fr = lane & 15, fq = lane >> 4;
  f32x4 acc[2][2][4][2];
#pragma unroll
  for (int a = 0; a < 2; ++a)
#pragma unroll
    for (int b = 0; b < 2; ++b)
#pragma unroll
      for (int m = 0; m < 4; ++m)
#pragma unroll
        for (int n = 0; n < 2; ++n) acc[a][b][m][n] = (f32x4){0.f, 0.f, 0.f, 0.f};
  bf16x8 At[4][2], B0[2][2], B1[2][2];
  const int nt = K / 64;
  const int swz_ = (fr * 64 + fq * 16) ^ ((((fr * 64 + fq * 16) >> 9) & 1) << 5);
  const char* lds_a = (const char*)shm + wr * 8192 + swz_;
  const char* lds_b = (const char*)shm + 65536 + wc * 4096 + swz_;
  unsigned voff0, voff1;
  {
    int r_, c_;
    stage_rc(TIDX * 16, r_, c_);
    voff0 = (unsigned)(r_ * ld + c_) * 2u;
    stage_rc(TIDX * 16 + 8192, r_, c_);
    voff1 = (unsigned)(r_ * ld + c_) * 2u;
  }
  STAGE(SB(0, 0), Bt, bcol, 0); STAGE(SA(0, 0), A, brow, 0);
  STAGE(SB(0, 1), Bt, bcol + 128, 0); STAGE(SA(0, 1), A, brow + 128, 0);
  if (wr == 1) BAR;
  WAIT_V(4); BAR;
  STAGE(SB(1, 0), Bt, bcol, 1); STAGE(SA(1, 0), A, brow, 1); STAGE(SB(1, 1), Bt, bcol + 128, 1);
  WAIT_V(6); BAR;
  for (int t = 0; t < nt - 2; t += 2) {
    LDB(B0, 0, 0); SCHED; LDA(At, 0, 0); STAGE(SA(1, 1), A, brow + 128, t + 1);
    WAIT_L(8); BAR; WAIT_L(0); MMA(0, 0, At, B0); BAR; SCHED;
    LDB(B1, 0, 1); STAGE(SB(0, 0), Bt, bcol, t + 2);
    BAR; WAIT_L(0); MMA(0, 1, At, B1); BAR;
    LDA(At, 0, 1); STAGE(SA(0, 0), A, brow, t + 2);
    BAR; WAIT_L(0); MMA(1, 0, At, B0); BAR; SCHED;
    STAGE(SB(0, 1), Bt, bcol + 128, t + 2);
    WAIT_V(6); BAR; MMA(1, 1, At, B1); BAR;
    LDB(B0, 1, 0); SCHED; LDA(At, 1, 0); STAGE(SA(0, 1), A, brow + 128, t + 2);
    WAIT_L(8); BAR; WAIT_L(0); MMA(0, 0, At, B0); BAR; SCHED;
    LDB(B1, 1, 1); STAGE(SB(1, 0), Bt, bcol, t + 3);
    BAR; WAIT_L(0); MMA(0, 1, At, B1); BAR;
    LDA(At, 1, 1); STAGE(SA(1, 0), A, brow, t + 3);
    BAR; WAIT_L(0); MMA(1, 0, At, B0); BAR; SCHED;
    STAGE(SB(1, 1), Bt, bcol + 128, t + 3);
    WAIT_V(6); BAR; MMA(1, 1, At, B1); BAR;
  }
  { LDB(B0, 0, 0); LDA(At, 0, 0); STAGE(SA(1, 1), A, brow + 128, nt - 1);
    BAR; WAIT_L(0); MMA(0, 0, At, B0); BAR;
    LDB(B1, 0, 1); BAR; WAIT_L(0); MMA(0, 1, At, B1); BAR;
    LDA(At, 0, 1); WAIT_V(4); BAR; WAIT_L(0); MMA(1, 0, At, B0); MMA(1, 1, At, B1); BAR; }
  { LDB(B0, 1, 0); LDA(At, 1, 0); WAIT_V(2); BAR; WAIT_L(0); MMA(0, 0, At, B0); BAR;
    LDB(B1, 1, 1); WAIT_V(0); BAR; WAIT_L(0); MMA(0, 1, At, B1); BAR;
    LDA(At, 1, 1); BAR; WAIT_L(0); MMA(1, 0, At, B0); MMA(1, 1, At, B1); BAR; }
  if (wr == 0) BAR;
  epi.begin();
#pragma unroll
  for (int ai = 0; ai < 2; ++ai)
#pragma unroll
    for (int m = 0; m < 4; ++m) {
      const int row = brow + ai * 128 + wr * 64 + m * 16 + fr;
      typename Epi::Pre pre[2][2];
#pragma unroll
      for (int bj = 0; bj < (HALF ? 1 : 2); ++bj)
#pragma unroll
        for (int n = 0; n < 2; ++n) pre[bj][n] = epi.load(row, bcol + bj * 128 + wc * 32 + n * 16 + fq * 4);
#pragma unroll
      for (int bj = 0; bj < (HALF ? 1 : 2); ++bj)
#pragma unroll
        for (int n = 0; n < 2; ++n) epi.store(row, bcol + bj * 128 + wc * 32 + n * 16 + fq * 4, acc[ai][bj][m][n], pre[bj][n]);
    }
  epi.end();
#undef SA
#undef SB
#undef STAGE
#undef LDA
#undef LDB
#undef MMA
}

struct EpiBf16 {
  u16* C;
  int ldc;
  float scale;
  struct Pre {};
  DI void begin() const {}
  DI void end() const {}
  DI Pre load(int, int) const { return Pre{}; }
  DI void store(int m, int n, f32x4 v, Pre) const {
    uint2 r;
    r.x = pack2(v[0] * scale, v[1] * scale);
    r.y = pack2(v[2] * scale, v[3] * scale);
    *(uint2*)(C + (size_t)m * ldc + n) = r;
  }
};

struct EpiBf16P {
  u16* C;
  int ldc;
  struct Pre {};
  DI void begin() const {}
  DI void end() const {}
  DI Pre load(int, int) const { return Pre{}; }
  DI void store(int m, int n, f32x4 v, Pre) const {
    const int np = (n & ~12) | ((n & 4) << 1) | ((n & 8) >> 1);
    uint2 r;
    r.x = pack2(v[0], v[1]);
    r.y = pack2(v[2], v[3]);
    *(uint2*)(C + (size_t)m * ldc + np) = r;
  }
};

struct EpiLdsF32 {
  float* lds;
  int m0;
  struct Pre {};
  DI void begin() const {}
  DI void end() const {}
  DI Pre load(int, int) const { return Pre{}; }
  DI void store(int m, int n, f32x4 v, Pre) const { *(f32x4*)(lds + (m - m0) * 128 + n) = v; }
};
struct EpiDftSym {
  const float* lds;
  int m0, S;
  u16* obase;
  int ldo;
  float scale;
  struct Pre { f32x4 pv; };
  DI void begin() const {}
  DI void end() const {}
  DI Pre load(int m, int n) const { Pre q; q.pv = *(const f32x4*)(lds + (m - m0) * 128 + n); return q; }
  DI void store(int m, int n, f32x4 v, const Pre& q) const {
    uint2 r;
    r.x = pack2((q.pv[0] + v[0]) * scale, (q.pv[1] + v[1]) * scale);
    r.y = pack2((q.pv[2] + v[2]) * scale, (q.pv[3] + v[3]) * scale);
    *(uint2*)(obase + (size_t)m * ldo + n) = r;
    if (m > 0) {
      r.x = pack2((q.pv[0] - v[0]) * scale, (q.pv[1] - v[1]) * scale);
      r.y = pack2((q.pv[2] - v[2]) * scale, (q.pv[3] - v[3]) * scale);
      *(uint2*)(obase + (size_t)(S - m) * ldo + n) = r;
    }
  }
};

DI void tile_decode(int t, int tilesN, int& tm, int& tn) {
  const int per = 8 * tilesN;
  const int grp = t / per, r = t - grp * per;
  tm = grp * 8 + (r & 7);
  tn = r >> 3;
}
DI void tile256_decode(int L, int nM, int nN, int& pm, int& pn) {
  const int nwg = nM * nN;
  int wgid = L;
  {
    const int q = nwg / 8, r = nwg % 8, xcd = wgid % 8, off = wgid / 8;
    wgid = (xcd < r ? xcd * (q + 1) : r * (q + 1) + (xcd - r) * q) + off;
  }
  const int nig = 8 * nN, gid = wgid / nig, fm = gid * 8, gsz = min(nM - fm, 8);
  pm = fm + ((wgid % nig) % gsz);
  pn = (wgid % nig) / gsz;
}

DI void prep_mod_item(const Params& p, u16* smem_u, int it) {
  const int TIDX = tid_opaque();
  float* sm = (float*)smem_u;
  float* red = sm + 5 * 2048;
  const int tid = TIDX;
  const int l = it / 384, n0 = (it % 384) * 32;
  for (int e = tid; e < 5 * 2048; e += NTHR) {
    const int j = e >> 11, k = e & 2047;
    const float v = j == 0 ? p.c_ctx[k] : p.c[(j - 1) * DM + k];
    sm[e] = v / (1.f + __expf(-v));
  }
  __syncthreads();
  const int cgp = tid & 7, kg = tid >> 3;
  float acc[5][4];
#pragma unroll
  for (int j = 0; j < 5; ++j)
#pragma unroll
    for (int q = 0; q < 4; ++q) acc[j][q] = 0.f;
  const float* wp = p.w_mod + (size_t)l * DM * (6 * DM) + (size_t)(kg * 32) * (6 * DM) + n0 + cgp * 4;
#pragma unroll 1
  for (int k0 = 0; k0 < 32; k0 += 16) {
    float4 w[16];
#pragma unroll
    for (int k = 0; k < 16; ++k) { const f32x4 t_ = __builtin_nontemporal_load((const f32x4*)(wp + (size_t)(k0 + k) * (6 * DM))); w[k] = make_float4(t_[0], t_[1], t_[2], t_[3]); }
#pragma unroll
    for (int k = 0; k < 16; ++k)
#pragma unroll
      for (int j = 0; j < 5; ++j) {
        const float s = sm[j * 2048 + kg * 32 + k0 + k];
        acc[j][0] += s * w[k].x; acc[j][1] += s * w[k].y; acc[j][2] += s * w[k].z; acc[j][3] += s * w[k].w;
      }
  }
#pragma unroll
  for (int j = 0; j < 5; ++j)
#pragma unroll
    for (int q = 0; q < 4; ++q) red[(kg * 8 + cgp) * 20 + j * 4 + q] = acc[j][q];
  __syncthreads();
  if (tid < 160) {
    const int j = tid >> 5, n = tid & 31;
    float s = p.b_mod[l * (6 * DM) + n0 + n];
#pragma unroll 8
    for (int g = 0; g < 64; ++g) s += red[(g * 8 + (n >> 2)) * 20 + j * 4 + (n & 3)];
    p.mod[((size_t)l * 5 + j) * (6 * DM) + n0 + n] = s;
  }
}

struct TrDesc { const float* src; u16* dst; int K, N, k0, n0; };
DI void transpose_load(const TrDesc& d, int tid, float4 (&v)[8]) {
  const int r = tid >> 4, c4 = tid & 15;
#pragma unroll
  for (int ps = 0; ps < 8; ++ps) {
    const f32x4 t_ = __builtin_nontemporal_load((const f32x4*)(d.src + (size_t)(d.k0 + r + 16 * ps) * d.N + d.n0 + c4 * 4));
    v[ps] = make_float4(t_[0], t_[1], t_[2], t_[3]);
  }
}
DI void transpose_finish(u16* smem_u, const TrDesc& d, int tid, const float4 (&v)[8]) {
  float* tile = (float*)smem_u;
  const int r = tid >> 4, c4 = tid & 15;
#pragma unroll
  for (int ps = 0; ps < 8; ++ps) {
    const int k = r + 16 * ps;
    tile[k * 65 + c4 * 4 + 0] = v[ps].x; tile[k * 65 + c4 * 4 + 1] = v[ps].y;
    tile[k * 65 + c4 * 4 + 2] = v[ps].z; tile[k * 65 + c4 * 4 + 3] = v[ps].w;
  }
  __syncthreads();
  const int n = tid >> 2, kq = tid & 3;
  unsigned w[16];
#pragma unroll
  for (int i = 0; i < 16; ++i) w[i] = pack2(tile[(kq * 32 + 2 * i) * 65 + n], tile[(kq * 32 + 2 * i + 1) * 65 + n]);
  uint4* o = (uint4*)(d.dst + (size_t)(d.n0 + n) * d.K + d.k0 + kq * 32);
  o[0] = make_uint4(w[0], w[1], w[2], w[3]);
  o[1] = make_uint4(w[4], w[5], w[6], w[7]);
  o[2] = make_uint4(w[8], w[9], w[10], w[11]);
  o[3] = make_uint4(w[12], w[13], w[14], w[15]);
}

DI void phase_prep(const Params& p, u16* smem_all) {
  const int TIDX = tid_opaque();
  constexpr int N_MOD = 768;
  constexpr int T_IN = 16 * 53, T_QUP = 3 * 12, T_KVUP = 1 * 16, T_OUT = 16 * 32, T_G = 16 * 88, T_D = 44 * 32;
  constexpr int T_LAYER = T_IN + T_QUP + T_KVUP + T_OUT + 2 * T_G + T_D;
  constexpr int N_TR = 2 * T_LAYER;
  constexpr int N_TRIG = 2088 + 192;
  const int total = N_MOD + N_TR + N_TRIG;
  const int half = TIDX >> 8, tid = TIDX & 255;
  u16* smem = smem_all + half * 32768;
  if (blockIdx.x == 0 && TIDX < 32) p.ctr[TIDX] = 0;
  if (blockIdx.x == 0) p.flags[TIDX] = 0u;
  for (int it = blockIdx.x; it < N_MOD; it += gridDim.x) {
    __syncthreads();
    prep_mod_item(p, smem_all, it);
  }
  {
    auto decode = [&](int t) {
      TrDesc d;
      const int l = t / T_LAYER;
      t -= l * T_LAYER;
      if (t < T_IN) { d.src = p.w_in + (size_t)l * DM * INC; d.dst = p.WinT + (size_t)l * RLD * DM; d.K = DM; d.N = INC; }
      else if ((t -= T_IN) < T_QUP) { d.src = p.w_q_up + (size_t)l * 384 * 768; d.dst = p.WqupT + (size_t)l * 768 * 384; d.K = 384; d.N = 768; }
      else if ((t -= T_QUP) < T_KVUP) { d.src = p.w_kv_up + (size_t)l * 128 * 1024; d.dst = p.WkvupT + (size_t)l * 1024 * 128; d.K = 128; d.N = 1024; }
      else if ((t -= T_KVUP) < T_OUT) { d.src = p.w_out + (size_t)l * DM * DM; d.dst = p.WoutT + (size_t)l * DM * DM; d.K = DM; d.N = DM; }
      else if ((t -= T_OUT) < T_G) { d.src = p.w_gate + (size_t)l * DM * DFF; d.dst = p.WgateT + (size_t)l * DFF * DM; d.K = DM; d.N = DFF; }
      else if ((t -= T_G) < T_G) { d.src = p.w_up + (size_t)l * DM * DFF; d.dst = p.WupT + (size_t)l * DFF * DM; d.K = DM; d.N = DFF; }
      else { t -= T_G; d.src = p.w_down + (size_t)l * DFF * DM; d.dst = p.WdownT + (size_t)l * DM * DFF; d.K = DFF; d.N = DM; }
      const int tilesN = d.N >> 6;
      const int tk = t / tilesN, tn = t - tk * tilesN;
      d.k0 = tk * 128;
      d.n0 = tn * 64;
      return d;
    };
    int t = blockIdx.x * 2 + half;
    const int tstep = gridDim.x * 2;
    float4 va[8], vb[8];
    TrDesc da, db;
    if (t < N_TR) { da = decode(t); transpose_load(da, tid, va); }
#pragma unroll 1
    for (; t < N_TR; t += 2 * tstep) {
      const bool hb = t + tstep < N_TR;
      if (hb) { db = decode(t + tstep); transpose_load(db, tid, vb); }
      __syncthreads();
      transpose_finish(smem, da, tid, va);
      if (hb) {
        const bool ha = t + 2 * tstep < N_TR;
        if (ha) { da = decode(t + 2 * tstep); transpose_load(da, tid, va); }
        __syncthreads();
        transpose_finish(smem, db, tid, vb);
      }
    }
  }
  for (int it = N_MOD + N_TR + blockIdx.x * 2 + half; it < total; it += gridDim.x * 2) {
    {
      const int t = it - N_MOD - N_TR;
#pragma unroll 1
      for (int q = 0; q < 16; ++q) {
        int e = t * 4096 + q * 256 + tid;
        if (e < 32768) {
          const int j = e >> 7, c = e & 127;
          const int jj = j & 127;
          const float x = (float)((jj * c) & 127) * (1.f / 64.f);
          float sn, cs;
          sincospif(x, &sn, &cs);
          p.trig128[e] = f2bf(j < 128 ? cs : sn);
        } else if ((e -= 32768) < 131072) {
          const int k = e >> 9, s2 = e & 511, s = s2 & 255;
          const float x = (float)((k * s) & 255) * (1.f / 128.f);
          float sn, cs;
          sincospif(x, &sn, &cs);
          p.W256[e] = f2bf(s2 < 256 ? cs : -sn);
        } else if ((e -= 131072) < 8388608) {
          const int k = e >> 12, s2 = e & 4095, s = s2 & 2047;
          const float x = (float)((k * s) & 2047) * (1.f / 1024.f);
          float sn, cs;
          sincospif(x, &sn, &cs);
          p.W2048[e] = f2bf(s2 < 2048 ? cs : -sn);
        } else {
          e -= 8388608;
          const int l = e / (192 * 2048), r = e - l * (192 * 2048);
          p.WinT[(size_t)l * RLD * DM + (size_t)INC * DM + r] = 0;
        }
      }
    }
  }
}

DI void load_row32(const float* xf, const u16* xb, int lane, float4 (&v)[8]) {
  if (xb) {
#pragma unroll
    for (int i = 0; i < 4; ++i) {
      const uint4 r = *(const uint4*)(xb + i * 512 + lane * 8);
      v[2 * i] = make_float4(bf2f((u16)(r.x & 0xffff)), bf2f((u16)(r.x >> 16)), bf2f((u16)(r.y & 0xffff)), bf2f((u16)(r.y >> 16)));
      v[2 * i + 1] = make_float4(bf2f((u16)(r.z & 0xffff)), bf2f((u16)(r.z >> 16)), bf2f((u16)(r.w & 0xffff)), bf2f((u16)(r.w >> 16)));
    }
  } else {
#pragma unroll
    for (int i = 0; i < 4; ++i) {
      v[2 * i] = *(const float4*)(xf + i * 512 + lane * 8);
      v[2 * i + 1] = *(const float4*)(xf + i * 512 + lane * 8 + 4);
    }
  }
}
DI void phase_modulate(const Params& p, int l, int which) {
  const int TIDX = tid_opaque();
  const int lane = TIDX & 63, wid = TIDX >> 6;
  const float* gain = (which ? p.g_ffn : p.g_mix) + l * DM;
  const u16* xbsrc = which ? p.x1b : (l == 0 ? nullptr : p.x2b);
  for (int it = blockIdx.x; it < NT / 16; it += gridDim.x) {
    const int row0 = it * 16 + wid * 2;
    float4 va[8], vb[8];
    load_row32(xbsrc ? nullptr : xin_row(p, 0, row0), xbsrc ? xbsrc + (size_t)row0 * DM : nullptr, lane, va);
    load_row32(xbsrc ? nullptr : xin_row(p, 0, row0 + 1), xbsrc ? xbsrc + (size_t)(row0 + 1) * DM : nullptr, lane, vb);
    float sa = 0.f, sb = 0.f;
#pragma unroll
    for (int i = 0; i < 8; ++i) {
      sa += va[i].x * va[i].x + va[i].y * va[i].y + va[i].z * va[i].z + va[i].w * va[i].w;
      sb += vb[i].x * vb[i].x + vb[i].y * vb[i].y + vb[i].z * vb[i].z + vb[i].w * vb[i].w;
    }
    sa = wave_sum(sa);
    sb = wave_sum(sb);
    const float ra = rsqrtf(sa * (1.f / DM) + EPSV), rb = rsqrtf(sb * (1.f / DM) + EPSV);
    const float* md = p.mod + ((size_t)l * 5 + mod_index(row0)) * (6 * DM);
    const float* sh = md + (which ? 3 : 0) * DM;
    const float* sc = md + (which ? 4 : 1) * DM;
#pragma unroll
    for (int i = 0; i < 4; ++i) {
      const int c = i * 512 + lane * 8;
      uint4 oa, ob;
#pragma unroll
      for (int hf = 0; hf < 2; ++hf) {
        const int cc = c + hf * 4;
        const float4 g = *(const float4*)(gain + cc), s1 = *(const float4*)(sc + cc), s0 = *(const float4*)(sh + cc);
        const float gx = g.x * (1.f + s1.x), gy = g.y * (1.f + s1.y), gz = g.z * (1.f + s1.z), gw = g.w * (1.f + s1.w);
        const float4 a = va[2 * i + hf], b = vb[2 * i + hf];
        const unsigned a0 = pack2(a.x * ra * gx + s0.x, a.y * ra * gy + s0.y), a1 = pack2(a.z * ra * gz + s0.z, a.w * ra * gw + s0.w);
        const unsigned b0 = pack2(b.x * rb * gx + s0.x, b.y * rb * gy + s0.y), b1 = pack2(b.z * rb * gz + s0.z, b.w * rb * gw + s0.w);
        if (hf == 0) { oa.x = a0; oa.y = a1; ob.x = b0; ob.y = b1; } else { oa.z = a0; oa.w = a1; ob.z = b0; ob.w = b1; }
      }
      *(uint4*)(p.h + (size_t)row0 * DM + c) = oa;
      *(uint4*)(p.h + (size_t)(row0 + 1) * DM + c) = ob;
    }
  }
}

DI void phase_qkv(const Params& p, u16* smem, int l) {
  const u16* W = p.WinT + (size_t)l * RLD * DM;
#pragma unroll 1
  for (int it = blockIdx.x; it < 48 * 14; it += gridDim.x) {
    __syncthreads();
    int pm, pn;
    tile256_decode(it, 48, 14, pm, pn);
    gemm256_tile(smem, p.h, W, DM, DM, pm * 256, pn * 256, EpiBf16{p.raw, RLD, 1.f});
  }
}

DI float rope_apply(float y, float sn, float cs, int lane) {
  const float pr = __shfl_xor(y, 16);
  return (lane & 16) ? (pr * sn + y * cs) : (y * cs - pr * sn);
}
DI void rope_trig(int lane, int pos_row, int pos_col, float& sn, float& cs) {
  const int i = lane & 15;
  const float inv = exp2f(-(float)i * (13.287712379549449f / 16.f));
  const float ang = (float)((lane < 32) ? pos_row : pos_col) * inv;
  sincosf(ang, &sn, &cs);
}

DI void phase_post1(const Params& p, u16* smem, int l) {
  const int TIDX = tid_opaque();
  const int lane = TIDX & 63, wid = TIDX >> 6;
  float* o_nak = p.out + 25165824;
  float* o_nav = o_nak + 4194304;
  float* o_ckv = o_nav + 4194304;
  float* o_kr = o_ckv + 1048576;
  float* o_wk = o_kr + 524288;
  float* o_wv = o_wk + 1048576;
  for (int it = blockIdx.x; it < NTA / 8; it += gridDim.x) {
    const int tok = it * 8 + wid;
    if (tok < NT) {
      const u16* rp = p.raw + (size_t)tok * RLD + lane;
      u16 r[45];
#pragma unroll
      for (int i = 0; i < 45; ++i) r[i] = rp[i * 64];
      asm volatile("" ::: "memory");
      const bool ctx = tok < NTC;
      size_t ob = 0;
      float sn = 0.f, cs = 1.f;
      if (ctx) {
        const int b = tok >> 8, s = tok & 255;
        ob = (size_t)(b * 2 + l) * 256 + s;
      } else {
        const int pos = (tok - NTC) & 2047;
        rope_trig(lane, pos >> 6, pos & 63, sn, cs);
      }
      const float gq = p.g_qn_na[l * 64 + lane], gk = p.g_kn_na[l * 64 + lane];
#pragma unroll
      for (int h = 0; h < 8; ++h) {
        float v = bf2f(r[h]);
        float ss = wave_sum(v * v);
        p.Qa[(size_t)tok * 512 + h * 64 + lane] = f2bf(v * rsqrtf(ss * (1.f / 64.f) + EPSV) * gq * (0.125f * LOG2E));
        v = bf2f(r[8 + h]);
        ss = wave_sum(v * v);
        const float y = v * rsqrtf(ss * (1.f / 64.f) + EPSV) * gk;
        p.Ka[(size_t)tok * 512 + h * 64 + lane] = f2bf(y);
        if (ctx) {
          o_nak[(ob * 8 + h) * 64 + lane] = y;
          o_nav[(ob * 8 + h) * 64 + lane] = bf2f(r[16 + h]);
        }
      }
      {
        float v[6], ss = 0.f;
#pragma unroll
        for (int i = 0; i < 6; ++i) { v[i] = bf2f(r[24 + i]); ss += v[i] * v[i]; }
        ss = wave_sum(ss);
        const float rs = rsqrtf(ss * (1.f / 384.f) + EPSV);
#pragma unroll
        for (int i = 0; i < 6; ++i) p.cq[(size_t)tok * 384 + i * 64 + lane] = f2bf(v[i] * rs * p.g_q_lora[l * 384 + i * 64 + lane]);
      }
      {
        const float v0 = bf2f(r[30]), v1 = bf2f(r[31]);
        const float ss = wave_sum(v0 * v0 + v1 * v1);
        const float rs = rsqrtf(ss * (1.f / 128.f) + EPSV);
        const float y0 = v0 * rs * p.g_kv_lora[l * 128 + lane], y1 = v1 * rs * p.g_kv_lora[l * 128 + 64 + lane];
        p.ckv[(size_t)tok * 128 + lane] = f2bf(y0);
        p.ckv[(size_t)tok * 128 + 64 + lane] = f2bf(y1);
        if (ctx) { o_ckv[ob * 128 + lane] = y0; o_ckv[ob * 128 + 64 + lane] = y1; }
      }
      {
        p.krope[(size_t)tok * 64 + lane] = r[32];
        if (ctx) o_kr[ob * 64 + lane] = bf2f(r[32]);
      }
      const float gqw = p.g_qn_win[l * 64 + lane], gkw = p.g_kn_win[l * 64 + lane];
#pragma unroll
      for (int hq = 0; hq < 8; ++hq) {
        const float v = bf2f(r[33 + hq]);
        const float ss = wave_sum(v * v);
        float y = v * rsqrtf(ss * (1.f / 64.f) + EPSV) * gqw;
        if (!ctx) y = rope_apply(y, sn, cs, lane);
        p.Qw[(size_t)tok * 512 + hq * 64 + lane] = f2bf(y * (0.125f * LOG2E));
      }
#pragma unroll
      for (int kh = 0; kh < 2; ++kh) {
        const float v = bf2f(r[41 + kh]);
        const float ss = wave_sum(v * v);
        float y = v * rsqrtf(ss * (1.f / 64.f) + EPSV) * gkw;
        if (ctx) {
          o_wk[(ob * 2 + kh) * 64 + lane] = y;
          o_wv[(ob * 2 + kh) * 64 + lane] = bf2f(r[43 + kh]);
        } else {
          y = rope_apply(y, sn, cs, lane);
        }
        p.Kw[(size_t)tok * 128 + kh * 64 + lane] = f2bf(y);
      }
    } else {
      const int cr = tok - NT, b = cr >> 9, key = cr & 511;
      const size_t cb = (size_t)(b * 2 + l) * 512 + key;
      const int tokp = (tok & ~12) | ((tok & 4) << 1) | ((tok & 8) >> 1);
      float ck[8], cv[8], c0, c1, c2, wk[2], wv[2];
#pragma unroll
      for (int h = 0; h < 8; ++h) {
        ck[h] = p.cache_na_k[(cb * 8 + h) * 64 + lane];
        cv[h] = p.cache_na_v[(cb * 8 + h) * 64 + lane];
      }
      c0 = p.cache_mla_ckv[cb * 128 + lane];
      c1 = p.cache_mla_ckv[cb * 128 + 64 + lane];
      c2 = p.cache_mla_krope[cb * 64 + lane];
#pragma unroll
      for (int kh = 0; kh < 2; ++kh) {
        wk[kh] = p.cache_win_k[(cb * 2 + kh) * 64 + lane];
        wv[kh] = p.cache_win_v[(cb * 2 + kh) * 64 + lane];
      }
      asm volatile("" ::: "memory");
#pragma unroll
      for (int h = 0; h < 8; ++h) {
        p.Ka[(size_t)tok * 512 + h * 64 + lane] = f2bf(ck[h]);
        p.VaT[(size_t)(h * 64 + lane) * NTA + tokp] = f2bf(cv[h]);
      }
      p.ckv[(size_t)tok * 128 + lane] = f2bf(c0);
      p.ckv[(size_t)tok * 128 + 64 + lane] = f2bf(c1);
      p.krope[(size_t)tok * 64 + lane] = f2bf(c2);
#pragma unroll
      for (int kh = 0; kh < 2; ++kh) {
        p.Kw[(size_t)tok * 128 + kh * 64 + lane] = f2bf(wk[kh]);
        p.VwT[(size_t)(kh * 64 + lane) * NTA + tokp] = f2bf(wv[kh]);
      }
    }
  }
  for (int it = blockIdx.x; it < NT / 64; it += gridDim.x) {
    __syncthreads();
    const int tok0 = it * 64;
    for (int e = TIDX; e < 64 * 80; e += NTHR) {
      const int row = e / 80, ch = e - row * 80;
      const int col = ch < 64 ? C_AV + ch * 8 : C_CV + (ch - 64) * 8;
      const uint4 v = *(const uint4*)(p.raw + (size_t)(tok0 + row) * RLD + col);
      *(uint4*)(smem + row * 648 + ch * 8) = v;
    }
    __syncthreads();
    for (int e = TIDX; e < 640 * 4; e += NTHR) {
      const int vc = e >> 2, tg = e & 3;
      u16 t[16];
#pragma unroll
      for (int i = 0; i < 16; ++i) t[i] = smem[(tg * 16 + i) * 648 + vc];
      uint4 a, b;
      a.x = t[0] | ((unsigned)t[1] << 16); a.y = t[2] | ((unsigned)t[3] << 16);
      a.z = t[8] | ((unsigned)t[9] << 16); a.w = t[10] | ((unsigned)t[11] << 16);
      b.x = t[4] | ((unsigned)t[5] << 16); b.y = t[6] | ((unsigned)t[7] << 16);
      b.z = t[12] | ((unsigned)t[13] << 16); b.w = t[14] | ((unsigned)t[15] << 16);
      u16* d = (vc < 512 ? p.VaT + (size_t)vc * NTA : p.VwT + (size_t)(vc - 512) * NTA) + tok0 + tg * 16;
      *(uint4*)d = a;
      *(uint4*)(d + 8) = b;
    }
  }
}

DI void phase_up(const Params& p, u16* smem, int l) {
  constexpr int T1 = 96 * 6, T2 = 112 * 4, T3 = 4 * 112, T4 = 256, T5 = 512;
  const u16* Wq = p.WqupT + (size_t)l * 768 * 384;
  const u16* Wkv = p.WkvupT + (size_t)l * 1024 * 128;
  for (int it = blockIdx.x; it < T1 + T2 + T3 + T4 + T5; it += gridDim.x) {
    __syncthreads();
    int t = it;
    if (t < T1) {
      const int tm = t / 6, tn = t - tm * 6;
      gemm_tile(smem, p.cq, 384, Wq, 384, 384, tm * 128, tn * 128, 768, EpiBf16{p.qmraw, 768, 1.f});
    } else if ((t -= T1) < T2) {
      const int tm = t >> 2, hd = t & 3;
      gemm_tile(smem, p.ckv, 128, Wkv, 128, 128, tm * 128, hd * 256, 1024, EpiBf16{p.kvraw, 1024, 1.f});
    } else if ((t -= T2) < T3) {
      const int hd = t & 3, tn = t >> 2;
      gemm_tile(smem, Wkv + (size_t)(hd * 256 + 128) * 128, 128, p.ckv, 128, 128, 0, tn * 128, NTA,
                EpiBf16P{p.VmT + (size_t)hd * 128 * NTA, NTA});
    } else if ((t -= T3) < T4) {
      const int tn = t & 1, pr = t >> 1, csn = pr & 1, bg = pr >> 1, b = bg >> 2, g = bg & 3;
      gemm_tile(smem, p.trig128 + csn * 128 * 128, 128, p.raw + (size_t)(b * 256) * RLD + C_FV + g * 128, RLD, 128, 0,
                tn * 128, 256, EpiBf16{p.ZtC + (size_t)bg * 128 * 512 + csn * 256, 512, 1.f});
    } else {
      t -= T4;
      const int tn = t & 15, pr = t >> 4, csn = pr & 1, bg = pr >> 1, b = bg >> 2, g = bg & 3;
      gemm_tile(smem, p.trig128 + csn * 128 * 128, 128, p.raw + (size_t)(NTC + b * 2048) * RLD + C_FV + g * 128, RLD, 128,
                0, tn * 128, 2048, EpiBf16{p.ZtL + (size_t)bg * 128 * 4096 + csn * 2048, 4096, 1.f});
    }
  }
}

DI void phase_post2(const Params& p, int l) {
  const int TIDX = tid_opaque();
  const int lane = TIDX & 63, wid = TIDX >> 6;
  const float SCM = 0.07216878364870322f * LOG2E;
  const float gq0 = p.g_qn_mla[l * 192 + lane], gq1 = p.g_qn_mla[l * 192 + 64 + lane], gq2 = p.g_qn_mla[l * 192 + 128 + lane];
  const float gk0 = p.g_kn_mla[l * 192 + lane], gk1 = p.g_kn_mla[l * 192 + 64 + lane], gk2 = p.g_kn_mla[l * 192 + 128 + lane];
  for (int it = blockIdx.x; it < NTA / 8; it += gridDim.x) {
    const int tok = it * 8 + wid;
    const bool lat = tok >= NTC && tok < NT;
    const bool hasq = tok < NT;
    u16 qv[12], kv[8], kr;
    {
      const u16* qp = p.qmraw + (size_t)(hasq ? tok : 0) * 768 + lane;
#pragma unroll
      for (int i = 0; i < 12; ++i) qv[i] = qp[i * 64];
      const u16* kp = p.kvraw + (size_t)tok * 1024 + lane;
#pragma unroll
      for (int h = 0; h < 4; ++h) { kv[2 * h] = kp[h * 256]; kv[2 * h + 1] = kp[h * 256 + 64]; }
      kr = p.krope[(size_t)tok * 64 + lane];
    }
    asm volatile("" ::: "memory");
    float sn = 0.f, cs = 1.f;
    if (lat) {
      const int pos = (tok - NTC) & 2047;
      rope_trig(lane, pos >> 6, pos & 63, sn, cs);
    }
    if (hasq) {
#pragma unroll
      for (int h = 0; h < 4; ++h) {
        const float v0 = bf2f(qv[3 * h]), v1 = bf2f(qv[3 * h + 1]), v2 = bf2f(qv[3 * h + 2]);
        const float ss = wave_sum(v0 * v0 + v1 * v1 + v2 * v2);
        const float rs = rsqrtf(ss * (1.f / 192.f) + EPSV);
        float y2 = v2 * rs * gq2;
        if (lat) y2 = rope_apply(y2, sn, cs, lane);
        u16* q = p.Qm + (size_t)tok * 768 + h * 192;
        q[lane] = f2bf(v0 * rs * gq0 * SCM);
        q[64 + lane] = f2bf(v1 * rs * gq1 * SCM);
        q[128 + lane] = f2bf(y2 * SCM);
      }
    }
    {
      const float v2 = bf2f(kr);
#pragma unroll
      for (int h = 0; h < 4; ++h) {
        const float v0 = bf2f(kv[2 * h]), v1 = bf2f(kv[2 * h + 1]);
        const float ss = wave_sum(v0 * v0 + v1 * v1 + v2 * v2);
        const float rs = rsqrtf(ss * (1.f / 192.f) + EPSV);
        float y2 = v2 * rs * gk2;
        if (lat) y2 = rope_apply(y2, sn, cs, lane);
        u16* k = p.Km + (size_t)tok * 768 + h * 192;
        k[lane] = f2bf(v0 * rs * gk0);
        k[64 + lane] = f2bf(v1 * rs * gk1);
        k[128 + lane] = f2bf(y2);
      }
    }
  }
}

DI void attn_mla_block(u16* smem, const u16* __restrict__ Qp, const u16* __restrict__ Kh, const u16* __restrict__ Vh,
                       u16* __restrict__ Op, int lk0, int nl, int ck0, int nc) {
  const int TIDX = tid_opaque();
  const int lane = TIDX & 63, qi = lane & 31, hh = lane >> 5;
  char* lds = (char*)smem;
  unsigned ko0, ko1, ko2, vo0, vo1;
  {
    int L = TIDX * 16, row = L / 384, pc = (L % 384) >> 4;
    ko0 = (unsigned)(row * 768 + ((pc & ~7) | ((pc & 7) ^ ((row >> 1) & 7))) * 8) * 2u;
    L += 8192; row = L / 384; pc = (L % 384) >> 4;
    ko1 = (unsigned)(row * 768 + ((pc & ~7) | ((pc & 7) ^ ((row >> 1) & 7))) * 8) * 2u;
    L += 8192; row = L / 384; pc = (L % 384) >> 4;
    ko2 = (unsigned)(row * 768 + ((pc & ~7) | ((pc & 7) ^ ((row >> 1) & 7))) * 8) * 2u;
    L = TIDX * 16; row = L >> 7; pc = (L & 127) >> 4;
    vo0 = (unsigned)(row * NTA + (pc ^ ((row >> 1) & 7)) * 8) * 2u;
    L += 8192; row = L >> 7; pc = (L & 127) >> 4;
    vo1 = (unsigned)(row * NTA + (pc ^ ((row >> 1) & 7)) * 8) * 2u;
  }
  const int xk = (qi >> 1) & 7;
  int kx[4], vx[4];
#pragma unroll
  for (int q = 0; q < 4; ++q) {
    kx[q] = qi * 384 + (((q * 2 + hh) ^ xk) << 4);
    vx[q] = qi * 128 + (((q * 2 + hh) ^ xk) << 4);
  }
  bf16x8 qf[12];
#pragma unroll
  for (int kk = 0; kk < 12; ++kk) qf[kk] = *(const bf16x8*)(Qp + (size_t)qi * 768 + kk * 16 + hh * 8);
  f32x16 o[4];
#pragma unroll
  for (int mt = 0; mt < 4; ++mt)
#pragma unroll
    for (int i = 0; i < 16; ++i) o[mt][i] = 0.f;
  float m = -1e30f, lsum = 0.f;
  const int nt = nl + nc;
#define MLA_LDS(p_) ((__attribute__((address_space(3))) unsigned*)(p_))
#define MLA_ISSUE(j_, st_)                                                                        \
  do {                                                                                            \
    const int kt_ = (j_) < nl ? lk0 + (j_) * 64 : ck0 + ((j_) - nl) * 64;                         \
    const char* kb_ = (const char*)(Kh + (size_t)kt_ * 768);                                      \
    const char* vb_ = (const char*)(Vh + kt_);                                                    \
    char* d_ = lds + (st_) * 40960 + TIDX * 16;                                                   \
    __builtin_amdgcn_global_load_lds((const unsigned*)(kb_ + ko0), MLA_LDS(d_), 16, 0, 0);        \
    __builtin_amdgcn_global_load_lds((const unsigned*)(kb_ + ko1), MLA_LDS(d_ + 8192), 16, 0, 0); \
    __builtin_amdgcn_global_load_lds((const unsigned*)(kb_ + ko2), MLA_LDS(d_ + 16384), 16, 0, 0); \
    __builtin_amdgcn_global_load_lds((const unsigned*)(vb_ + vo0), MLA_LDS(d_ + 24576), 16, 0, 0); \
    __builtin_amdgcn_global_load_lds((const unsigned*)(vb_ + vo1), MLA_LDS(d_ + 32768), 16, 0, 0); \
  } while (0)
#define MLA_BAR                                \
  do {                                         \
    asm volatile("" ::: "memory");             \
    __builtin_amdgcn_s_barrier();              \
    asm volatile("" ::: "memory");             \
  } while (0)
  MLA_ISSUE(0, 0);
  if (nt > 1) MLA_ISSUE(1, 1);
  int st = 0, stn = 2;
#pragma unroll 1
  for (int j = 0; j < nt; ++j) {
    if (j + 1 < nt) {
      asm volatile("s_waitcnt vmcnt(5)" ::: "memory");
    } else {
      asm volatile("s_waitcnt vmcnt(0)" ::: "memory");
    }
    MLA_BAR;
    if (j + 2 < nt) MLA_ISSUE(j + 2, stn);
    const char* ks = lds + st * 40960;
    const char* vs = ks + 24576;
    f32x16 s0, s1;
#pragma unroll
    for (int i = 0; i < 16; ++i) { s0[i] = 0.f; s1[i] = 0.f; }
#pragma unroll
    for (int kk = 0; kk < 12; ++kk) {
      const int off = (kk >> 2) * 128 + kx[kk & 3];
      const bf16x8 k0 = *(const bf16x8*)(ks + off);
      const bf16x8 k1 = *(const bf16x8*)(ks + 12288 + off);
      s0 = __builtin_amdgcn_mfma_f32_32x32x16_bf16(k0, qf[kk], s0, 0, 0, 0);
      s1 = __builtin_amdgcn_mfma_f32_32x32x16_bf16(k1, qf[kk], s1, 0, 0, 0);
    }
    float mx = fmaxf(s0[0], s1[0]);
#pragma unroll
    for (int i = 1; i < 16; ++i) mx = fmaxf(mx, fmaxf(s0[i], s1[i]));
    mx = fmaxf(mx, __shfl_xor(mx, 32));
    const float mn = fmaxf(m, mx);
    const float alpha = __builtin_amdgcn_exp2f(m - mn);
    m = mn;
    float rs = 0.f;
#pragma unroll
    for (int i = 0; i < 16; ++i) {
      s0[i] = __builtin_amdgcn_exp2f(s0[i] - mn);
      s1[i] = __builtin_amdgcn_exp2f(s1[i] - mn);
      rs += s0[i] + s1[i];
    }
    rs += __shfl_xor(rs, 32);
    lsum = lsum * alpha + rs;
    if (__builtin_amdgcn_ballot_w64(alpha != 1.f) != 0ull) {
#pragma unroll
      for (int mt = 0; mt < 4; ++mt)
#pragma unroll
        for (int i = 0; i < 16; ++i) o[mt][i] *= alpha;
    }
    union { bf16x8 v; unsigned u[4]; } pf[4];
#pragma unroll
    for (int q = 0; q < 4; ++q) {
      pf[0].u[q] = pack2(s0[2 * q], s0[2 * q + 1]);
      pf[1].u[q] = pack2(s0[8 + 2 * q], s0[8 + 2 * q + 1]);
      pf[2].u[q] = pack2(s1[2 * q], s1[2 * q + 1]);
      pf[3].u[q] = pack2(s1[8 + 2 * q], s1[8 + 2 * q + 1]);
    }
#pragma unroll
    for (int mt = 0; mt < 4; ++mt)
#pragma unroll
      for (int q = 0; q < 4; ++q) {
        const bf16x8 vfr = *(const bf16x8*)(vs + mt * 4096 + vx[q]);
        o[mt] = __builtin_amdgcn_mfma_f32_32x32x16_bf16(vfr, pf[q].v, o[mt], 0, 0, 0);
      }
    st = st == 2 ? 0 : st + 1;
    stn = stn == 2 ? 0 : stn + 1;
  }
#undef MLA_ISSUE
#undef MLA_BAR
#undef MLA_LDS
  const float inv = 1.f / lsum;
#pragma unroll
  for (int mt = 0; mt < 4; ++mt)
#pragma unroll
    for (int g = 0; g < 4; ++g) {
      uint2 r;
      r.x = pack2(o[mt][4 * g] * inv, o[mt][4 * g + 1] * inv);
      r.y = pack2(o[mt][4 * g + 2] * inv, o[mt][4 * g + 3] * inv);
      *(uint2*)(Op + (size_t)qi * DM + mt * 32 + 8 * g + 4 * hh) = r;
    }
}

DI void attn64_block(u16* smem, const u16* __restrict__ Qp, const u16* __restrict__ Kh, int ldk, const u16* __restrict__ Vh,
                     u16* __restrict__ Op, int lk0, int nl, int ck0, int nc, int mode, int qpos0, int seq0, int jlo, int jhi,
                     const float* rpb, float sink2, bool has_sink) {
  const int TIDX = tid_opaque();
  const int lane = TIDX & 63, qi = lane & 31, hh = lane >> 5;
  char* lds = (char*)smem;
  unsigned ko, vo;
  {
    const int L = TIDX * 16, row = L >> 7, pc = (L & 127) >> 4, c = pc ^ ((row >> 1) & 7);
    ko = (unsigned)(row * ldk + c * 8) * 2u;
    vo = (unsigned)(row * NTA + c * 8) * 2u;
  }
  const int xk = (qi >> 1) & 7;
  int kx[4];
#pragma unroll
  for (int q = 0; q < 4; ++q) kx[q] = qi * 128 + (((q * 2 + hh) ^ xk) << 4);
  bf16x8 qf[4];
#pragma unroll
  for (int kk = 0; kk < 4; ++kk) qf[kk] = *(const bf16x8*)(Qp + (size_t)qi * 512 + kk * 16 + hh * 8);
  f32x16 o[2];
#pragma unroll
  for (int mt = 0; mt < 2; ++mt)
#pragma unroll
    for (int i = 0; i < 16; ++i) o[mt][i] = 0.f;
  float m = -1e30f, lsum = 0.f;
  const int qp = qpos0 + qi, qr = qp >> 6, qc = qp & 63;
  const int cs = min(max(qc - 8, 0), 48);
  const float NINF = -__builtin_inff();
  const int nt = nl + nc;
#define A64_LDS(p_) ((__attribute__((address_space(3))) unsigned*)(p_))
#define A64_ISSUE(j_, st_)                                                                    \
  do {                                                                                        \
    const int kt_ = (j_) < nl ? lk0 + (j_) * 64 : ck0 + ((j_) - nl) * 64;                     \
    const char* kb_ = (const char*)(Kh + (size_t)kt_ * ldk);                                  \
    const char* vb_ = (const char*)(Vh + kt_);                                                \
    char* d_ = lds + (st_) * 16384 + TIDX * 16;                                               \
    __builtin_amdgcn_global_load_lds((const unsigned*)(kb_ + ko), A64_LDS(d_), 16, 0, 0);     \
    __builtin_amdgcn_global_load_lds((const unsigned*)(vb_ + vo), A64_LDS(d_ + 8192), 16, 0, 0); \
  } while (0)
#define A64_BAR                                \
  do {                                         \
    asm volatile("" ::: "memory");             \
    __builtin_amdgcn_s_barrier();              \
    asm volatile("" ::: "memory");             \
  } while (0)
  A64_ISSUE(0, 0);
  if (nt > 1) A64_ISSUE(1, 1);
  if (nt > 2) A64_ISSUE(2, 2);
#pragma unroll 1
  for (int j = 0; j < nt; ++j) {
    const int st = j & 3;
    if (j + 2 < nt) {
      asm volatile("s_waitcnt vmcnt(4)" ::: "memory");
    } else if (j + 1 < nt) {
      asm volatile("s_waitcnt vmcnt(2)" ::: "memory");
    } else {
      asm volatile("s_waitcnt vmcnt(0)" ::: "memory");
    }
    A64_BAR;
    if (j + 3 < nt) A64_ISSUE(j + 3, (j + 3) & 3);
    const bool active = (j >= nl) || (j >= jlo && j < jhi);
    if (active) {
      const int kt = j < nl ? lk0 + j * 64 : ck0 + (j - nl) * 64;
      const int md = j < nl ? mode : 0;
      const char* ks = lds + st * 16384;
      const char* vs = ks + 8192;
      f32x16 s0, s1;
#pragma unroll
      for (int i = 0; i < 16; ++i) { s0[i] = 0.f; s1[i] = 0.f; }
#pragma unroll
      for (int kk = 0; kk < 4; ++kk) {
        const bf16x8 k0 = *(const bf16x8*)(ks + kx[kk]);
        const bf16x8 k1 = *(const bf16x8*)(ks + 4096 + kx[kk]);
        s0 = __builtin_amdgcn_mfma_f32_32x32x16_bf16(k0, qf[kk], s0, 0, 0, 0);
        s1 = __builtin_amdgcn_mfma_f32_32x32x16_bf16(k1, qf[kk], s1, 0, 0, 0);
      }
      if (md == 1) {
        const int kr = (kt - seq0) >> 6;
        const float* rl = rpb + (kr - qr + 7) * 31 + (15 - qc);
#pragma unroll
        for (int i = 0; i < 16; ++i) {
          const int kc0 = (i & 3) + 8 * (i >> 2) + 4 * hh, kc1 = kc0 + 32;
          const float b0 = rl[kc0], b1 = rl[kc1];
          s0[i] = ((unsigned)(kc0 - cs) < 16u) ? s0[i] + b0 : NINF;
          s1[i] = ((unsigned)(kc1 - cs) < 16u) ? s1[i] + b1 : NINF;
        }
      } else if (md == 2) {
        const int q0w = qpos0, kb = kt - seq0;
        if (kb + 63 - q0w > 128 || q0w + 31 - kb > 128) {
          const int base = kb - qp + 128;
#pragma unroll
          for (int i = 0; i < 16; ++i) {
            const int c0 = (i & 3) + 8 * (i >> 2) + 4 * hh;
            if ((unsigned)(base + c0) > 256u) s0[i] = NINF;
            if ((unsigned)(base + c0 + 32) > 256u) s1[i] = NINF;
          }
        }
      }
      float mx = fmaxf(s0[0], s1[0]);
#pragma unroll
      for (int i = 1; i < 16; ++i) mx = fmaxf(mx, fmaxf(s0[i], s1[i]));
      mx = fmaxf(mx, __shfl_xor(mx, 32));
      const float mn = fmaxf(m, mx);
      const float alpha = __builtin_amdgcn_exp2f(m - mn);
      m = mn;
      float rs = 0.f;
#pragma unroll
      for (int i = 0; i < 16; ++i) {
        s0[i] = __builtin_amdgcn_exp2f(s0[i] - mn);
        s1[i] = __builtin_amdgcn_exp2f(s1[i] - mn);
        rs += s0[i] + s1[i];
      }
      rs += __shfl_xor(rs, 32);
      lsum = lsum * alpha + rs;
      if (__builtin_amdgcn_ballot_w64(alpha != 1.f) != 0ull) {
#pragma unroll
        for (int mt = 0; mt < 2; ++mt)
#pragma unroll
          for (int i = 0; i < 16; ++i) o[mt][i] *= alpha;
      }
      union { bf16x8 v; unsigned u[4]; } pf[4];
#pragma unroll
      for (int q = 0; q < 4; ++q) {
        pf[0].u[q] = pack2(s0[2 * q], s0[2 * q + 1]);
        pf[1].u[q] = pack2(s0[8 + 2 * q], s0[8 + 2 * q + 1]);
        pf[2].u[q] = pack2(s1[2 * q], s1[2 * q + 1]);
        pf[3].u[q] = pack2(s1[8 + 2 * q], s1[8 + 2 * q + 1]);
      }
#pragma unroll
      for (int mt = 0; mt < 2; ++mt)
#pragma unroll
        for (int q = 0; q < 4; ++q) {
          const bf16x8 vfr = *(const bf16x8*)(vs + mt * 4096 + kx[q]);
          o[mt] = __builtin_amdgcn_mfma_f32_32x32x16_bf16(vfr, pf[q].v, o[mt], 0, 0, 0);
        }
    }
  }
#undef A64_ISSUE
#undef A64_BAR
#undef A64_LDS
  if (has_sink) lsum += __builtin_amdgcn_exp2f(sink2 - m);
  const float inv = 1.f / lsum;
#pragma unroll
  for (int mt = 0; mt < 2; ++mt)
#pragma unroll
    for (int g = 0; g < 4; ++g) {
      uint2 r;
      r.x = pack2(o[mt][4 * g] * inv, o[mt][4 * g + 1] * inv);
      r.y = pack2(o[mt][4 * g + 2] * inv, o[mt][4 * g + 3] * inv);
      *(uint2*)(Op + (size_t)qi * DM + mt * 32 + 8 * g + 4 * hh) = r;
    }
}

DI void phase_attn(const Params& p, u16* smem, int l, int* s_item, int rep) {
  const int TIDX = tid_opaque();
  constexpr int S0 = 128;
  constexpr int D_L = 128;
  constexpr int NYQ = 32;
  constexpr int S1 = 256, S2 = 256;
  constexpr int D_C = 128;
  constexpr int S3 = 128, S4 = 64, S5 = 128;
  constexpr int TOTAL = S0 + D_L + S1 + S2 + D_C + S3 + S4 + S5 + NYQ;
  const int wid = TIDX >> 6, lane = TIDX & 63;
  float* rpb_l = (float*)smem + 24576 + wid * 512;
  int* ctr = p.ctr + l + 2 * rep;
  for (;;) {
    __syncthreads();
    if (TIDX == 0) *s_item = atomicAdd(ctr, 1);
    __syncthreads();
    int t = *s_item;
    if (t >= TOTAL) break;
    if (t >= TOTAL - NYQ) {
      const int r0 = (t - (TOTAL - NYQ)) * 64 + wid * 8;
#pragma unroll 1
      for (int rr = 0; rr < 8; ++rr) {
        const int row = r0 + rr, bg = row >> 7, lcol = row & 127, b = bg >> 2, g = bg & 3;
        const u16* z = p.ZtL + (size_t)row * 4096;
        float acc = 0.f;
#pragma unroll
        for (int i = 0; i < 4; ++i) {
          const uint4 v = *(const uint4*)(z + i * 512 + lane * 8);
          acc += bf2f((u16)(v.x & 0xffff)) - bf2f((u16)(v.x >> 16)) + bf2f((u16)(v.y & 0xffff)) - bf2f((u16)(v.y >> 16)) +
                 bf2f((u16)(v.z & 0xffff)) - bf2f((u16)(v.z >> 16)) + bf2f((u16)(v.w & 0xffff)) - bf2f((u16)(v.w >> 16));
        }
        acc = wave_sum(acc);
        if (lane == 0) p.o[(size_t)(NTC + b * 2048 + 1024) * DM + 1536 + g * 128 + lcol] = f2bf(acc * (1.f / 512.f));
      }
    } else if (t < S0) {
      const int head = t & 3, qt = (t >> 2) * 8 + wid, b = qt >> 6;
      const int tok0 = NTC + qt * 32, seq0 = NTC + b * 2048;
      attn_mla_block(smem, p.Qm + (size_t)tok0 * 768 + head * 192, p.Km + head * 192, p.VmT + (size_t)head * 128 * NTA,
                     p.o + (size_t)tok0 * DM + 512 + head * 128, seq0, 32, NT + b * 512, 8);
    } else if ((t -= S0) < D_L) {
      const int tm = t & 7, bg = t >> 3, b = bg >> 2, g = bg & 3;
      float* pl = (float*)smem + 16384;
      const u16* Z = p.ZtL + (size_t)bg * 128 * 4096;
      gemm_tile(smem, p.W2048, 4096, Z, 4096, 2048, tm * 128, 0, 128, EpiLdsF32{pl, tm * 128});
      __syncthreads();
      gemm_tile(smem, p.W2048 + 2048, 4096, Z + 2048, 4096, 2048, tm * 128, 0, 128,
                EpiDftSym{pl, tm * 128, 2048, p.o + (size_t)(NTC + b * 2048) * DM + 1536 + g * 128, DM, 1.f / 512.f});
    } else if ((t -= D_L) < S1) {
      const int head = t & 7, rg = (t >> 3) & 7, b = t >> 6;
      const int r0 = rg * 4, r = r0 + (wid >> 1);
      const int seq0 = NTC + b * 2048, qpos0 = r * 64 + (wid & 1) * 32, tok0 = seq0 + qpos0;
      const float* rp = p.rpb_na + ((size_t)l * 8 + head) * 465;
      for (int e = lane; e < 465; e += 64) rpb_l[e] = rp[e] * LOG2E;
      const int lrow0 = min(max(r0 - 4, 0), 24), lrow1 = min(max(r0 + 3 - 4, 0), 24) + 8;
      const int jlo = min(max(r - 4, 0), 24) - lrow0;
      attn64_block(smem, p.Qa + (size_t)tok0 * 512 + head * 64, p.Ka + head * 64, 512, p.VaT + (size_t)head * 64 * NTA,
                   p.o + (size_t)tok0 * DM + head * 64, seq0 + lrow0 * 64, lrow1 - lrow0, NT + b * 512, 8, 1, qpos0, seq0,
                   jlo, jlo + 8, rpb_l, 0.f, false);
    } else if ((t -= S1) < S2) {
      const int kvh = t & 1, rest = t >> 1, b = rest >> 5, q0 = (rest & 31) * 64;
      const int hq = kvh * 4 + (wid & 3), qpos0 = q0 + (wid >> 2) * 32;
      const int seq0 = NTC + b * 2048, tok0 = seq0 + qpos0;
      const int k0 = max(q0 - 128, 0), k1 = min(q0 + 192, 2048);
      attn64_block(smem, p.Qw + (size_t)tok0 * 512 + hq * 64, p.Kw + kvh * 64, 128, p.VwT + (size_t)kvh * 64 * NTA,
                   p.o + (size_t)tok0 * DM + 1024 + hq * 64, seq0 + k0, (k1 - k0) >> 6, NT + b * 512, 8, 2, qpos0, seq0, 0,
                   64, nullptr, p.sink_win[l * 8 + hq] * LOG2E, true);
    } else if ((t -= S2) < D_C) {
      const int tm = t & 1, bg = t >> 1, b = bg >> 2, g = bg & 3;
      gemm_tile(smem, p.W256, 512, p.ZtC + (size_t)bg * 128 * 512, 512, 512, tm * 128, 0, 128,
                EpiBf16{p.o + (size_t)(b * 256) * DM + 1536 + g * 128, DM, 0.005524271728019903f});
    } else if ((t -= D_C) < S3) {
      const int head = t & 7, b = t >> 3;
      const int seq0 = b * 256, qpos0 = wid * 32, tok0 = seq0 + qpos0;
      attn64_block(smem, p.Qa + (size_t)tok0 * 512 + head * 64, p.Ka + head * 64, 512, p.VaT + (size_t)head * 64 * NTA,
                   p.o + (size_t)tok0 * DM + head * 64, seq0, 4, 0, 0, 0, qpos0, seq0, 0, 64, nullptr, 0.f, false);
    } else if ((t -= S3) < S4) {
      const int head = t & 3, b = t >> 2, qt = b * 8 + wid;
      const int tok0 = qt * 32, seq0 = b * 256;
      attn_mla_block(smem, p.Qm + (size_t)tok0 * 768 + head * 192, p.Km + head * 192, p.VmT + (size_t)head * 128 * NTA,
                     p.o + (size_t)tok0 * DM + 512 + head * 128, seq0, 4, 0, 0);
    } else {
      t -= S4;
      const int kvh = t & 1, rest = t >> 1, b = rest >> 2, q0 = (rest & 3) * 64;
      const int hq = kvh * 4 + (wid & 3), qpos0 = q0 + (wid >> 2) * 32;
      const int seq0 = b * 256, tok0 = seq0 + qpos0;
      attn64_block(smem, p.Qw + (size_t)tok0 * 512 + hq * 64, p.Kw + kvh * 64, 128, p.VwT + (size_t)kvh * 64 * NTA,
                   p.o + (size_t)tok0 * DM + 1024 + hq * 64, seq0, 4, 0, 0, 0, qpos0, seq0, 0, 64, nullptr,
                   p.sink_win[l * 8 + hq] * LOG2E, true);
    }
  }
}

struct EpiResid {
  const float* mod_l;
  const void* res_c;
  const void* res_l;
  void* dstp;
  int res_bf, dst_bf;
  int mode;
  float* part;
  unsigned* flag;
  int brow, bcol;
  DI void begin() const {
    if (mode == 2) {
      if (threadIdx.x == 0) {
        while (__hip_atomic_load(flag, __ATOMIC_RELAXED, __HIP_MEMORY_SCOPE_AGENT) == 0u) __builtin_amdgcn_s_sleep(1);
        __builtin_amdgcn_fence(__ATOMIC_ACQUIRE, "agent");
        asm volatile("s_waitcnt vmcnt(0)" ::: "memory");
      }
      __syncthreads();
    }
  }
  DI void end() const {
    if (mode == 1) {
      asm volatile("s_waitcnt vmcnt(0)" ::: "memory");
      __syncthreads();
      if (threadIdx.x == 0) {
        __builtin_amdgcn_fence(__ATOMIC_RELEASE, "agent");
        asm volatile("s_waitcnt vmcnt(0)" ::: "memory");
        __hip_atomic_store(flag, 1u, __ATOMIC_RELAXED, __HIP_MEMORY_SCOPE_AGENT);
      }
    }
  }
  struct Pre { float4 g, x; f32x4 pv; };
  DI Pre load(int m, int n) const {
    Pre q;
    q.pv = (f32x4){0.f, 0.f, 0.f, 0.f};
    if (mode == 1) { q.g = make_float4(0.f, 0.f, 0.f, 0.f); q.x = q.g; return q; }
    if (mode == 2) q.pv = *(const f32x4*)(part + (size_t)(m - brow) * 256 + (n - bcol));
    q.g = *(const float4*)(mod_l + (size_t)mod_index(m) * (6 * DM) + n);
    if (res_bf) {
      const u16* xr = m < NTC ? (const u16*)res_c + (size_t)m * DM : (const u16*)res_l + (size_t)(m - NTC) * DM;
      const uint2 r = *(const uint2*)(xr + n);
      q.x = make_float4(bf2f((u16)(r.x & 0xffff)), bf2f((u16)(r.x >> 16)), bf2f((u16)(r.y & 0xffff)), bf2f((u16)(r.y >> 16)));
    } else {
      const float* xr = m < NTC ? (const float*)res_c + (size_t)m * DM : (const float*)res_l + (size_t)(m - NTC) * DM;
      q.x = *(const float4*)(xr + n);
    }
    return q;
  }
  DI void store(int m, int n, f32x4 v, const Pre& q) const {
    if (mode == 1) {
      *(f32x4*)(part + (size_t)(m - brow) * 256 + (n - bcol)) = v;
      return;
    }
    v += q.pv;
    float4 r;
    r.x = q.x.x + q.g.x * v[0]; r.y = q.x.y + q.g.y * v[1]; r.z = q.x.z + q.g.z * v[2]; r.w = q.x.w + q.g.w * v[3];
    if (dst_bf) {
      uint2 o;
      o.x = pack2(r.x, r.y);
      o.y = pack2(r.z, r.w);
      *(uint2*)((u16*)dstp + (size_t)m * DM + n) = o;
    } else {
      *(float4*)((float*)dstp + (size_t)m * DM + n) = r;
    }
  }
};
DI void gemm_n2048(const Params& p, u16* smem, const u16* A, const u16* W, int K, EpiResid epi, unsigned* flags) {
#pragma unroll 1
  for (int it = blockIdx.x; it < 256; it += gridDim.x) {
    __syncthreads();
    int pm, pn;
    tile256_decode(it, 48, 8, pm, pn);
    gemm256_tile<false>(smem, A, W, K, K, pm * 256, pn * 256, epi);
  }
#pragma unroll 1
  for (int it = blockIdx.x; it < 256; it += gridDim.x) {
    __syncthreads();
    int pm, pn;
    tile256_decode(256 + (it >> 1), 48, 8, pm, pn);
    gemm256_tile<true>(smem, A, W, K, K, pm * 256, pn * 256 + (it & 1) * 128, epi);
  }
}
DI void phase_outproj(const Params& p, u16* smem, int l) {
  const EpiResid epi{p.mod + (size_t)l * 5 * 6 * DM + 2 * DM,
                     l == 0 ? (const void*)p.x_prompt : (const void*)p.x2b,
                     l == 0 ? (const void*)p.x_sample : (const void*)(p.x2b + (size_t)NTC * DM),
                     (void*)p.x1b, l == 0 ? 0 : 1, 1, 0, nullptr, nullptr, 0, 0};
  gemm_n2048(p, smem, p.o, p.WoutT + (size_t)l * DM * DM, DM, epi, p.flags + (l * 2 + 0) * 128);
}
DI void phase_gate(const Params& p, u16* smem, int l) {
  const u16* W = p.WgateT + (size_t)l * DFF * DM;
#pragma unroll 1
  for (int it = blockIdx.x; it < 128; it += gridDim.x) {
    __syncthreads();
    int pm, pn;
    tile256_decode(1024 + (it >> 2), 48, 22, pm, pn);
    gemm_tile(smem, p.h, DM, W, DM, DM, pm * 256 + (it & 1) * 128, pn * 256 + ((it >> 1) & 1) * 128, DFF, EpiBf16{p.g, DFF, 1.f});
  }
#pragma unroll 1
  for (int it = blockIdx.x; it < 1024; it += gridDim.x) {
    __syncthreads();
    int pm, pn;
    tile256_decode(it, 48, 22, pm, pn);
    gemm256_tile(smem, p.h, W, DM, DM, pm * 256, pn * 256, EpiBf16{p.g, DFF, 1.f});
  }
}
struct EpiUp {
  const float* wconv;
  const u16* gbuf;
  u16* abuf;
  struct Pre { uint2 c0, c1, c2; float4 w0, w1, w2; };
  DI void begin() const {}
  DI void end() const {}
  DI Pre load(int m, int n) const {
    Pre q;
    const float* wc = wconv + n;
    q.w0 = *(const float4*)wc; q.w1 = *(const float4*)(wc + DFF); q.w2 = *(const float4*)(wc + 2 * DFF);
    const int pos = m < NTC ? (m & 255) : ((m - NTC) & 2047);
    const int last = m < NTC ? 255 : 2047;
    const u16* gp = gbuf + (size_t)m * DFF + n;
    q.c1 = *(const uint2*)gp;
    q.c0 = make_uint2(0u, 0u);
    q.c2 = make_uint2(0u, 0u);
    if (pos > 0) q.c0 = *(const uint2*)(gp - DFF);
    if (pos < last) q.c2 = *(const uint2*)(gp + DFF);
    return q;
  }
  DI void store(int m, int n, f32x4 v, const Pre& q) const {
    float gg[4];
    gg[0] = bf2f((u16)(q.c0.x & 0xffff)) * q.w0.x + bf2f((u16)(q.c1.x & 0xffff)) * q.w1.x + bf2f((u16)(q.c2.x & 0xffff)) * q.w2.x;
    gg[1] = bf2f((u16)(q.c0.x >> 16)) * q.w0.y + bf2f((u16)(q.c1.x >> 16)) * q.w1.y + bf2f((u16)(q.c2.x >> 16)) * q.w2.y;
    gg[2] = bf2f((u16)(q.c0.y & 0xffff)) * q.w0.z + bf2f((u16)(q.c1.y & 0xffff)) * q.w1.z + bf2f((u16)(q.c2.y & 0xffff)) * q.w2.z;
    gg[3] = bf2f((u16)(q.c0.y >> 16)) * q.w0.w + bf2f((u16)(q.c1.y >> 16)) * q.w1.w + bf2f((u16)(q.c2.y >> 16)) * q.w2.w;
    float r[4];
#pragma unroll
    for (int i = 0; i < 4; ++i) r[i] = gg[i] / (1.f + __expf(-gg[i])) * v[i];
    uint2 o;
    o.x = pack2(r[0], r[1]);
    o.y = pack2(r[2], r[3]);
    *(uint2*)(abuf + (size_t)m * DFF + n) = o;
  }
};
DI void phase_up_ffn(const Params& p, u16* smem, int l) {
  const u16* W = p.WupT + (size_t)l * DFF * DM;
#pragma unroll 1
  for (int it = blockIdx.x; it < 128; it += gridDim.x) {
    __syncthreads();
    int pm, pn;
    tile256_decode(1024 + (it >> 2), 48, 22, pm, pn);
    gemm_tile(smem, p.h, DM, W, DM, DM, pm * 256 + (it & 1) * 128, pn * 256 + ((it >> 1) & 1) * 128, DFF, EpiUp{p.w_conv + (size_t)l * 3 * DFF, p.g, p.a});
  }
#pragma unroll 1
  for (int it = blockIdx.x; it < 1024; it += gridDim.x) {
    __syncthreads();
    int pm, pn;
    tile256_decode(it, 48, 22, pm, pn);
    gemm256_tile(smem, p.h, W, DM, DM, pm * 256, pn * 256, EpiUp{p.w_conv + (size_t)l * 3 * DFF, p.g, p.a});
  }
}
DI void phase_down(const Params& p, u16* smem, int l) {
  const EpiResid epi{p.mod + (size_t)l * 5 * 6 * DM + 5 * DM, (const void*)p.x1b, (const void*)(p.x1b + (size_t)NTC * DM),
                     l == 0 ? (void*)p.x2b : (void*)p.out, 1, l == 0 ? 1 : 0, 0, nullptr, nullptr, 0, 0};
  gemm_n2048(p, smem, p.a, p.WdownT + (size_t)l * DM * DFF, DFF, epi, p.flags + (l * 2 + 1) * 128);
}

constexpr int N_PHASES = 1 + 2 * 11;
DI void run_phase(const Params& p, u16* smem, int* s_item, int ph, int rep) {
#ifdef ONLY
  if (ONLY == 11) { phase_prep(p, smem); return; }
  const int l = ph & 1, s = ONLY;
#else
  if (ph == 0) { phase_prep(p, smem); return; }
  const int l = (ph - 1) / 11, s = (ph - 1) % 11;
#endif
  switch (s) {
    case 0: phase_modulate(p, l, 0); break;
    case 1: phase_qkv(p, smem, l); break;
    case 2: phase_post1(p, smem, l); break;
    case 3: phase_up(p, smem, l); break;
    case 4: phase_post2(p, l); break;
    case 5: phase_attn(p, smem, l, s_item, rep); break;
    case 6: phase_outproj(p, smem, l); break;
    case 7: phase_modulate(p, l, 1); break;
    case 8: phase_gate(p, smem, l); break;
    case 9: phase_up_ffn(p, smem, l); break;
    default: phase_down(p, smem, l); break;
  }
}

#if MEGA
DI void grid_bar(unsigned* bw, unsigned gen, lds_uint* s_nloc_p) {
  asm volatile("s_waitcnt vmcnt(0)" ::: "memory");
  __syncthreads();
  if (threadIdx.x == 0) {
    const unsigned xc = (unsigned)__builtin_amdgcn_s_getreg((3 << 11) | 20) & 0xFu;
    const unsigned nloc = *(volatile lds_uint*)s_nloc_p;
    const unsigned old = __hip_atomic_fetch_add(bw + 64 + 64 * xc, 1u, __ATOMIC_RELAXED, __HIP_MEMORY_SCOPE_AGENT);
    if (old + 1u == gen * nloc) {
      __builtin_amdgcn_fence(__ATOMIC_RELEASE, "agent");
      asm volatile("s_waitcnt vmcnt(0)" ::: "memory");
      __hip_atomic_fetch_add(bw, nloc, __ATOMIC_RELAXED, __HIP_MEMORY_SCOPE_AGENT);
    }
    const unsigned target = gen * gridDim.x;
    while (__hip_atomic_load(bw, __ATOMIC_RELAXED, __HIP_MEMORY_SCOPE_AGENT) < target) __builtin_amdgcn_s_sleep(1);
    __builtin_amdgcn_fence(__ATOMIC_ACQUIRE, "agent");
    asm volatile("s_waitcnt vmcnt(0)" ::: "memory");
  }
  __syncthreads();
}

__global__ void __launch_bounds__(NTHR) mega_kernel(Params p) {
  __shared__ __attribute__((aligned(16))) u16 smem[65536];
  __shared__ int s_item;
  cg::grid_group grid = cg::this_grid();
  unsigned* bar = p.barw;
  __shared__ unsigned s_nloc;
  if (threadIdx.x == 0) {
    const unsigned xc = (unsigned)__builtin_amdgcn_s_getreg((3 << 11) | 20) & 0xFu;
    __hip_atomic_fetch_add(bar + 1536 + 16 * xc, 1u, __ATOMIC_RELAXED, __HIP_MEMORY_SCOPE_AGENT);
  }
  unsigned nbar = 0;
#pragma unroll 1
  for (int ph = 0; ph < N_PHASES; ++ph) {
    run_phase(p, smem, &s_item, ph, 0);
#ifdef DUP_MASK
    {
      const int ty = ph == 0 ? 11 : (ph - 1) % 11;
      if ((DUP_MASK >> ty) & 1) { ++nbar; grid_bar(bar, nbar, (lds_uint*)&s_nloc); run_phase(p, smem, &s_item, ph, 1); }
    }
#endif
    if (ph == 0) {
      grid.sync();
      if (threadIdx.x == 0) {
        const unsigned xc = (unsigned)__builtin_amdgcn_s_getreg((3 << 11) | 20) & 0xFu;
        s_nloc = __hip_atomic_load(bar + 1536 + 16 * xc, __ATOMIC_RELAXED, __HIP_MEMORY_SCOPE_AGENT);
      }
      __syncthreads();
    } else if (ph + 1 < N_PHASES) { ++nbar; grid_bar(bar, nbar, (lds_uint*)&s_nloc); }
  }
}
#else
__global__ void __launch_bounds__(NTHR) phase_kernel(Params p, int ph) {
  __shared__ __attribute__((aligned(16))) u16 smem[65536];
  __shared__ int s_item;
  run_phase(p, smem, &s_item, ph, 0);
}
#endif

extern "C" void kernel_launch(void* const* d_in, const int* in_sizes, int n_in, void* d_out, int out_size, void* d_ws,
                              size_t ws_size, hipStream_t stream) {
  Params p{};
  const float** pi = (const float**)&p;
  for (int i = 0; i < 32; ++i) pi[i] = (const float*)d_in[i];
  p.out = (float*)d_out;
  char* w = (char*)d_ws;
  size_t off = 0;
  auto take = [&](size_t bytes) { char* r = w + off; off += (bytes + 255) & ~(size_t)255; return r; };
  p.WinT = (u16*)take((size_t)2 * RLD * DM * 2);
  p.WqupT = (u16*)take((size_t)2 * 768 * 384 * 2);
  p.WkvupT = (u16*)take((size_t)2 * 1024 * 128 * 2);
  p.WoutT = (u16*)take((size_t)2 * DM * DM * 2);
  p.WgateT = (u16*)take((size_t)2 * DFF * DM * 2);
  p.WupT = (u16*)take((size_t)2 * DFF * DM * 2);
  p.WdownT = (u16*)take((size_t)2 * DM * DFF * 2);
  p.trig128 = (u16*)take(256 * 128 * 2);
  p.W256 = (u16*)take(256 * 512 * 2);
  p.W2048 = (u16*)take((size_t)2048 * 4096 * 2);
  p.mod = (float*)take((size_t)2 * 5 * 6 * DM * 4);
  p.ctr = (int*)take(256);
  p.flags = (unsigned*)take(512 * 4);
  p.barw = (unsigned*)take(2048 * 4);
  p.x1b = (u16*)take((size_t)NT * DM * 2);
  p.x2b = (u16*)take((size_t)NT * DM * 2);
  p.h = (u16*)take((size_t)NT * DM * 2);
  const size_t att0 = off;
  p.raw = (u16*)take((size_t)NT * RLD * 2);
  p.Qa = (u16*)take((size_t)NT * 512 * 2);
  p.Ka = (u16*)take((size_t)NTA * 512 * 2);
  p.VaT = (u16*)take((size_t)512 * NTA * 2);
  p.Qw = (u16*)take((size_t)NT * 512 * 2);
  p.Kw = (u16*)take((size_t)NTA * 128 * 2);
  p.VwT = (u16*)take((size_t)128 * NTA * 2);
  p.cq = (u16*)take((size_t)NT * 384 * 2);
  p.ckv = (u16*)take((size_t)NTA * 128 * 2);
  p.krope = (u16*)take((size_t)NTA * 64 * 2);
  p.qmraw = (u16*)take((size_t)NT * 768 * 2);
  p.kvraw = (u16*)take((size_t)NTA * 1024 * 2);
  p.Qm = (u16*)take((size_t)NT * 768 * 2);
  p.Km = (u16*)take((size_t)NTA * 768 * 2);
  p.VmT = (u16*)take((size_t)512 * NTA * 2);
  p.ZtC = (u16*)take((size_t)64 * 128 * 512 * 2);
  p.ZtL = (u16*)take((size_t)16 * 128 * 4096 * 2);
  p.o = (u16*)take((size_t)NT * DM * 2);
  const size_t att1 = off;
  off = att0;
  p.g = (u16*)take((size_t)NT * DFF * 2);
  p.a = (u16*)take((size_t)NT * DFF * 2);
  if (off < att1) off = att1;
  p.part = (float*)take((size_t)128 * 65536 * 4);
  if (off > ws_size) fprintf(stderr, "workspace too small: need %zu have %zu\n", off, ws_size);

#if MEGA
  (void)hipMemsetAsync(p.barw, 0, 2048 * 4, stream);
  static int grid_blocks = 0;
  if (!grid_blocks) {
    int dev = 0, cus = 0, per_cu = 0;
    hipGetDevice(&dev);
    hipDeviceGetAttribute(&cus, hipDeviceAttributeMultiprocessorCount, dev);
    (void)hipOccupancyMaxActiveBlocksPerMultiprocessor(&per_cu, mega_kernel, NTHR, 0);
    grid_blocks = cus * per_cu;
  }
  void* args[] = {&p};
  hipError_t e = hipLaunchCooperativeKernel((void*)mega_kernel, dim3(grid_blocks), dim3(NTHR), args, 0, stream);
  if (e != hipSuccess) fprintf(stderr, "cooperative launch failed: %s (grid %d)\n", hipGetErrorString(e), grid_blocks);
#else
  for (int ph = 0; ph < N_PHASES; ++ph) phase_kernel<<<dim3(256), dim3(NTHR), 0, stream>>>(p, ph);
#endif
}
```

```cpp
#include <hip/hip_runtime.h>
#include <hip/hip_cooperative_groups.h>
#include <cstdio>
#include <cstdint>
namespace cg = cooperative_groups;

#ifndef MEGA
#define MEGA 1
#endif

typedef unsigned short u16;
using bf16x8 = __attribute__((ext_vector_type(8))) short;
using bf16x4 = __attribute__((ext_vector_type(4))) short;
using f32x4 = __attribute__((ext_vector_type(4))) float;
using f32x16 = __attribute__((ext_vector_type(16))) float;

#define DI __device__ __forceinline__
typedef __attribute__((address_space(3))) unsigned lds_uint;
#define LOG2E 1.4426950408889634f
#define EPSV 1e-6f

constexpr int NT = 12288;
constexpr int NTC = 4096;
constexpr int NTA = 14336;
constexpr int DM = 2048;
constexpr int INC = 3392;
constexpr int RLD = 3584;
constexpr int NTHR = 512;
constexpr int DFF = 5632;
constexpr int C_AQ = 0, C_AK = 512, C_AV = 1024, C_MQ = 1536, C_CKV = 1920, C_KR = 2048, C_CQ = 2112, C_CK = 2624, C_CV = 2752, C_FV = 2880;

struct Params {
  const float *x_prompt, *x_sample, *cache_na_k, *cache_na_v, *cache_mla_ckv, *cache_mla_krope, *cache_win_k, *cache_win_v,
      *c, *c_ctx, *w_mod, *b_mod, *g_mix, *g_ffn, *w_in, *g_qn_na, *g_kn_na, *rpb_na, *g_q_lora, *w_q_up, *g_kv_lora,
      *w_kv_up, *g_qn_mla, *g_kn_mla, *g_qn_win, *g_kn_win, *sink_win, *w_out, *w_gate, *w_up, *w_conv, *w_down;
  float* out;
  u16 *WinT, *WqupT, *WkvupT, *WoutT, *WgateT, *WupT, *WdownT;
  u16 *trig128, *W2048, *W256;
  float* mod;
  u16 *h, *raw, *Qa, *Ka, *VaT, *Qw, *Kw, *VwT, *cq, *ckv, *krope, *qmraw, *kvraw, *Qm, *Km, *VmT, *ZtC, *ZtL, *o, *g, *a;
  u16* x1b;
  u16* x2b;
  int* ctr;
  unsigned* flags;
  float* part;
  unsigned* barw;
};

typedef __bf16 bf16n2 __attribute__((ext_vector_type(2)));
typedef float f32n2 __attribute__((ext_vector_type(2)));
DI unsigned pack2(float a, float b) {
  const f32n2 v = {a, b};
  return __builtin_bit_cast(unsigned, __builtin_convertvector(v, bf16n2));
}
DI u16 f2bf(float x) { return (u16)(pack2(x, 0.f) & 0xffffu); }
DI float bf2f(u16 b) { return __uint_as_float(((unsigned)b) << 16); }
#define DPP_F(v, ctrl, row_mask) \
  __builtin_bit_cast(float, __builtin_amdgcn_update_dpp(0, __builtin_bit_cast(int, (v)), (ctrl), (row_mask), 0xF, false))
DI float wave_sum(float v) {
  v += DPP_F(v, 0xB1, 0xF);
  v += DPP_F(v, 0x4E, 0xF);
  v += DPP_F(v, 0x141, 0xF);
  v += DPP_F(v, 0x140, 0xF);
  v += DPP_F(v, 0x142, 0xA);
  v += DPP_F(v, 0x143, 0xC);
  return __builtin_bit_cast(float, __builtin_amdgcn_readlane(__builtin_bit_cast(int, v), 63));
}
DI int tid_opaque() { int t = threadIdx.x; asm volatile("" : "+v"(t)); return t; }
DI int mod_index(int row) { return row < NTC ? 0 : 1 + ((row - NTC) >> 11); }
DI const float* xin_row(const Params& p, int l, int row) {
  if (l == 0) return row < NTC ? p.x_prompt + (size_t)row * DM : p.x_sample + (size_t)(row - NTC) * DM;
  return p.out + (size_t)row * DM;
}

template <int NI = 2, class Epi>
DI void gemm_tile(u16* smem, const u16* __restrict__ A, int lda, const u16* __restrict__ Bt, int ldb, int K, int m0,
                  int n0, int N, Epi epi) {
  const int TIDX = tid_opaque();
  const int tid = TIDX, lane = tid & 63, wid = tid >> 6;
  const int wr = wid >> 2, wc = wid & 3, fr = lane & 15, fq = lane >> 4;
  constexpr int WN = 16 * NI;
  const int lr = tid >> 3, lc = tid & 7;
  u16* As = smem;
  u16* Bs = smem + 16384;
  f32x4 acc[4][NI];
#pragma unroll
  for (int i = 0; i < 4; ++i)
#pragma unroll
    for (int j = 0; j < NI; ++j) acc[i][j] = (f32x4){0.f, 0.f, 0.f, 0.f};
  const u16* ap = A + (size_t)(m0 + lr) * lda + lc * 8;
  const size_t a64 = (size_t)64 * lda;
  const int rn0 = min(n0 + lr, N - 1), rn1 = NI == 2 ? min(n0 + lr + 64, N - 1) : rn0;
  const u16* bp0 = Bt + (size_t)rn0 * ldb + lc * 8;
  const u16* bp1 = Bt + (size_t)rn1 * ldb + lc * 8;
  const int nt = K >> 6;
  uint4 ra0 = *(const uint4*)(ap), ra1 = *(const uint4*)(ap + a64);
  uint4 rb0 = *(const uint4*)(bp0), rb1 = *(const uint4*)(bp1);
  uint4 sa0 = ra0, sa1 = ra1, sb0 = rb0, sb1 = rb1;
  if (nt > 1) {
    sa0 = *(const uint4*)(ap + 64); sa1 = *(const uint4*)(ap + a64 + 64);
    sb0 = *(const uint4*)(bp0 + 64); sb1 = *(const uint4*)(bp1 + 64);
  }
  const int st_off = lr * 64 + ((lc ^ ((lr >> 1) & 7)) << 3);
  const int sw = (fr >> 1) & 7;
#define GT_COMPUTE(as, bs)                                                                              \
  _Pragma("unroll") for (int ks = 0; ks < 2; ++ks) {                                                    \
    bf16x8 af[4], bfv[NI];                                                                               \
    const int pc = ((ks * 4 + fq) ^ sw) << 3;                                                           \
    _Pragma("unroll") for (int mi = 0; mi < 4; ++mi) af[mi] = *(const bf16x8*)((as) + (wr * 64 + mi * 16 + fr) * 64 + pc); \
    _Pragma("unroll") for (int ni = 0; ni < NI; ++ni) bfv[ni] = *(const bf16x8*)((bs) + (wc * WN + ni * 16 + fr) * 64 + pc); \
    _Pragma("unroll") for (int mi = 0; mi < 4; ++mi)                                                    \
      _Pragma("unroll") for (int ni = 0; ni < NI; ++ni)                                                 \
        acc[mi][ni] = __builtin_amdgcn_mfma_f32_16x16x32_bf16(bfv[ni], af[mi], acc[mi][ni], 0, 0, 0);   \
  }
  for (int t = 0; t < nt; t += 2) {
    {
      u16* as = As;
      u16* bs = Bs;
      *(uint4*)(as + st_off) = ra0;
      *(uint4*)(as + st_off + 4096) = ra1;
      *(uint4*)(bs + st_off) = rb0;
      *(uint4*)(bs + st_off + 4096) = rb1;
      __syncthreads();
      if (t + 2 < nt) {
        const int ko = (t + 2) << 6;
        ra0 = *(const uint4*)(ap + ko);
        ra1 = *(const uint4*)(ap + a64 + ko);
        rb0 = *(const uint4*)(bp0 + ko);
        rb1 = *(const uint4*)(bp1 + ko);
      }
      GT_COMPUTE(as, bs)
    }
    if (t + 1 < nt) {
      u16* as = As + 8192;
      u16* bs = Bs + 8192;
      *(uint4*)(as + st_off) = sa0;
      *(uint4*)(as + st_off + 4096) = sa1;
      *(uint4*)(bs + st_off) = sb0;
      *(uint4*)(bs + st_off + 4096) = sb1;
      __syncthreads();
      if (t + 3 < nt) {
        const int ko = (t + 3) << 6;
        sa0 = *(const uint4*)(ap + ko);
        sa1 = *(const uint4*)(ap + a64 + ko);
        sb0 = *(const uint4*)(bp0 + ko);
        sb1 = *(const uint4*)(bp1 + ko);
      }
      GT_COMPUTE(as, bs)
    }
  }
#undef GT_COMPUTE
  epi.begin();
  {
    typename Epi::Pre pre[4][NI];
#pragma unroll
    for (int mi = 0; mi < 4; ++mi)
#pragma unroll
      for (int ni = 0; ni < NI; ++ni) {
        const int m = m0 + wr * 64 + mi * 16 + fr;
        const int n = n0 + wc * WN + ni * 16 + fq * 4;
        if (n < N) pre[mi][ni] = epi.load(m, n);
      }
#pragma unroll
    for (int mi = 0; mi < 4; ++mi)
#pragma unroll
      for (int ni = 0; ni < NI; ++ni) {
        const int m = m0 + wr * 64 + mi * 16 + fr;
        const int n = n0 + wc * WN + ni * 16 + fq * 4;
        if (n < N) epi.store(m, n, acc[mi][ni], pre[mi][ni]);
      }
  }
  epi.end();
}

constexpr int G_HT = 128 * 64;
DI int lds_byte(int r, int c) {
  const int st = (r >> 4) * 2 + (c >> 5), rr = r & 15, cc = c & 31, ob = rr * 64 + cc * 2;
  return st * 1024 + (ob ^ (((ob >> 9) & 1) << 5));
}
DI void stage_rc(int b, int& R, int& C) {
  const int st = b / 1024, sb = b % 1024, swz = sb ^ (((sb >> 9) & 1) << 5);
  R = (st >> 1) * 16 + swz / 64;
  C = (st & 1) * 32 + (swz % 64) / 2;
}
template <bool HALF = false, class Epi>
DI void gemm256_tile(u16* shm, const u16* __restrict__ A, const u16* __restrict__ Bt, int K, int ld, int brow, int bcol, Epi epi) {
  const int TIDX = tid_opaque();
#define SA(b, h) (shm + ((b) * 2 + (h)) * G_HT)
#define SB(b, h) (shm + (4 + (b) * 2 + (h)) * G_HT)
#define STAGE(P, BASE, br, kt)                                                                          \
  do {                                                                                                  \
    const char* _ub = (const char*)((BASE) + (long)(br) * ld + (long)(kt) * 64);                         \
    __builtin_amdgcn_global_load_lds((const unsigned*)(_ub + voff0),                                    \
                                     (__attribute__((address_space(3))) unsigned*)((char*)(P) + TIDX * 16), 16, 0, 0); \
    __builtin_amdgcn_global_load_lds((const unsigned*)(_ub + voff1),                                    \
                                     (__attribute__((address_space(3))) unsigned*)((char*)(P) + TIDX * 16 + 8192), 16, 0, 0); \
  } while (0)
#define LDA(dst, b, h)                                                                                  \
  for (int m = 0; m < 4; ++m)                                                                           \
    for (int k = 0; k < 2; ++k)                                                                         \
      dst[m][k] = *reinterpret_cast<const bf16x8*>(lds_a + (((b) * 2 + (h)) * 16384 + m * 2048 + k * 1024))
#define LDB(dst, b, h)                                                                                  \
  for (int n = 0; n < 2; ++n)                                                                           \
    for (int k = 0; k < 2; ++k)                                                                         \
      dst[n][k] = *reinterpret_cast<const bf16x8*>(lds_b + (((b) * 2 + (h)) * 16384 + n * 2048 + k * 1024))
#define MMA(ai, bj, At, Bv)                                                                             \
  if (!(HALF && (bj) == 1)) do {                                                                        \
    __builtin_amdgcn_s_setprio(1);                                                                      \
    for (int m = 0; m < 4; ++m)                                                                         \
      for (int n = 0; n < 2; ++n)                                                                       \
        for (int k = 0; k < 2; ++k)                                                                     \
          acc[ai][bj][m][n] = __builtin_amdgcn_mfma_f32_16x16x32_bf16(Bv[n][k], At[m][k], acc[ai][bj][m][n], 0, 0, 0); \
    __builtin_amdgcn_s_setprio(0);                                                                      \
  } while (0)
#define WAIT_V(n) asm volatile("s_waitcnt vmcnt(" #n ")" ::: "memory")
#define WAIT_L(n) asm volatile("s_waitcnt lgkmcnt(" #n ")" ::: "memory")
#define BAR __builtin_amdgcn_s_barrier()
#define SCHED __builtin_amdgcn_sched_barrier(0)
  const int wid = TIDX >> 6, lane = TIDX & 63, wr = wid >> 2, wc = wid & 3, fr = lane & 15, fq = lane >> 4;
  f32x4 acc[2][2][4][2];
#pragma unroll
  for (int a = 0; a < 2; ++a)
#pragma unroll
    for (int b = 0; b < 2; ++b)
#pragma unroll
      for (int m = 0; m < 4; ++m)
#pragma unroll
        for (int n = 0; n < 2; ++n) acc[a][b][m][n] = (f32x4){0.f, 0.f, 0.f, 0.f};
  bf16x8 At[4][2], B0[2][2], B1[2][2];
  const int nt = K / 64;
  const int swz_ = (fr * 64 + fq * 16) ^ ((((fr * 64 + fq * 16) >> 9) & 1) << 5);
  const char* lds_a = (const char*)shm + wr * 8192 + swz_;
  const char* lds_b = (const char*)shm + 65536 + wc * 4096 + swz_;
  unsigned voff0, voff1;
  {
    int r_, c_;
    stage_rc(TIDX * 16, r_, c_);
    voff0 = (unsigned)(r_ * ld + c_) * 2u;
    stage_rc(TIDX * 16 + 8192, r_, c_);
    voff1 = (unsigned)(r_ * ld + c_) * 2u;
  }
  STAGE(SB(0, 0), Bt, bcol, 0); STAGE(SA(0, 0), A, brow, 0);
  STAGE(SB(0, 1), Bt, bcol + 128, 0); STAGE(SA(0, 1), A, brow + 128, 0);
  if (wr == 1) BAR;
  WAIT_V(4); BAR;
  STAGE(SB(1, 0), Bt, bcol, 1); STAGE(SA(1, 0), A, brow, 1); STAGE(SB(1, 1), Bt, bcol + 128, 1);
  WAIT_V(6); BAR;
  for (int t = 0; t < nt - 2; t += 2) {
    LDB(B0, 0, 0); SCHED; LDA(At, 0, 0); STAGE(SA(1, 1), A, brow + 128, t + 1);
    WAIT_L(8); BAR; WAIT_L(0); MMA(0, 0, At, B0); BAR; SCHED;
    LDB(B1, 0, 1); STAGE(SB(0, 0), Bt, bcol, t + 2);
    BAR; WAIT_L(0); MMA(0, 1, At, B1); BAR;
    LDA(At, 0, 1); STAGE(SA(0, 0), A, brow, t + 2);
    BAR; WAIT_L(0); MMA(1, 0, At, B0); BAR; SCHED;
    STAGE(SB(0, 1), Bt, bcol + 128, t + 2);
    WAIT_V(6); BAR; MMA(1, 1, At, B1); BAR;
    LDB(B0, 1, 0); SCHED; LDA(At, 1, 0); STAGE(SA(0, 1), A, brow + 128, t + 2);
    WAIT_L(8); BAR; WAIT_L(0); MMA(0, 0, At, B0); BAR; SCHED;
    LDB(B1, 1, 1); STAGE(SB(1, 0), Bt, bcol, t + 3);
    BAR; WAIT_L(0); MMA(0, 1, At, B1); BAR;
    LDA(At, 1, 1); STAGE(SA(1, 0), A, brow, t + 3);
    BAR; WAIT_L(0); MMA(1, 0, At, B0); BAR; SCHED;
    STAGE(SB(1, 1), Bt, bcol + 128, t + 3);
    WAIT_V(6); BAR; MMA(1, 1, At, B1); BAR;
  }
  { LDB(B0, 0, 0); LDA(At, 0, 0); STAGE(SA(1, 1), A, brow + 128, nt - 1);
    BAR; WAIT_L(0); MMA(0, 0, At, B0); BAR;
    LDB(B1, 0, 1); BAR; WAIT_L(0); MMA(0, 1, At, B1); BAR;
    LDA(At, 0, 1); WAIT_V(4); BAR; WAIT_L(0); MMA(1, 0, At, B0); MMA(1, 1, At, B1); BAR; }
  { LDB(B0, 1, 0); LDA(At, 1, 0); WAIT_V(2); BAR; WAIT_L(0); MMA(0, 0, At, B0); BAR;
    LDB(B1, 1, 1); WAIT_V(0); BAR; WAIT_L(0); MMA(0, 1, At, B1); BAR;
    LDA(At, 1, 1); BAR; WAIT_L(0); MMA(1, 0, At, B0); MMA(1, 1, At, B1); BAR; }
  if (wr == 0) BAR;
  epi.begin();
#pragma unroll
  for (int ai = 0; ai < 2; ++ai)
#pragma unroll
    for (int m = 0; m < 4; ++m) {
      const int row = brow + ai * 128 + wr * 64 + m * 16 + fr;
      typename Epi::Pre pre[2][2];
#pragma unroll
      for (int bj = 0; bj < (HALF ? 1 : 2); ++bj)
#pragma unroll
        for (int n = 0; n < 2; ++n) pre[bj][n] = epi.load(row, bcol + bj * 128 + wc * 32 + n * 16 + fq * 4);
#pragma unroll
      for (int bj = 0; bj < (HALF ? 1 : 2); ++bj)
#pragma unroll
        for (int n = 0; n < 2; ++n) epi.store(row, bcol + bj * 128 + wc * 32 + n * 16 + fq * 4, acc[ai][bj][m][n], pre[bj][n]);
    }
  epi.end();
#undef SA
#undef SB
#undef STAGE
#undef LDA
#undef LDB
#undef MMA
}

struct EpiBf16 {
  u16* C;
  int ldc;
  float scale;
  struct Pre {};
  DI void begin() const {}
  DI void end() const {}
  DI Pre load(int, int) const { return Pre{}; }
  DI void store(int m, int n, f32x4 v, Pre) const {
    uint2 r;
    r.x = pack2(v[0] * scale, v[1] * scale);
    r.y = pack2(v[2] * scale, v[3] * scale);
    *(uint2*)(C + (size_t)m * ldc + n) = r;
  }
};

struct EpiBf16P {
  u16* C;
  int ldc;
  struct Pre {};
  DI void begin() const {}
  DI void end() const {}
  DI Pre load(int, int) const { return Pre{}; }
  DI void store(int m, int n, f32x4 v, Pre) const {
    const int np = (n & ~12) | ((n & 4) << 1) | ((n & 8) >> 1);
    uint2 r;
    r.x = pack2(v[0], v[1]);
    r.y = pack2(v[2], v[3]);
    *(uint2*)(C + (size_t)m * ldc + np) = r;
  }
};

struct EpiLdsF32 {
  float* lds;
  int m0;
  struct Pre {};
  DI void begin() const {}
  DI void end() const {}
  DI Pre load(int, int) const { return Pre{}; }
  DI void store(int m, int n, f32x4 v, Pre) const { *(f32x4*)(lds + (m - m0) * 128 + n) = v; }
};
struct EpiDftSym {
  const float* lds;
  int m0, S;
  u16* obase;
  int ldo;
  float scale;
  struct Pre { f32x4 pv; };
  DI void begin() const {}
  DI void end() const {}
  DI Pre load(int m, int n) const { Pre q; q.pv = *(const f32x4*)(lds + (m - m0) * 128 + n); return q; }
  DI void store(int m, int n, f32x4 v, const Pre& q) const {
    uint2 r;
    r.x = pack2((q.pv[0] + v[0]) * scale, (q.pv[1] + v[1]) * scale);
    r.y = pack2((q.pv[2] + v[2]) * scale, (q.pv[3] + v[3]) * scale);
    *(uint2*)(obase + (size_t)m * ldo + n) = r;
    if (m > 0) {
      r.x = pack2((q.pv[0] - v[0]) * scale, (q.pv[1] - v[1]) * scale);
      r.y = pack2((q.pv[2] - v[2]) * scale, (q.pv[3] - v[3]) * scale);
      *(uint2*)(obase + (size_t)(S - m) * ldo + n) = r;
    }
  }
};

DI void tile_decode(int t, int tilesN, int& tm, int& tn) {
  const int per = 8 * tilesN;
  const int grp = t / per, r = t - grp * per;
  tm = grp * 8 + (r & 7);
  tn = r >> 3;
}
DI void tile256_decode(int L, int nM, int nN, int& pm, int& pn) {
  const int nwg = nM * nN;
  int wgid = L;
  {
    const int q = nwg / 8, r = nwg % 8, xcd = wgid % 8, off = wgid / 8;
    wgid = (xcd < r ? xcd * (q + 1) : r * (q + 1) + (xcd - r) * q) + off;
  }
  const int nig = 8 * nN, gid = wgid / nig, fm = gid * 8, gsz = min(nM - fm, 8);
  pm = fm + ((wgid % nig) % gsz);
  pn = (wgid % nig) / gsz;
}

DI void prep_mod_item(const Params& p, u16* smem_u, int it) {
  const int TIDX = tid_opaque();
  float* sm = (float*)smem_u;
  float* red = sm + 5 * 2048;
  const int tid = TIDX;
  const int l = it / 384, n0 = (it % 384) * 32;
  for (int e = tid; e < 5 * 2048; e += NTHR) {
    const int j = e >> 11, k = e & 2047;
    const float v = j == 0 ? p.c_ctx[k] : p.c[(j - 1) * DM + k];
    sm[e] = v / (1.f + __expf(-v));
  }
  __syncthreads();
  const int cgp = tid & 7, kg = tid >> 3;
  float acc[5][4];
#pragma unroll
  for (int j = 0; j < 5; ++j)
#pragma unroll
    for (int q = 0; q < 4; ++q) acc[j][q] = 0.f;
  const float* wp = p.w_mod + (size_t)l * DM * (6 * DM) + (size_t)(kg * 32) * (6 * DM) + n0 + cgp * 4;
#pragma unroll 1
  for (int k0 = 0; k0 < 32; k0 += 16) {
    float4 w[16];
#pragma unroll
    for (int k = 0; k < 16; ++k) { const f32x4 t_ = __builtin_nontemporal_load((const f32x4*)(wp + (size_t)(k0 + k) * (6 * DM))); w[k] = make_float4(t_[0], t_[1], t_[2], t_[3]); }
#pragma unroll
    for (int k = 0; k < 16; ++k)
#pragma unroll
      for (int j = 0; j < 5; ++j) {
        const float s = sm[j * 2048 + kg * 32 + k0 + k];
        acc[j][0] += s * w[k].x; acc[j][1] += s * w[k].y; acc[j][2] += s * w[k].z; acc[j][3] += s * w[k].w;
      }
  }
#pragma unroll
  for (int j = 0; j < 5; ++j)
#pragma unroll
    for (int q = 0; q < 4; ++q) red[(kg * 8 + cgp) * 20 + j * 4 + q] = acc[j][q];
  __syncthreads();
  if (tid < 160) {
    const int j = tid >> 5, n = tid & 31;
    float s = p.b_mod[l * (6 * DM) + n0 + n];
#pragma unroll 8
    for (int g = 0; g < 64; ++g) s += red[(g * 8 + (n >> 2)) * 20 + j * 4 + (n & 3)];
    p.mod[((size_t)l * 5 + j) * (6 * DM) + n0 + n] = s;
  }
}

struct TrDesc { const float* src; u16* dst; int K, N, k0, n0; };
DI void transpose_load(const TrDesc& d, int tid, float4 (&v)[8]) {
  const int r = tid >> 4, c4 = tid & 15;
#pragma unroll
  for (int ps = 0; ps < 8; ++ps) {
    const f32x4 t_ = __builtin_nontemporal_load((const f32x4*)(d.src + (size_t)(d.k0 + r + 16 * ps) * d.N + d.n0 + c4 * 4));
    v[ps] = make_float4(t_[0], t_[1], t_[2], t_[3]);
  }
}
DI void transpose_finish(u16* smem_u, const TrDesc& d, int tid, const float4 (&v)[8]) {
  float* tile = (float*)smem_u;
  const int r = tid >> 4, c4 = tid & 15;
#pragma unroll
  for (int ps = 0; ps < 8; ++ps) {
    const int k = r + 16 * ps;
    tile[k * 65 + c4 * 4 + 0] = v[ps].x; tile[k * 65 + c4 * 4 + 1] = v[ps].y;
    tile[k * 65 + c4 * 4 + 2] = v[ps].z; tile[k * 65 + c4 * 4 + 3] = v[ps].w;
  }
  __syncthreads();
  const int n = tid >> 2, kq = tid & 3;
  unsigned w[16];
#pragma unroll
  for (int i = 0; i < 16; ++i) w[i] = pack2(tile[(kq * 32 + 2 * i) * 65 + n], tile[(kq * 32 + 2 * i + 1) * 65 + n]);
  uint4* o = (uint4*)(d.dst + (size_t)(d.n0 + n) * d.K + d.k0 + kq * 32);
  o[0] = make_uint4(w[0], w[1], w[2], w[3]);
  o[1] = make_uint4(w[4], w[5], w[6], w[7]);
  o[2] = make_uint4(w[8], w[9], w[10], w[11]);
  o[3] = make_uint4(w[12], w[13], w[14], w[15]);
}

DI void phase_prep(const Params& p, u16* smem_all) {
  const int TIDX = tid_opaque();
  constexpr int N_MOD = 768;
  constexpr int T_IN = 16 * 53, T_QUP = 3 * 12, T_KVUP = 1 * 16, T_OUT = 16 * 32, T_G = 16 * 88, T_D = 44 * 32;
  constexpr int T_LAYER = T_IN + T_QUP + T_KVUP + T_OUT + 2 * T_G + T_D;
  constexpr int N_TR = 2 * T_LAYER;
  constexpr int N_TRIG = 2088 + 192;
  const int total = N_MOD + N_TR + N_TRIG;
  const int half = TIDX >> 8, tid = TIDX & 255;
  u16* smem = smem_all + half * 32768;
  if (blockIdx.x == 0 && TIDX < 32) p.ctr[TIDX] = 0;
  if (blockIdx.x == 0) p.flags[TIDX] = 0u;
  for (int it = blockIdx.x; it < N_MOD; it += gridDim.x) {
    __syncthreads();
    prep_mod_item(p, smem_all, it);
  }
  {
    auto decode = [&](int t) {
      TrDesc d;
      const int l = t / T_LAYER;
      t -= l * T_LAYER;
      if (t < T_IN) { d.src = p.w_in + (size_t)l * DM * INC; d.dst = p.WinT + (size_t)l * RLD * DM; d.K = DM; d.N = INC; }
      else if ((t -= T_IN) < T_QUP) { d.src = p.w_q_up + (size_t)l * 384 * 768; d.dst = p.WqupT + (size_t)l * 768 * 384; d.K = 384; d.N = 768; }
      else if ((t -= T_QUP) < T_KVUP) { d.src = p.w_kv_up + (size_t)l * 128 * 1024; d.dst = p.WkvupT + (size_t)l * 1024 * 128; d.K = 128; d.N = 1024; }
      else if ((t -= T_KVUP) < T_OUT) { d.src = p.w_out + (size_t)l * DM * DM; d.dst = p.WoutT + (size_t)l * DM * DM; d.K = DM; d.N = DM; }
      else if ((t -= T_OUT) < T_G) { d.src = p.w_gate + (size_t)l * DM * DFF; d.dst = p.WgateT + (size_t)l * DFF * DM; d.K = DM; d.N = DFF; }
      else if ((t -= T_G) < T_G) { d.src = p.w_up + (size_t)l * DM * DFF; d.dst = p.WupT + (size_t)l * DFF * DM; d.K = DM; d.N = DFF; }
      else { t -= T_G; d.src = p.w_down + (size_t)l * DFF * DM; d.dst = p.WdownT + (size_t)l * DM * DFF; d.K = DFF; d.N = DM; }
      const int tilesN = d.N >> 6;
      const int tk = t / tilesN, tn = t - tk * tilesN;
      d.k0 = tk * 128;
      d.n0 = tn * 64;
      return d;
    };
    int t = blockIdx.x * 2 + half;
    const int tstep = gridDim.x * 2;
    float4 va[8], vb[8];
    TrDesc da, db;
    if (t < N_TR) { da = decode(t); transpose_load(da, tid, va); }
#pragma unroll 1
    for (; t < N_TR; t += 2 * tstep) {
      const bool hb = t + tstep < N_TR;
      if (hb) { db = decode(t + tstep); transpose_load(db, tid, vb); }
      __syncthreads();
      transpose_finish(smem, da, tid, va);
      if (hb) {
        const bool ha = t + 2 * tstep < N_TR;
        if (ha) { da = decode(t + 2 * tstep); transpose_load(da, tid, va); }
        __syncthreads();
        transpose_finish(smem, db, tid, vb);
      }
    }
  }
  for (int it = N_MOD + N_TR + blockIdx.x * 2 + half; it < total; it += gridDim.x * 2) {
    {
      const int t = it - N_MOD - N_TR;
#pragma unroll 1
      for (int q = 0; q < 16; ++q) {
        int e = t * 4096 + q * 256 + tid;
        if (e < 32768) {
          const int j = e >> 7, c = e & 127;
          const int jj = j & 127;
          const float x = (float)((jj * c) & 127) * (1.f / 64.f);
          float sn, cs;
          sincospif(x, &sn, &cs);
          p.trig128[e] = f2bf(j < 128 ? cs : sn);
        } else if ((e -= 32768) < 131072) {
          const int k = e >> 9, s2 = e & 511, s = s2 & 255;
          const float x = (float)((k * s) & 255) * (1.f / 128.f);
          float sn, cs;
          sincospif(x, &sn, &cs);
          p.W256[e] = f2bf(s2 < 256 ? cs : -sn);
        } else if ((e -= 131072) < 8388608) {
          const int k = e >> 12, s2 = e & 4095, s = s2 & 2047;
          const float x = (float)((k * s) & 2047) * (1.f / 1024.f);
          float sn, cs;
          sincospif(x, &sn, &cs);
          p.W2048[e] = f2bf(s2 < 2048 ? cs : -sn);
        } else {
          e -= 8388608;
          const int l = e / (192 * 2048), r = e - l * (192 * 2048);
          p.WinT[(size_t)l * RLD * DM + (size_t)INC * DM + r] = 0;
        }
      }
    }
  }
}

DI void load_row32(const float* xf, const u16* xb, int lane, float4 (&v)[8]) {
  if (xb) {
#pragma unroll
    for (int i = 0; i < 4; ++i) {
      const uint4 r = *(const uint4*)(xb + i * 512 + lane * 8);
      v[2 * i] = make_float4(bf2f((u16)(r.x & 0xffff)), bf2f((u16)(r.x >> 16)), bf2f((u16)(r.y & 0xffff)), bf2f((u16)(r.y >> 16)));
      v[2 * i + 1] = make_float4(bf2f((u16)(r.z & 0xffff)), bf2f((u16)(r.z >> 16)), bf2f((u16)(r.w & 0xffff)), bf2f((u16)(r.w >> 16)));
    }
  } else {
#pragma unroll
    for (int i = 0; i < 4; ++i) {
      v[2 * i] = *(const float4*)(xf + i * 512 + lane * 8);
      v[2 * i + 1] = *(const float4*)(xf + i * 512 + lane * 8 + 4);
    }
  }
}
DI void phase_modulate(const Params& p, int l, int which) {
  const int TIDX = tid_opaque();
  const int lane = TIDX & 63, wid = TIDX >> 6;
  const float* gain = (which ? p.g_ffn : p.g_mix) + l * DM;
  const u16* xbsrc = which ? p.x1b : (l == 0 ? nullptr : p.x2b);
  for (int it = blockIdx.x; it < NT / 16; it += gridDim.x) {
    const int row0 = it * 16 + wid * 2;
    float4 va[8], vb[8];
    load_row32(xbsrc ? nullptr : xin_row(p, 0, row0), xbsrc ? xbsrc + (size_t)row0 * DM : nullptr, lane, va);
    load_row32(xbsrc ? nullptr : xin_row(p, 0, row0 + 1), xbsrc ? xbsrc + (size_t)(row0 + 1) * DM : nullptr, lane, vb);
    float sa = 0.f, sb = 0.f;
#pragma unroll
    for (int i = 0; i < 8; ++i) {
      sa += va[i].x * va[i].x + va[i].y * va[i].y + va[i].z * va[i].z + va[i].w * va[i].w;
      sb += vb[i].x * vb[i].x + vb[i].y * vb[i].y + vb[i].z * vb[i].z + vb[i].w * vb[i].w;
    }
    sa = wave_sum(sa);
    sb = wave_sum(sb);
    const float ra = rsqrtf(sa * (1.f / DM) + EPSV), rb = rsqrtf(sb * (1.f / DM) + EPSV);
    const float* md = p.mod + ((size_t)l * 5 + mod_index(row0)) * (6 * DM);
    const float* sh = md + (which ? 3 : 0) * DM;
    const float* sc = md + (which ? 4 : 1) * DM;
#pragma unroll
    for (int i = 0; i < 4; ++i) {
      const int c = i * 512 + lane * 8;
      uint4 oa, ob;
#pragma unroll
      for (int hf = 0; hf < 2; ++hf) {
        const int cc = c + hf * 4;
        const float4 g = *(const float4*)(gain + cc), s1 = *(const float4*)(sc + cc), s0 = *(const float4*)(sh + cc);
        const float gx = g.x * (1.f + s1.x), gy = g.y * (1.f + s1.y), gz = g.z * (1.f + s1.z), gw = g.w * (1.f + s1.w);
        const float4 a = va[2 * i + hf], b = vb[2 * i + hf];
        const unsigned a0 = pack2(a.x * ra * gx + s0.x, a.y * ra * gy + s0.y), a1 = pack2(a.z * ra * gz + s0.z, a.w * ra * gw + s0.w);
        const unsigned b0 = pack2(b.x * rb * gx + s0.x, b.y * rb * gy + s0.y), b1 = pack2(b.z * rb * gz + s0.z, b.w * rb * gw + s0.w);
        if (hf == 0) { oa.x = a0; oa.y = a1; ob.x = b0; ob.y = b1; } else { oa.z = a0; oa.w = a1; ob.z = b0; ob.w = b1; }
      }
      *(uint4*)(p.h + (size_t)row0 * DM + c) = oa;
      *(uint4*)(p.h + (size_t)(row0 + 1) * DM + c) = ob;
    }
  }
}

DI void phase_qkv(const Params& p, u16* smem, int l) {
  const u16* W = p.WinT + (size_t)l * RLD * DM;
#pragma unroll 1
  for (int it = blockIdx.x; it < 48 * 14; it += gridDim.x) {
    __syncthreads();
    int pm, pn;
    tile256_decode(it, 48, 14, pm, pn);
    gemm256_tile(smem, p.h, W, DM, DM, pm * 256, pn * 256, EpiBf16{p.raw, RLD, 1.f});
  }
}

DI float rope_apply(float y, float sn, float cs, int lane) {
  const float pr = __shfl_xor(y, 16);
  return (lane & 16) ? (pr * sn + y * cs) : (y * cs - pr * sn);
}
DI void rope_trig(int lane, int pos_row, int pos_col, float& sn, float& cs) {
  const int i = lane & 15;
  const float inv = exp2f(-(float)i * (13.287712379549449f / 16.f));
  const float ang = (float)((lane < 32) ? pos_row : pos_col) * inv;
  sincosf(ang, &sn, &cs);
}

DI void phase_post1(const Params& p, u16* smem, int l) {
  const int TIDX = tid_opaque();
  const int lane = TIDX & 63, wid = TIDX >> 6;
  float* o_nak = p.out + 25165824;
  float* o_nav = o_nak + 4194304;
  float* o_ckv = o_nav + 4194304;
  float* o_kr = o_ckv + 1048576;
  float* o_wk = o_kr + 524288;
  float* o_wv = o_wk + 1048576;
  for (int it = blockIdx.x; it < NTA / 8; it += gridDim.x) {
    const int tok = it * 8 + wid;
    if (tok < NT) {
      const u16* rp = p.raw + (size_t)tok * RLD + lane;
      u16 r[45];
#pragma unroll
      for (int i = 0; i < 45; ++i) r[i] = rp[i * 64];
      asm volatile("" ::: "memory");
      const bool ctx = tok < NTC;
      size_t ob = 0;
      float sn = 0.f, cs = 1.f;
      if (ctx) {
        const int b = tok >> 8, s = tok & 255;
        ob = (size_t)(b * 2 + l) * 256 + s;
      } else {
        const int pos = (tok - NTC) & 2047;
        rope_trig(lane, pos >> 6, pos & 63, sn, cs);
      }
      const float gq = p.g_qn_na[l * 64 + lane], gk = p.g_kn_na[l * 64 + lane];
#pragma unroll
      for (int h = 0; h < 8; ++h) {
        float v = bf2f(r[h]);
        float ss = wave_sum(v * v);
        p.Qa[(size_t)tok * 512 + h * 64 + lane] = f2bf(v * rsqrtf(ss * (1.f / 64.f) + EPSV) * gq * (0.125f * LOG2E));
        v = bf2f(r[8 + h]);
        ss = wave_sum(v * v);
        const float y = v * rsqrtf(ss * (1.f / 64.f) + EPSV) * gk;
        p.Ka[(size_t)tok * 512 + h * 64 + lane] = f2bf(y);
        if (ctx) {
          o_nak[(ob * 8 + h) * 64 + lane] = y;
          o_nav[(ob * 8 + h) * 64 + lane] = bf2f(r[16 + h]);
        }
      }
      {
        float v[6], ss = 0.f;
#pragma unroll
        for (int i = 0; i < 6; ++i) { v[i] = bf2f(r[24 + i]); ss += v[i] * v[i]; }
        ss = wave_sum(ss);
        const float rs = rsqrtf(ss * (1.f / 384.f) + EPSV);
#pragma unroll
        for (int i = 0; i < 6; ++i) p.cq[(size_t)tok * 384 + i * 64 + lane] = f2bf(v[i] * rs * p.g_q_lora[l * 384 + i * 64 + lane]);
      }
      {
        const float v0 = bf2f(r[30]), v1 = bf2f(r[31]);
        const float ss = wave_sum(v0 * v0 + v1 * v1);
        const float rs = rsqrtf(ss * (1.f / 128.f) + EPSV);
        const float y0 = v0 * rs * p.g_kv_lora[l * 128 + lane], y1 = v1 * rs * p.g_kv_lora[l * 128 + 64 + lane];
        p.ckv[(size_t)tok * 128 + lane] = f2bf(y0);
        p.ckv[(size_t)tok * 128 + 64 + lane] = f2bf(y1);
        if (ctx) { o_ckv[ob * 128 + lane] = y0; o_ckv[ob * 128 + 64 + lane] = y1; }
      }
      {
        p.krope[(size_t)tok * 64 + lane] = r[32];
        if (ctx) o_kr[ob * 64 + lane] = bf2f(r[32]);
      }
      const float gqw = p.g_qn_win[l * 64 + lane], gkw = p.g_kn_win[l * 64 + lane];
#pragma unroll
      for (int hq = 0; hq < 8; ++hq) {
        const float v = bf2f(r[33 + hq]);
        const float ss = wave_sum(v * v);
        float y = v * rsqrtf(ss * (1.f / 64.f) + EPSV) * gqw;
        if (!ctx) y = rope_apply(y, sn, cs, lane);
        p.Qw[(size_t)tok * 512 + hq * 64 + lane] = f2bf(y * (0.125f * LOG2E));
      }
#pragma unroll
      for (int kh = 0; kh < 2; ++kh) {
        const float v = bf2f(r[41 + kh]);
        const float ss = wave_sum(v * v);
        float y = v * rsqrtf(ss * (1.f / 64.f) + EPSV) * gkw;
        if (ctx) {
          o_wk[(ob * 2 + kh) * 64 + lane] = y;
          o_wv[(ob * 2 + kh) * 64 + lane] = bf2f(r[43 + kh]);
        } else {
          y = rope_apply(y, sn, cs, lane);
        }
        p.Kw[(size_t)tok * 128 + kh * 64 + lane] = f2bf(y);
      }
    } else {
      const int cr = tok - NT, b = cr >> 9, key = cr & 511;
      const size_t cb = (size_t)(b * 2 + l) * 512 + key;
      const int tokp = (tok & ~12) | ((tok & 4) << 1) | ((tok & 8) >> 1);
      float ck[8], cv[8], c0, c1, c2, wk[2], wv[2];
#pragma unroll
      for (int h = 0; h < 8; ++h) {
        ck[h] = p.cache_na_k[(cb * 8 + h) * 64 + lane];
        cv[h] = p.cache_na_v[(cb * 8 + h) * 64 + lane];
      }
      c0 = p.cache_mla_ckv[cb * 128 + lane];
      c1 = p.cache_mla_ckv[cb * 128 + 64 + lane];
      c2 = p.cache_mla_krope[cb * 64 + lane];
#pragma unroll
      for (int kh = 0; kh < 2; ++kh) {
        wk[kh] = p.cache_win_k[(cb * 2 + kh) * 64 + lane];
        wv[kh] = p.cache_win_v[(cb * 2 + kh) * 64 + lane];
      }
      asm volatile("" ::: "memory");
#pragma unroll
      for (int h = 0; h < 8; ++h) {
        p.Ka[(size_t)tok * 512 + h * 64 + lane] = f2bf(ck[h]);
        p.VaT[(size_t)(h * 64 + lane) * NTA + tokp] = f2bf(cv[h]);
      }
      p.ckv[(size_t)tok * 128 + lane] = f2bf(c0);
      p.ckv[(size_t)tok * 128 + 64 + lane] = f2bf(c1);
      p.krope[(size_t)tok * 64 + lane] = f2bf(c2);
#pragma unroll
      for (int kh = 0; kh < 2; ++kh) {
        p.Kw[(size_t)tok * 128 + kh * 64 + lane] = f2bf(wk[kh]);
        p.VwT[(size_t)(kh * 64 + lane) * NTA + tokp] = f2bf(wv[kh]);
      }
    }
  }
  for (int it = blockIdx.x; it < NT / 64; it += gridDim.x) {
    __syncthreads();
    const int tok0 = it * 64;
    for (int e = TIDX; e < 64 * 80; e += NTHR) {
      const int row = e / 80, ch = e - row * 80;
      const int col = ch < 64 ? C_AV + ch * 8 : C_CV + (ch - 64) * 8;
      const uint4 v = *(const uint4*)(p.raw + (size_t)(tok0 + row) * RLD + col);
      *(uint4*)(smem + row * 648 + ch * 8) = v;
    }
    __syncthreads();
    for (int e = TIDX; e < 640 * 4; e += NTHR) {
      const int vc = e >> 2, tg = e & 3;
      u16 t[16];
#pragma unroll
      for (int i = 0; i < 16; ++i) t[i] = smem[(tg * 16 + i) * 648 + vc];
      uint4 a, b;
      a.x = t[0] | ((unsigned)t[1] << 16); a.y = t[2] | ((unsigned)t[3] << 16);
      a.z = t[8] | ((unsigned)t[9] << 16); a.w = t[10] | ((unsigned)t[11] << 16);
      b.x = t[4] | ((unsigned)t[5] << 16); b.y = t[6] | ((unsigned)t[7] << 16);
      b.z = t[12] | ((unsigned)t[13] << 16); b.w = t[14] | ((unsigned)t[15] << 16);
      u16* d = (vc < 512 ? p.VaT + (size_t)vc * NTA : p.VwT + (size_t)(vc - 512) * NTA) + tok0 + tg * 16;
      *(uint4*)d = a;
      *(uint4*)(d + 8) = b;
    }
  }
}

DI void phase_up(const Params& p, u16* smem, int l) {
  constexpr int T1 = 96 * 6, T2 = 112 * 4, T3 = 4 * 112, T4 = 256, T5 = 512;
  const u16* Wq = p.WqupT + (size_t)l * 768 * 384;
  const u16* Wkv = p.WkvupT + (size_t)l * 1024 * 128;
  for (int it = blockIdx.x; it < T1 + T2 + T3 + T4 + T5; it += gridDim.x) {
    __syncthreads();
    int t = it;
    if (t < T1) {
      const int tm = t / 6, tn = t - tm * 6;
      gemm_tile(smem, p.cq, 384, Wq, 384, 384, tm * 128, tn * 128, 768, EpiBf16{p.qmraw, 768, 1.f});
    } else if ((t -= T1) < T2) {
      const int tm = t >> 2, hd = t & 3;
      gemm_tile(smem, p.ckv, 128, Wkv, 128, 128, tm * 128, hd * 256, 1024, EpiBf16{p.kvraw, 1024, 1.f});
    } else if ((t -= T2) < T3) {
      const int hd = t & 3, tn = t >> 2;
      gemm_tile(smem, Wkv + (size_t)(hd * 256 + 128) * 128, 128, p.ckv, 128, 128, 0, tn * 128, NTA,
                EpiBf16P{p.VmT + (size_t)hd * 128 * NTA, NTA});
    } else if ((t -= T3) < T4) {
      const int tn = t & 1, pr = t >> 1, csn = pr & 1, bg = pr >> 1, b = bg >> 2, g = bg & 3;
      gemm_tile(smem, p.trig128 + csn * 128 * 128, 128, p.raw + (size_t)(b * 256) * RLD + C_FV + g * 128, RLD, 128, 0,
                tn * 128, 256, EpiBf16{p.ZtC + (size_t)bg * 128 * 512 + csn * 256, 512, 1.f});
    } else {
      t -= T4;
      const int tn = t & 15, pr = t >> 4, csn = pr & 1, bg = pr >> 1, b = bg >> 2, g = bg & 3;
      gemm_tile(smem, p.trig128 + csn * 128 * 128, 128, p.raw + (size_t)(NTC + b * 2048) * RLD + C_FV + g * 128, RLD, 128,
                0, tn * 128, 2048, EpiBf16{p.ZtL + (size_t)bg * 128 * 4096 + csn * 2048, 4096, 1.f});
    }
  }
}

DI void phase_post2(const Params& p, int l) {
  const int TIDX = tid_opaque();
  const int lane = TIDX & 63, wid = TIDX >> 6;
  const float SCM = 0.07216878364870322f * LOG2E;
  const float gq0 = p.g_qn_mla[l * 192 + lane], gq1 = p.g_qn_mla[l * 192 + 64 + lane], gq2 = p.g_qn_mla[l * 192 + 128 + lane];
  const float gk0 = p.g_kn_mla[l * 192 + lane], gk1 = p.g_kn_mla[l * 192 + 64 + lane], gk2 = p.g_kn_mla[l * 192 + 128 + lane];
  for (int it = blockIdx.x; it < NTA / 8; it += gridDim.x) {
    const int tok = it * 8 + wid;
    const bool lat = tok >= NTC && tok < NT;
    const bool hasq = tok < NT;
    u16 qv[12], kv[8], kr;
    {
      const u16* qp = p.qmraw + (size_t)(hasq ? tok : 0) * 768 + lane;
#pragma unroll
      for (int i = 0; i < 12; ++i) qv[i] = qp[i * 64];
      const u16* kp = p.kvraw + (size_t)tok * 1024 + lane;
#pragma unroll
      for (int h = 0; h < 4; ++h) { kv[2 * h] = kp[h * 256]; kv[2 * h + 1] = kp[h * 256 + 64]; }
      kr = p.krope[(size_t)tok * 64 + lane];
    }
    asm volatile("" ::: "memory");
    float sn = 0.f, cs = 1.f;
    if (lat) {
      const int pos = (tok - NTC) & 2047;
      rope_trig(lane, pos >> 6, pos & 63, sn, cs);
    }
    if (hasq) {
#pragma unroll
      for (int h = 0; h < 4; ++h) {
        const float v0 = bf2f(qv[3 * h]), v1 = bf2f(qv[3 * h + 1]), v2 = bf2f(qv[3 * h + 2]);
        const float ss = wave_sum(v0 * v0 + v1 * v1 + v2 * v2);
        const float rs = rsqrtf(ss * (1.f / 192.f) + EPSV);
        float y2 = v2 * rs * gq2;
        if (lat) y2 = rope_apply(y2, sn, cs, lane);
        u16* q = p.Qm + (size_t)tok * 768 + h * 192;
        q[lane] = f2bf(v0 * rs * gq0 * SCM);
        q[64 + lane] = f2bf(v1 * rs * gq1 * SCM);
        q[128 + lane] = f2bf(y2 * SCM);
      }
    }
    {
      const float v2 = bf2f(kr);
#pragma unroll
      for (int h = 0; h < 4; ++h) {
        const float v0 = bf2f(kv[2 * h]), v1 = bf2f(kv[2 * h + 1]);
        const float ss = wave_sum(v0 * v0 + v1 * v1 + v2 * v2);
        const float rs = rsqrtf(ss * (1.f / 192.f) + EPSV);
        float y2 = v2 * rs * gk2;
        if (lat) y2 = rope_apply(y2, sn, cs, lane);
        u16* k = p.Km + (size_t)tok * 768 + h * 192;
        k[lane] = f2bf(v0 * rs * gk0);
        k[64 + lane] = f2bf(v1 * rs * gk1);
        k[128 + lane] = f2bf(y2);
      }
    }
  }
}

DI void attn_mla_block(u16* smem, const u16* __restrict__ Qp, const u16* __restrict__ Kh, const u16* __restrict__ Vh,
                       u16* __restrict__ Op, int lk0, int nl, int ck0, int nc) {
  const int TIDX = tid_opaque();
  const int lane = TIDX & 63, qi = lane & 31, hh = lane >> 5;
  char* lds = (char*)smem;
  unsigned ko0, ko1, ko2, vo0, vo1;
  {
    int L = TIDX * 16, row = L / 384, pc = (L % 384) >> 4;
    ko0 = (unsigned)(row * 768 + ((pc & ~7) | ((pc & 7) ^ ((row >> 1) & 7))) * 8) * 2u;
    L += 8192; row = L / 384; pc = (L % 384) >> 4;
    ko1 = (unsigned)(row * 768 + ((pc & ~7) | ((pc & 7) ^ ((row >> 1) & 7))) * 8) * 2u;
    L += 8192; row = L / 384; pc = (L % 384) >> 4;
    ko2 = (unsigned)(row * 768 + ((pc & ~7) | ((pc & 7) ^ ((row >> 1) & 7))) * 8) * 2u;
    L = TIDX * 16; row = L >> 7; pc = (L & 127) >> 4;
    vo0 = (unsigned)(row * NTA + (pc ^ ((row >> 1) & 7)) * 8) * 2u;
    L += 8192; row = L >> 7; pc = (L & 127) >> 4;
    vo1 = (unsigned)(row * NTA + (pc ^ ((row >> 1) & 7)) * 8) * 2u;
  }
  const int xk = (qi >> 1) & 7;
  int kx[4], vx[4];
#pragma unroll
  for (int q = 0; q < 4; ++q) {
    kx[q] = qi * 384 + (((q * 2 + hh) ^ xk) << 4);
    vx[q] = qi * 128 + (((q * 2 + hh) ^ xk) << 4);
  }
  bf16x8 qf[12];
#pragma unroll
  for (int kk = 0; kk < 12; ++kk) qf[kk] = *(const bf16x8*)(Qp + (size_t)qi * 768 + kk * 16 + hh * 8);
  f32x16 o[4];
#pragma unroll
  for (int mt = 0; mt < 4; ++mt)
#pragma unroll
    for (int i = 0; i < 16; ++i) o[mt][i] = 0.f;
  float m = -1e30f, lsum = 0.f;
  const int nt = nl + nc;
#define MLA_LDS(p_) ((__attribute__((address_space(3))) unsigned*)(p_))
#define MLA_ISSUE(j_, st_)                                                                        \
  do {                                                                                            \
    const int kt_ = (j_) < nl ? lk0 + (j_) * 64 : ck0 + ((j_) - nl) * 64;                         \
    const char* kb_ = (const char*)(Kh + (size_t)kt_ * 768);                                      \
    const char* vb_ = (const char*)(Vh + kt_);                                                    \
    char* d_ = lds + (st_) * 40960 + TIDX * 16;                                                   \
    __builtin_amdgcn_global_load_lds((const unsigned*)(kb_ + ko0), MLA_LDS(d_), 16, 0, 0);        \
    __builtin_amdgcn_global_load_lds((const unsigned*)(kb_ + ko1), MLA_LDS(d_ + 8192), 16, 0, 0); \
    __builtin_amdgcn_global_load_lds((const unsigned*)(kb_ + ko2), MLA_LDS(d_ + 16384), 16, 0, 0); \
    __builtin_amdgcn_global_load_lds((const unsigned*)(vb_ + vo0), MLA_LDS(d_ + 24576), 16, 0, 0); \
    __builtin_amdgcn_global_load_lds((const unsigned*)(vb_ + vo1), MLA_LDS(d_ + 32768), 16, 0, 0); \
  } while (0)
#define MLA_BAR                                \
  do {                                         \
    asm volatile("" ::: "memory");             \
    __builtin_amdgcn_s_barrier();              \
    asm volatile("" ::: "memory");             \
  } while (0)
  MLA_ISSUE(0, 0);
  if (nt > 1) MLA_ISSUE(1, 1);
  int st = 0, stn = 2;
#pragma unroll 1
  for (int j = 0; j < nt; ++j) {
    if (j + 1 < nt) {
      asm volatile("s_waitcnt vmcnt(5)" ::: "memory");
    } else {
      asm volatile("s_waitcnt vmcnt(0)" ::: "memory");
    }
    MLA_BAR;
    if (j + 2 < nt) MLA_ISSUE(j + 2, stn);
    const char* ks = lds + st * 40960;
    const char* vs = ks + 24576;
    f32x16 s0, s1;
#pragma unroll
    for (int i = 0; i < 16; ++i) { s0[i] = 0.f; s1[i] = 0.f; }
#pragma unroll
    for (int kk = 0; kk < 12; ++kk) {
      const int off = (kk >> 2) * 128 + kx[kk & 3];
      const bf16x8 k0 = *(const bf16x8*)(ks + off);
      const bf16x8 k1 = *(const bf16x8*)(ks + 12288 + off);
      s0 = __builtin_amdgcn_mfma_f32_32x32x16_bf16(k0, qf[kk], s0, 0, 0, 0);
      s1 = __builtin_amdgcn_mfma_f32_32x32x16_bf16(k1, qf[kk], s1, 0, 0, 0);
    }
    float mx = fmaxf(s0[0], s1[0]);
#pragma unroll
    for (int i = 1; i < 16; ++i) mx = fmaxf(mx, fmaxf(s0[i], s1[i]));
    mx = fmaxf(mx, __shfl_xor(mx, 32));
    const float mn = fmaxf(m, mx);
    const float alpha = __builtin_amdgcn_exp2f(m - mn);
    m = mn;
    float rs = 0.f;
#pragma unroll
    for (int i = 0; i < 16; ++i) {
      s0[i] = __builtin_amdgcn_exp2f(s0[i] - mn);
      s1[i] = __builtin_amdgcn_exp2f(s1[i] - mn);
      rs += s0[i] + s1[i];
    }
    rs += __shfl_xor(rs, 32);
    lsum = lsum * alpha + rs;
    if (__builtin_amdgcn_ballot_w64(alpha != 1.f) != 0ull) {
#pragma unroll
      for (int mt = 0; mt < 4; ++mt)
#pragma unroll
        for (int i = 0; i < 16; ++i) o[mt][i] *= alpha;
    }
    union { bf16x8 v; unsigned u[4]; } pf[4];
#pragma unroll
    for (int q = 0; q < 4; ++q) {
      pf[0].u[q] = pack2(s0[2 * q], s0[2 * q + 1]);
      pf[1].u[q] = pack2(s0[8 + 2 * q], s0[8 + 2 * q + 1]);
      pf[2].u[q] = pack2(s1[2 * q], s1[2 * q + 1]);
      pf[3].u[q] = pack2(s1[8 + 2 * q], s1[8 + 2 * q + 1]);
    }
#pragma unroll
    for (int mt = 0; mt < 4; ++mt)
#pragma unroll
      for (int q = 0; q < 4; ++q) {
        const bf16x8 vfr = *(const bf16x8*)(vs + mt * 4096 + vx[q]);
        o[mt] = __builtin_amdgcn_mfma_f32_32x32x16_bf16(vfr, pf[q].v, o[mt], 0, 0, 0);
      }
    st = st == 2 ? 0 : st + 1;
    stn = stn == 2 ? 0 : stn + 1;
  }
#undef MLA_ISSUE
#undef MLA_BAR
#undef MLA_LDS
  const float inv = 1.f / lsum;
#pragma unroll
  for (int mt = 0; mt < 4; ++mt)
#pragma unroll
    for (int g = 0; g < 4; ++g) {
      uint2 r;
      r.x = pack2(o[mt][4 * g] * inv, o[mt][4 * g + 1] * inv);
      r.y = pack2(o[mt][4 * g + 2] * inv, o[mt][4 * g + 3] * inv);
      *(uint2*)(Op + (size_t)qi * DM + mt * 32 + 8 * g + 4 * hh) = r;
    }
}

DI void attn64_block(u16* smem, const u16* __restrict__ Qp, const u16* __restrict__ Kh, int ldk, const u16* __restrict__ Vh,
                     u16* __restrict__ Op, int lk0, int nl, int ck0, int nc, int mode, int qpos0, int seq0, int jlo, int jhi,
                     const float* rpb, float sink2, bool has_sink) {
  const int TIDX = tid_opaque();
  const int lane = TIDX & 63, qi = lane & 31, hh = lane >> 5;
  char* lds = (char*)smem;
  unsigned ko, vo;
  {
    const int L = TIDX * 16, row = L >> 7, pc = (L & 127) >> 4, c = pc ^ ((row >> 1) & 7);
    ko = (unsigned)(row * ldk + c * 8) * 2u;
    vo = (unsigned)(row * NTA + c * 8) * 2u;
  }
  const int xk = (qi >> 1) & 7;
  int kx[4];
#pragma unroll
  for (int q = 0; q < 4; ++q) kx[q] = qi * 128 + (((q * 2 + hh) ^ xk) << 4);
  bf16x8 qf[4];
#pragma unroll
  for (int kk = 0; kk < 4; ++kk) qf[kk] = *(const bf16x8*)(Qp + (size_t)qi * 512 + kk * 16 + hh * 8);
  f32x16 o[2];
#pragma unroll
  for (int mt = 0; mt < 2; ++mt)
#pragma unroll
    for (int i = 0; i < 16; ++i) o[mt][i] = 0.f;
  float m = -1e30f, lsum = 0.f;
  const int qp = qpos0 + qi, qr = qp >> 6, qc = qp & 63;
  const int cs = min(max(qc - 8, 0), 48);
  const float NINF = -__builtin_inff();
  const int nt = nl + nc;
#define A64_LDS(p_) ((__attribute__((address_space(3))) unsigned*)(p_))
#define A64_ISSUE(j_, st_)                                                                    \
  do {                                                                                        \
    const int kt_ = (j_) < nl ? lk0 + (j_) * 64 : ck0 + ((j_) - nl) * 64;                     \
    const char* kb_ = (const char*)(Kh + (size_t)kt_ * ldk);                                  \
    const char* vb_ = (const char*)(Vh + kt_);                                                \
    char* d_ = lds + (st_) * 16384 + TIDX * 16;                                               \
    __builtin_amdgcn_global_load_lds((const unsigned*)(kb_ + ko), A64_LDS(d_), 16, 0, 0);     \
    __builtin_amdgcn_global_load_lds((const unsigned*)(vb_ + vo), A64_LDS(d_ + 8192), 16, 0, 0); \
  } while (0)
#define A64_BAR                                \
  do {                                         \
    asm volatile("" ::: "memory");             \
    __builtin_amdgcn_s_barrier();              \
    asm volatile("" ::: "memory");             \
  } while (0)
  A64_ISSUE(0, 0);
  if (nt > 1) A64_ISSUE(1, 1);
  if (nt > 2) A64_ISSUE(2, 2);
#pragma unroll 1
  for (int j = 0; j < nt; ++j) {
    const int st = j & 3;
    if (j + 2 < nt) {
      asm volatile("s_waitcnt vmcnt(4)" ::: "memory");
    } else if (j + 1 < nt) {
      asm volatile("s_waitcnt vmcnt(2)" ::: "memory");
    } else {
      asm volatile("s_waitcnt vmcnt(0)" ::: "memory");
    }
    A64_BAR;
    if (j + 3 < nt) A64_ISSUE(j + 3, (j + 3) & 3);
    const bool active = (j >= nl) || (j >= jlo && j < jhi);
    if (active) {
      const int kt = j < nl ? lk0 + j * 64 : ck0 + (j - nl) * 64;
      const int md = j < nl ? mode : 0;
      const char* ks = lds + st * 16384;
      const char* vs = ks + 8192;
      f32x16 s0, s1;
#pragma unroll
      for (int i = 0; i < 16; ++i) { s0[i] = 0.f; s1[i] = 0.f; }
#pragma unroll
      for (int kk = 0; kk < 4; ++kk) {
        const bf16x8 k0 = *(const bf16x8*)(ks + kx[kk]);
        const bf16x8 k1 = *(const bf16x8*)(ks + 4096 + kx[kk]);
        s0 = __builtin_amdgcn_mfma_f32_32x32x16_bf16(k0, qf[kk], s0, 0, 0, 0);
        s1 = __builtin_amdgcn_mfma_f32_32x32x16_bf16(k1, qf[kk], s1, 0, 0, 0);
      }
      if (md == 1) {
        const int kr = (kt - seq0) >> 6;
        const float* rl = rpb + (kr - qr + 7) * 31 + (15 - qc);
#pragma unroll
        for (int i = 0; i < 16; ++i) {
          const int kc0 = (i & 3) + 8 * (i >> 2) + 4 * hh, kc1 = kc0 + 32;
          const float b0 = rl[kc0], b1 = rl[kc1];
          s0[i] = ((unsigned)(kc0 - cs) < 16u) ? s0[i] + b0 : NINF;
          s1[i] = ((unsigned)(kc1 - cs) < 16u) ? s1[i] + b1 : NINF;
        }
      } else if (md == 2) {
        const int q0w = qpos0, kb = kt - seq0;
        if (kb + 63 - q0w > 128 || q0w + 31 - kb > 128) {
          const int base = kb - qp + 128;
#pragma unroll
          for (int i = 0; i < 16; ++i) {
            const int c0 = (i & 3) + 8 * (i >> 2) + 4 * hh;
            if ((unsigned)(base + c0) > 256u) s0[i] = NINF;
            if ((unsigned)(base + c0 + 32) > 256u) s1[i] = NINF;
          }
        }
      }
      float mx = fmaxf(s0[0], s1[0]);
#pragma unroll
      for (int i = 1; i < 16; ++i) mx = fmaxf(mx, fmaxf(s0[i], s1[i]));
      mx = fmaxf(mx, __shfl_xor(mx, 32));
      const float mn = fmaxf(m, mx);
      const float alpha = __builtin_amdgcn_exp2f(m - mn);
      m = mn;
      float rs = 0.f;
#pragma unroll
      for (int i = 0; i < 16; ++i) {
        s0[i] = __builtin_amdgcn_exp2f(s0[i] - mn);
        s1[i] = __builtin_amdgcn_exp2f(s1[i] - mn);
        rs += s0[i] + s1[i];
      }
      rs += __shfl_xor(rs, 32);
      lsum = lsum * alpha + rs;
      if (__builtin_amdgcn_ballot_w64(alpha != 1.f) != 0ull) {
#pragma unroll
        for (int mt = 0; mt < 2; ++mt)
#pragma unroll
          for (int i = 0; i < 16; ++i) o[mt][i] *= alpha;
      }
      union { bf16x8 v; unsigned u[4]; } pf[4];
#pragma unroll
      for (int q = 0; q < 4; ++q) {
        pf[0].u[q] = pack2(s0[2 * q], s0[2 * q + 1]);
        pf[1].u[q] = pack2(s0[8 + 2 * q], s0[8 + 2 * q + 1]);
        pf[2].u[q] = pack2(s1[2 * q], s1[2 * q + 1]);
        pf[3].u[q] = pack2(s1[8 + 2 * q], s1[8 + 2 * q + 1]);
      }
#pragma unroll
      for (int mt = 0; mt < 2; ++mt)
#pragma unroll
        for (int q = 0; q < 4; ++q) {
          const bf16x8 vfr = *(const bf16x8*)(vs + mt * 4096 + kx[q]);
          o[mt] = __builtin_amdgcn_mfma_f32_32x32x16_bf16(vfr, pf[q].v, o[mt], 0, 0, 0);
        }
    }
  }
#undef A64_ISSUE
#undef A64_BAR
#undef A64_LDS
  if (has_sink) lsum += __builtin_amdgcn_exp2f(sink2 - m);
  const float inv = 1.f / lsum;
#pragma unroll
  for (int mt = 0; mt < 2; ++mt)
#pragma unroll
    for (int g = 0; g < 4; ++g) {
      uint2 r;
      r.x = pack2(o[mt][4 * g] * inv, o[mt][4 * g + 1] * inv);
      r.y = pack2(o[mt][4 * g + 2] * inv, o[mt][4 * g + 3] * inv);
      *(uint2*)(Op + (size_t)qi * DM + mt * 32 + 8 * g + 4 * hh) = r;
    }
}

DI void phase_attn(const Params& p, u16* smem, int l, int* s_item, int rep) {
  const int TIDX = tid_opaque();
  constexpr int S0 = 128;
  constexpr int D_L = 128;
  constexpr int NYQ = 32;
  constexpr int S1 = 256, S2 = 256;
  constexpr int D_C = 128;
  constexpr int S3 = 128, S4 = 64, S5 = 128;
  constexpr int TOTAL = S0 + D_L + S1 + S2 + D_C + S3 + S4 + S5 + NYQ;
  const int wid = TIDX >> 6, lane = TIDX & 63;
  float* rpb_l = (float*)smem + 24576 + wid * 512;
  int* ctr = p.ctr + l + 2 * rep;
  for (;;) {
    __syncthreads();
    if (TIDX == 0) *s_item = atomicAdd(ctr, 1);
    __syncthreads();
    int t = *s_item;
    if (t >= TOTAL) break;
    if (t >= TOTAL - NYQ) {
      const int r0 = (t - (TOTAL - NYQ)) * 64 + wid * 8;
#pragma unroll 1
      for (int rr = 0; rr < 8; ++rr) {
        const int row = r0 + rr, bg = row >> 7, lcol = row & 127, b = bg >> 2, g = bg & 3;
        const u16* z = p.ZtL + (size_t)row * 4096;
        float acc = 0.f;
#pragma unroll
        for (int i = 0; i < 4; ++i) {
          const uint4 v = *(const uint4*)(z + i * 512 + lane * 8);
          acc += bf2f((u16)(v.x & 0xffff)) - bf2f((u16)(v.x >> 16)) + bf2f((u16)(v.y & 0xffff)) - bf2f((u16)(v.y >> 16)) +
                 bf2f((u16)(v.z & 0xffff)) - bf2f((u16)(v.z >> 16)) + bf2f((u16)(v.w & 0xffff)) - bf2f((u16)(v.w >> 16));
        }
        acc = wave_sum(acc);
        if (lane == 0) p.o[(size_t)(NTC + b * 2048 + 1024) * DM + 1536 + g * 128 + lcol] = f2bf(acc * (1.f / 512.f));
      }
    } else if (t < S0) {
      const int head = t & 3, qt = (t >> 2) * 8 + wid, b = qt >> 6;
      const int tok0 = NTC + qt * 32, seq0 = NTC + b * 2048;
      attn_mla_block(smem, p.Qm + (size_t)tok0 * 768 + head * 192, p.Km + head * 192, p.VmT + (size_t)head * 128 * NTA,
                     p.o + (size_t)tok0 * DM + 512 + head * 128, seq0, 32, NT + b * 512, 8);
    } else if ((t -= S0) < D_L) {
      const int tm = t & 7, bg = t >> 3, b = bg >> 2, g = bg & 3;
      float* pl = (float*)smem + 16384;
      const u16* Z = p.ZtL + (size_t)bg * 128 * 4096;
      gemm_tile(smem, p.W2048, 4096, Z, 4096, 2048, tm * 128, 0, 128, EpiLdsF32{pl, tm * 128});
      __syncthreads();
      gemm_tile(smem, p.W2048 + 2048, 4096, Z + 2048, 4096, 2048, tm * 128, 0, 128,
                EpiDftSym{pl, tm * 128, 2048, p.o + (size_t)(NTC + b * 2048) * DM + 1536 + g * 128, DM, 1.f / 512.f});
    } else if ((t -= D_L) < S1) {
      const int head = t & 7, rg = (t >> 3) & 7, b = t >> 6;
      const int r0 = rg * 4, r = r0 + (wid >> 1);
      const int seq0 = NTC + b * 2048, qpos0 = r * 64 + (wid & 1) * 32, tok0 = seq0 + qpos0;
      const float* rp = p.rpb_na + ((size_t)l * 8 + head) * 465;
      for (int e = lane; e < 465; e += 64) rpb_l[e] = rp[e] * LOG2E;
      const int lrow0 = min(max(r0 - 4, 0), 24), lrow1 = min(max(r0 + 3 - 4, 0), 24) + 8;
      const int jlo = min(max(r - 4, 0), 24) - lrow0;
      attn64_block(smem, p.Qa + (size_t)tok0 * 512 + head * 64, p.Ka + head * 64, 512, p.VaT + (size_t)head * 64 * NTA,
                   p.o + (size_t)tok0 * DM + head * 64, seq0 + lrow0 * 64, lrow1 - lrow0, NT + b * 512, 8, 1, qpos0, seq0,
                   jlo, jlo + 8, rpb_l, 0.f, false);
    } else if ((t -= S1) < S2) {
      const int kvh = t & 1, rest = t >> 1, b = rest >> 5, q0 = (rest & 31) * 64;
      const int hq = kvh * 4 + (wid & 3), qpos0 = q0 + (wid >> 2) * 32;
      const int seq0 = NTC + b * 2048, tok0 = seq0 + qpos0;
      const int k0 = max(q0 - 128, 0), k1 = min(q0 + 192, 2048);
      attn64_block(smem, p.Qw + (size_t)tok0 * 512 + hq * 64, p.Kw + kvh * 64, 128, p.VwT + (size_t)kvh * 64 * NTA,
                   p.o + (size_t)tok0 * DM + 1024 + hq * 64, seq0 + k0, (k1 - k0) >> 6, NT + b * 512, 8, 2, qpos0, seq0, 0,
                   64, nullptr, p.sink_win[l * 8 + hq] * LOG2E, true);
    } else if ((t -= S2) < D_C) {
      const int tm = t & 1, bg = t >> 1, b = bg >> 2, g = bg & 3;
      gemm_tile(smem, p.W256, 512, p.ZtC + (size_t)bg * 128 * 512, 512, 512, tm * 128, 0, 128,
                EpiBf16{p.o + (size_t)(b * 256) * DM + 1536 + g * 128, DM, 0.005524271728019903f});
    } else if ((t -= D_C) < S3) {
      const int head = t & 7, b = t >> 3;
      const int seq0 = b * 256, qpos0 = wid * 32, tok0 = seq0 + qpos0;
      attn64_block(smem, p.Qa + (size_t)tok0 * 512 + head * 64, p.Ka + head * 64, 512, p.VaT + (size_t)head * 64 * NTA,
                   p.o + (size_t)tok0 * DM + head * 64, seq0, 4, 0, 0, 0, qpos0, seq0, 0, 64, nullptr, 0.f, false);
    } else if ((t -= S3) < S4) {
      const int head = t & 3, b = t >> 2, qt = b * 8 + wid;
      const int tok0 = qt * 32, seq0 = b * 256;
      attn_mla_block(smem, p.Qm + (size_t)tok0 * 768 + head * 192, p.Km + head * 192, p.VmT + (size_t)head * 128 * NTA,
                     p.o + (size_t)tok0 * DM + 512 + head * 128, seq0, 4, 0, 0);
    } else {
      t -= S4;
      const int kvh = t & 1, rest = t >> 1, b = rest >> 2, q0 = (rest & 3) * 64;
      const int hq = kvh * 4 + (wid & 3), qpos0 = q0 + (wid >> 2) * 32;
      const int seq0 = b * 256, tok0 = seq0 + qpos0;
      attn64_block(smem, p.Qw + (size_t)tok0 * 512 + hq * 64, p.Kw + kvh * 64, 128, p.VwT + (size_t)kvh * 64 * NTA,
                   p.o + (size_t)tok0 * DM + 1024 + hq * 64, seq0, 4, 0, 0, 0, qpos0, seq0, 0, 64, nullptr,
                   p.sink_win[l * 8 + hq] * LOG2E, true);
    }
  }
}

struct EpiResid {
  const float* mod_l;
  const void* res_c;
  const void* res_l;
  void* dstp;
  int res_bf, dst_bf;
  int mode;
  float* part;
  unsigned* flag;
  int brow, bcol;
  DI void begin() const {
    if (mode == 2) {
      if (threadIdx.x == 0) {
        while (__hip_atomic_load(flag, __ATOMIC_RELAXED, __HIP_MEMORY_SCOPE_AGENT) == 0u) __builtin_amdgcn_s_sleep(1);
        __builtin_amdgcn_fence(__ATOMIC_ACQUIRE, "agent");
        asm volatile("s_waitcnt vmcnt(0)" ::: "memory");
      }
      __syncthreads();
    }
  }
  DI void end() const {
    if (mode == 1) {
      asm volatile("s_waitcnt vmcnt(0)" ::: "memory");
      __syncthreads();
      if (threadIdx.x == 0) {
        __builtin_amdgcn_fence(__ATOMIC_RELEASE, "agent");
        asm volatile("s_waitcnt vmcnt(0)" ::: "memory");
        __hip_atomic_store(flag, 1u, __ATOMIC_RELAXED, __HIP_MEMORY_SCOPE_AGENT);
      }
    }
  }
  struct Pre { float4 g, x; f32x4 pv; };
  DI Pre load(int m, int n) const {
    Pre q;
    q.pv = (f32x4){0.f, 0.f, 0.f, 0.f};
    if (mode == 1) { q.g = make_float4(0.f, 0.f, 0.f, 0.f); q.x = q.g; return q; }
    if (mode == 2) q.pv = *(const f32x4*)(part + (size_t)(m - brow) * 256 + (n - bcol));
    q.g = *(const float4*)(mod_l + (size_t)mod_index(m) * (6 * DM) + n);
    if (res_bf) {
      const u16* xr = m < NTC ? (const u16*)res_c + (size_t)m * DM : (const u16*)res_l + (size_t)(m - NTC) * DM;
      const uint2 r = *(const uint2*)(xr + n);
      q.x = make_float4(bf2f((u16)(r.x & 0xffff)), bf2f((u16)(r.x >> 16)), bf2f((u16)(r.y & 0xffff)), bf2f((u16)(r.y >> 16)));
    } else {
      const float* xr = m < NTC ? (const float*)res_c + (size_t)m * DM : (const float*)res_l + (size_t)(m - NTC) * DM;
      q.x = *(const float4*)(xr + n);
    }
    return q;
  }
  DI void store(int m, int n, f32x4 v, const Pre& q) const {
    if (mode == 1) {
      *(f32x4*)(part + (size_t)(m - brow) * 256 + (n - bcol)) = v;
      return;
    }
    v += q.pv;
    float4 r;
    r.x = q.x.x + q.g.x * v[0]; r.y = q.x.y + q.g.y * v[1]; r.z = q.x.z + q.g.z * v[2]; r.w = q.x.w + q.g.w * v[3];
    if (dst_bf) {
      uint2 o;
      o.x = pack2(r.x, r.y);
      o.y = pack2(r.z, r.w);
      *(uint2*)((u16*)dstp + (size_t)m * DM + n) = o;
    } else {
      *(float4*)((float*)dstp + (size_t)m * DM + n) = r;
    }
  }
};
DI void gemm_n2048(const Params& p, u16* smem, const u16* A, const u16* W, int K, EpiResid epi, unsigned* flags) {
#pragma unroll 1
  for (int it = blockIdx.x; it < 256; it += gridDim.x) {
    __syncthreads();
    int pm, pn;
    tile256_decode(it, 48, 8, pm, pn);
    gemm256_tile<false>(smem, A, W, K, K, pm * 256, pn * 256, epi);
  }
#pragma unroll 1
  for (int it = blockIdx.x; it < 256; it += gridDim.x) {
    __syncthreads();
    int pm, pn;
    tile256_decode(256 + (it >> 1), 48, 8, pm, pn);
    gemm256_tile<true>(smem, A, W, K, K, pm * 256, pn * 256 + (it & 1) * 128, epi);
  }
}
DI void phase_outproj(const Params& p, u16* smem, int l) {
  const EpiResid epi{p.mod + (size_t)l * 5 * 6 * DM + 2 * DM,
                     l == 0 ? (const void*)p.x_prompt : (const void*)p.x2b,
                     l == 0 ? (const void*)p.x_sample : (const void*)(p.x2b + (size_t)NTC * DM),
                     (void*)p.x1b, l == 0 ? 0 : 1, 1, 0, nullptr, nullptr, 0, 0};
  gemm_n2048(p, smem, p.o, p.WoutT + (size_t)l * DM * DM, DM, epi, p.flags + (l * 2 + 0) * 128);
}
DI void phase_gate(const Params& p, u16* smem, int l) {
  const u16* W = p.WgateT + (size_t)l * DFF * DM;
#pragma unroll 1
  for (int it = blockIdx.x; it < 256; it += gridDim.x) {
    __syncthreads();
    int pm, pn;
    tile256_decode(1024 + (it >> 3), 48, 22, pm, pn);
    const int n0p = pn * 256 + ((it >> 1) & 3) * 64;
    gemm_tile<1>(smem, p.h, DM, W, DM, DM, pm * 256 + (it & 1) * 128, n0p, n0p + 64, EpiBf16{p.g, DFF, 1.f});
  }
#pragma unroll 1
  for (int it = blockIdx.x; it < 1024; it += gridDim.x) {
    __syncthreads();
    int pm, pn;
    tile256_decode(it, 48, 22, pm, pn);
    gemm256_tile(smem, p.h, W, DM, DM, pm * 256, pn * 256, EpiBf16{p.g, DFF, 1.f});
  }
}
struct EpiUp {
  const float* wconv;
  const u16* gbuf;
  u16* abuf;
  struct Pre { uint2 c0, c1, c2; float4 w0, w1, w2; };
  DI void begin() const {}
  DI void end() const {}
  DI Pre load(int m, int n) const {
    Pre q;
    const float* wc = wconv + n;
    q.w0 = *(const float4*)wc; q.w1 = *(const float4*)(wc + DFF); q.w2 = *(const float4*)(wc + 2 * DFF);
    const int pos = m < NTC ? (m & 255) : ((m - NTC) & 2047);
    const int last = m < NTC ? 255 : 2047;
    const u16* gp = gbuf + (size_t)m * DFF + n;
    q.c1 = *(const uint2*)gp;
    q.c0 = make_uint2(0u, 0u);
    q.c2 = make_uint2(0u, 0u);
    if (pos > 0) q.c0 = *(const uint2*)(gp - DFF);
    if (pos < last) q.c2 = *(const uint2*)(gp + DFF);
    return q;
  }
  DI void store(int m, int n, f32x4 v, const Pre& q) const {
    float gg[4];
    gg[0] = bf2f((u16)(q.c0.x & 0xffff)) * q.w0.x + bf2f((u16)(q.c1.x & 0xffff)) * q.w1.x + bf2f((u16)(q.c2.x & 0xffff)) * q.w2.x;
    gg[1] = bf2f((u16)(q.c0.x >> 16)) * q.w0.y + bf2f((u16)(q.c1.x >> 16)) * q.w1.y + bf2f((u16)(q.c2.x >> 16)) * q.w2.y;
    gg[2] = bf2f((u16)(q.c0.y & 0xffff)) * q.w0.z + bf2f((u16)(q.c1.y & 0xffff)) * q.w1.z + bf2f((u16)(q.c2.y & 0xffff)) * q.w2.z;
    gg[3] = bf2f((u16)(q.c0.y >> 16)) * q.w0.w + bf2f((u16)(q.c1.y >> 16)) * q.w1.w + bf2f((u16)(q.c2.y >> 16)) * q.w2.w;
    float r[4];
#pragma unroll
    for (int i = 0; i < 4; ++i) r[i] = gg[i] / (1.f + __expf(-gg[i])) * v[i];
    uint2 o;
    o.x = pack2(r[0], r[1]);
    o.y = pack2(r[2], r[3]);
    *(uint2*)(abuf + (size_t)m * DFF + n) = o;
  }
};
DI void phase_up_ffn(const Params& p, u16* smem, int l) {
  const u16* W = p.WupT + (size_t)l * DFF * DM;
#pragma unroll 1
  for (int it = blockIdx.x; it < 256; it += gridDim.x) {
    __syncthreads();
    int pm, pn;
    tile256_decode(1024 + (it >> 3), 48, 22, pm, pn);
    const int n0p = pn * 256 + ((it >> 1) & 3) * 64;
    gemm_tile<1>(smem, p.h, DM, W, DM, DM, pm * 256 + (it & 1) * 128, n0p, n0p + 64, EpiUp{p.w_conv + (size_t)l * 3 * DFF, p.g, p.a});
  }
#pragma unroll 1
  for (int it = blockIdx.x; it < 1024; it += gridDim.x) {
    __syncthreads();
    int pm, pn;
    tile256_decode(it, 48, 22, pm, pn);
    gemm256_tile(smem, p.h, W, DM, DM, pm * 256, pn * 256, EpiUp{p.w_conv + (size_t)l * 3 * DFF, p.g, p.a});
  }
}
DI void phase_down(const Params& p, u16* smem, int l) {
  const EpiResid epi{p.mod + (size_t)l * 5 * 6 * DM + 5 * DM, (const void*)p.x1b, (const void*)(p.x1b + (size_t)NTC * DM),
                     l == 0 ? (void*)p.x2b : (void*)p.out, 1, l == 0 ? 1 : 0, 0, nullptr, nullptr, 0, 0};
  gemm_n2048(p, smem, p.a, p.WdownT + (size_t)l * DM * DFF, DFF, epi, p.flags + (l * 2 + 1) * 128);
}

constexpr int N_PHASES = 1 + 2 * 11;
DI void run_phase(const Params& p, u16* smem, int* s_item, int ph, int rep) {
#ifdef ONLY
  if (ONLY == 11) { phase_prep(p, smem); return; }
  const int l = ph & 1, s = ONLY;
#else
  if (ph == 0) { phase_prep(p, smem); return; }
  const int l = (ph - 1) / 11, s = (ph - 1) % 11;
#endif
  switch (s) {
    case 0: phase_modulate(p, l, 0); break;
    case 1: phase_qkv(p, smem, l); break;
    case 2: phase_post1(p, smem, l); break;
    case 3: phase_up(p, smem, l); break;
    case 4: phase_post2(p, l); break;
    case 5: phase_attn(p, smem, l, s_item, rep); break;
    case 6: phase_outproj(p, smem, l); break;
    case 7: phase_modulate(p, l, 1); break;
    case 8: phase_gate(p, smem, l); break;
    case 9: phase_up_ffn(p, smem, l); break;
    default: phase_down(p, smem, l); break;
  }
}

#if MEGA
DI void grid_bar(unsigned* bw, unsigned gen, lds_uint* s_nloc_p) {
  asm volatile("s_waitcnt vmcnt(0)" ::: "memory");
  __syncthreads();
  if (threadIdx.x == 0) {
    const unsigned xc = (unsigned)__builtin_amdgcn_s_getreg((3 << 11) | 20) & 0xFu;
    const unsigned nloc = *(volatile lds_uint*)s_nloc_p;
    const unsigned old = __hip_atomic_fetch_add(bw + 64 + 64 * xc, 1u, __ATOMIC_RELAXED, __HIP_MEMORY_SCOPE_AGENT);
    if (old + 1u == gen * nloc) {
      __builtin_amdgcn_fence(__ATOMIC_RELEASE, "agent");
      asm volatile("s_waitcnt vmcnt(0)" ::: "memory");
      __hip_atomic_fetch_add(bw, nloc, __ATOMIC_RELAXED, __HIP_MEMORY_SCOPE_AGENT);
    }
    const unsigned target = gen * gridDim.x;
    while (__hip_atomic_load(bw, __ATOMIC_RELAXED, __HIP_MEMORY_SCOPE_AGENT) < target) __builtin_amdgcn_s_sleep(1);
    __builtin_amdgcn_fence(__ATOMIC_ACQUIRE, "agent");
    asm volatile("s_waitcnt vmcnt(0)" ::: "memory");
  }
  __syncthreads();
}

__global__ void __launch_bounds__(NTHR) mega_kernel(Params p) {
  __shared__ __attribute__((aligned(16))) u16 smem[65536];
  __shared__ int s_item;
  cg::grid_group grid = cg::this_grid();
  unsigned* bar = p.barw;
  __shared__ unsigned s_nloc;
  if (threadIdx.x == 0) {
    const unsigned xc = (unsigned)__builtin_amdgcn_s_getreg((3 << 11) | 20) & 0xFu;
    __hip_atomic_fetch_add(bar + 1536 + 16 * xc, 1u, __ATOMIC_RELAXED, __HIP_MEMORY_SCOPE_AGENT);
  }
  unsigned nbar = 0;
#pragma unroll 1
  for (int ph = 0; ph < N_PHASES; ++ph) {
    run_phase(p, smem, &s_item, ph, 0);
#ifdef DUP_MASK
    {
      const int ty = ph == 0 ? 11 : (ph - 1) % 11;
      if ((DUP_MASK >> ty) & 1) { ++nbar; grid_bar(bar, nbar, (lds_uint*)&s_nloc); run_phase(p, smem, &s_item, ph, 1); }
    }
#endif
    if (ph == 0) {
      grid.sync();
      if (threadIdx.x == 0) {
        const unsigned xc = (unsigned)__builtin_amdgcn_s_getreg((3 << 11) | 20) & 0xFu;
        s_nloc = __hip_atomic_load(bar + 1536 + 16 * xc, __ATOMIC_RELAXED, __HIP_MEMORY_SCOPE_AGENT);
      }
      __syncthreads();
    } else if (ph + 1 < N_PHASES) { ++nbar; grid_bar(bar, nbar, (lds_uint*)&s_nloc); }
  }
}
#else
__global__ void __launch_bounds__(NTHR) phase_kernel(Params p, int ph) {
  __shared__ __attribute__((aligned(16))) u16 smem[65536];
  __shared__ int s_item;
  run_phase(p, smem, &s_item, ph, 0);
}
#endif

extern "C" void kernel_launch(void* const* d_in, const int* in_sizes, int n_in, void* d_out, int out_size, void* d_ws,
                              size_t ws_size, hipStream_t stream) {
  Params p{};
  const float** pi = (const float**)&p;
  for (int i = 0; i < 32; ++i) pi[i] = (const float*)d_in[i];
  p.out = (float*)d_out;
  char* w = (char*)d_ws;
  size_t off = 0;
  auto take = [&](size_t bytes) { char* r = w + off; off += (bytes + 255) & ~(size_t)255; return r; };
  p.WinT = (u16*)take((size_t)2 * RLD * DM * 2);
  p.WqupT = (u16*)take((size_t)2 * 768 * 384 * 2);
  p.WkvupT = (u16*)take((size_t)2 * 1024 * 128 * 2);
  p.WoutT = (u16*)take((size_t)2 * DM * DM * 2);
  p.WgateT = (u16*)take((size_t)2 * DFF * DM * 2);
  p.WupT = (u16*)take((size_t)2 * DFF * DM * 2);
  p.WdownT = (u16*)take((size_t)2 * DM * DFF * 2);
  p.trig128 = (u16*)take(256 * 128 * 2);
  p.W256 = (u16*)take(256 * 512 * 2);
  p.W2048 = (u16*)take((size_t)2048 * 4096 * 2);
  p.mod = (float*)take((size_t)2 * 5 * 6 * DM * 4);
  p.ctr = (int*)take(256);
  p.flags = (unsigned*)take(512 * 4);
  p.barw = (unsigned*)take(2048 * 4);
  p.x1b = (u16*)take((size_t)NT * DM * 2);
  p.x2b = (u16*)take((size_t)NT * DM * 2);
  p.h = (u16*)take((size_t)NT * DM * 2);
  const size_t att0 = off;
  p.raw = (u16*)take((size_t)NT * RLD * 2);
  p.Qa = (u16*)take((size_t)NT * 512 * 2);
  p.Ka = (u16*)take((size_t)NTA * 512 * 2);
  p.VaT = (u16*)take((size_t)512 * NTA * 2);
  p.Qw = (u16*)take((size_t)NT * 512 * 2);
  p.Kw = (u16*)take((size_t)NTA * 128 * 2);
  p.VwT = (u16*)take((size_t)128 * NTA * 2);
  p.cq = (u16*)take((size_t)NT * 384 * 2);
  p.ckv = (u16*)take((size_t)NTA * 128 * 2);
  p.krope = (u16*)take((size_t)NTA * 64 * 2);
  p.qmraw = (u16*)take((size_t)NT * 768 * 2);
  p.kvraw = (u16*)take((size_t)NTA * 1024 * 2);
  p.Qm = (u16*)take((size_t)NT * 768 * 2);
  p.Km = (u16*)take((size_t)NTA * 768 * 2);
  p.VmT = (u16*)take((size_t)512 * NTA * 2);
  p.ZtC = (u16*)take((size_t)64 * 128 * 512 * 2);
  p.ZtL = (u16*)take((size_t)16 * 128 * 4096 * 2);
  p.o = (u16*)take((size_t)NT * DM * 2);
  const size_t att1 = off;
  off = att0;
  p.g = (u16*)take((size_t)NT * DFF * 2);
  p.a = (u16*)take((size_t)NT * DFF * 2);
  if (off < att1) off = att1;
  p.part = (float*)take((size_t)128 * 65536 * 4);
  if (off > ws_size) fprintf(stderr, "workspace too small: need %zu have %zu\n", off, ws_size);

#if MEGA
  (void)hipMemsetAsync(p.barw, 0, 2048 * 4, stream);
  static int grid_blocks = 0;
  if (!grid_blocks) {
    int dev = 0, cus = 0, per_cu = 0;
    hipGetDevice(&dev);
    hipDeviceGetAttribute(&cus, hipDeviceAttributeMultiprocessorCount, dev);
    (void)hipOccupancyMaxActiveBlocksPerMultiprocessor(&per_cu, mega_kernel, NTHR, 0);
    grid_blocks = cus * per_cu;
  }
  void* args[] = {&p};
  hipError_t e = hipLaunchCooperativeKernel((void*)mega_kernel, dim3(grid_blocks), dim3(NTHR), args, 0, stream);
  if (e != hipSuccess) fprintf(stderr, "cooperative launch failed: %s (grid %d)\n", hipGetErrorString(e), grid_blocks);
#else
  for (int ph = 0; ph < N_PHASES; ++ph) phase_kernel<<<dim3(256), dim3(NTHR), 0, stream>>>(p, ph);
#endif
}
```

```cpp
#include <hip/hip_runtime.h>
#include <hip/hip_cooperative_groups.h>
#include <cstdio>
#include <cstdint>
namespace cg = cooperative_groups;

#ifndef MEGA
#define MEGA 1
#endif

typedef unsigned short u16;
using bf16x8 = __attribute__((ext_vector_type(8))) short;
using bf16x4 = __attribute__((ext_vector_type(4))) short;
using f32x4 = __attribute__((ext_vector_type(4))) float;
using f32x16 = __attribute__((ext_vector_type(16))) float;

#define DI __device__ __forceinline__
typedef __attribute__((address_space(3))) unsigned lds_uint;
#define LOG2E 1.4426950408889634f
#define EPSV 1e-6f

constexpr int NT = 12288;
constexpr int NTC = 4096;
constexpr int NTA = 14336;
constexpr int DM = 2048;
constexpr int INC = 3392;
constexpr int RLD = 3584;
constexpr int NTHR = 512;
constexpr int DFF = 5632;
constexpr int C_AQ = 0, C_AK = 512, C_AV = 1024, C_MQ = 1536, C_CKV = 1920, C_KR = 2048, C_CQ = 2112, C_CK = 2624, C_CV = 2752, C_FV = 2880;

struct Params {
  const float *x_prompt, *x_sample, *cache_na_k, *cache_na_v, *cache_mla_ckv, *cache_mla_krope, *cache_win_k, *cache_win_v,
      *c, *c_ctx, *w_mod, *b_mod, *g_mix, *g_ffn, *w_in, *g_qn_na, *g_kn_na, *rpb_na, *g_q_lora, *w_q_up, *g_kv_lora,
      *w_kv_up, *g_qn_mla, *g_kn_mla, *g_qn_win, *g_kn_win, *sink_win, *w_out, *w_gate, *w_up, *w_conv, *w_down;
  float* out;
  u16 *WinT, *WqupT, *WkvupT, *WoutT, *WgateT, *WupT, *WdownT;
  u16 *trig128, *W2048, *W256;
  float* mod;
  u16 *h, *raw, *Qa, *Ka, *VaT, *Qw, *Kw, *VwT, *cq, *ckv, *krope, *qmraw, *kvraw, *Qm, *Km, *VmT, *ZtC, *ZtL, *o, *g, *a;
  u16* x1b;
  u16* x2b;
  int* ctr;
  unsigned* flags;
  float* part;
  unsigned* barw;
};

typedef __bf16 bf16n2 __attribute__((ext_vector_type(2)));
typedef float f32n2 __attribute__((ext_vector_type(2)));
DI unsigned pack2(float a, float b) {
  const f32n2 v = {a, b};
  return __builtin_bit_cast(unsigned, __builtin_convertvector(v, bf16n2));
}
DI u16 f2bf(float x) { return (u16)(pack2(x, 0.f) & 0xffffu); }
DI float bf2f(u16 b) { return __uint_as_float(((unsigned)b) << 16); }
#define DPP_F(v, ctrl, row_mask) \
  __builtin_bit_cast(float, __builtin_amdgcn_update_dpp(0, __builtin_bit_cast(int, (v)), (ctrl), (row_mask), 0xF, false))
DI float wave_sum(float v) {
  v += DPP_F(v, 0xB1, 0xF);
  v += DPP_F(v, 0x4E, 0xF);
  v += DPP_F(v, 0x141, 0xF);
  v += DPP_F(v, 0x140, 0xF);
  v += DPP_F(v, 0x142, 0xA);
  v += DPP_F(v, 0x143, 0xC);
  return __builtin_bit_cast(float, __builtin_amdgcn_readlane(__builtin_bit_cast(int, v), 63));
}
DI int tid_opaque() { int t = threadIdx.x; asm volatile("" : "+v"(t)); return t; }
DI int mod_index(int row) { return row < NTC ? 0 : 1 + ((row - NTC) >> 11); }
DI const float* xin_row(const Params& p, int l, int row) {
  if (l == 0) return row < NTC ? p.x_prompt + (size_t)row * DM : p.x_sample + (size_t)(row - NTC) * DM;
  return p.out + (size_t)row * DM;
}

template <int NI = 2, class Epi>
DI void gemm_tile(u16* smem, const u16* __restrict__ A, int lda, const u16* __restrict__ Bt, int ldb, int K, int m0,
                  int n0, int N, Epi epi) {
  const int TIDX = tid_opaque();
  const int tid = TIDX, lane = tid & 63, wid = tid >> 6;
  const int wr = wid >> 2, wc = wid & 3, fr = lane & 15, fq = lane >> 4;
  constexpr int WN = 16 * NI;
  const int lr = tid >> 3, lc = tid & 7;
  u16* As = smem;
  u16* Bs = smem + 16384;
  f32x4 acc[4][NI];
#pragma unroll
  for (int i = 0; i < 4; ++i)
#pragma unroll
    for (int j = 0; j < NI; ++j) acc[i][j] = (f32x4){0.f, 0.f, 0.f, 0.f};
  const u16* ap = A + (size_t)(m0 + lr) * lda + lc * 8;
  const size_t a64 = (size_t)64 * lda;
  const int rn0 = min(n0 + lr, N - 1), rn1 = NI == 2 ? min(n0 + lr + 64, N - 1) : rn0;
  const u16* bp0 = Bt + (size_t)rn0 * ldb + lc * 8;
  const u16* bp1 = Bt + (size_t)rn1 * ldb + lc * 8;
  const int nt = K >> 6;
  uint4 ra0 = *(const uint4*)(ap), ra1 = *(const uint4*)(ap + a64);
  uint4 rb0 = *(const uint4*)(bp0), rb1 = *(const uint4*)(bp1);
  uint4 sa0 = ra0, sa1 = ra1, sb0 = rb0, sb1 = rb1;
  if (nt > 1) {
    sa0 = *(const uint4*)(ap + 64); sa1 = *(const uint4*)(ap + a64 + 64);
    sb0 = *(const uint4*)(bp0 + 64); sb1 = *(const uint4*)(bp1 + 64);
  }
  const int st_off = lr * 64 + ((lc ^ ((lr >> 1) & 7)) << 3);
  const int sw = (fr >> 1) & 7;
#define GT_COMPUTE(as, bs)                                                                              \
  _Pragma("unroll") for (int ks = 0; ks < 2; ++ks) {                                                    \
    bf16x8 af[4], bfv[NI];                                                                               \
    const int pc = ((ks * 4 + fq) ^ sw) << 3;                                                           \
    _Pragma("unroll") for (int mi = 0; mi < 4; ++mi) af[mi] = *(const bf16x8*)((as) + (wr * 64 + mi * 16 + fr) * 64 + pc); \
    _Pragma("unroll") for (int ni = 0; ni < NI; ++ni) bfv[ni] = *(const bf16x8*)((bs) + (wc * WN + ni * 16 + fr) * 64 + pc); \
    _Pragma("unroll") for (int mi = 0; mi < 4; ++mi)                                                    \
      _Pragma("unroll") for (int ni = 0; ni < NI; ++ni)                                                 \
        acc[mi][ni] = __builtin_amdgcn_mfma_f32_16x16x32_bf16(bfv[ni], af[mi], acc[mi][ni], 0, 0, 0);   \
  }
  for (int t = 0; t < nt; t += 2) {
    {
      u16* as = As;
      u16* bs = Bs;
      *(uint4*)(as + st_off) = ra0;
      *(uint4*)(as + st_off + 4096) = ra1;
      *(uint4*)(bs + st_off) = rb0;
      *(uint4*)(bs + st_off + 4096) = rb1;
      __syncthreads();
      if (t + 2 < nt) {
        const int ko = (t + 2) << 6;
        ra0 = *(const uint4*)(ap + ko);
        ra1 = *(const uint4*)(ap + a64 + ko);
        rb0 = *(const uint4*)(bp0 + ko);
        rb1 = *(const uint4*)(bp1 + ko);
      }
      GT_COMPUTE(as, bs)
    }
    if (t + 1 < nt) {
      u16* as = As + 8192;
      u16* bs = Bs + 8192;
      *(uint4*)(as + st_off) = sa0;
      *(uint4*)(as + st_off + 4096) = sa1;
      *(uint4*)(bs + st_off) = sb0;
      *(uint4*)(bs + st_off + 4096) = sb1;
      __syncthreads();
      if (t + 3 < nt) {
        const int ko = (t + 3) << 6;
        sa0 = *(const uint4*)(ap + ko);
        sa1 = *(const uint4*)(ap + a64 + ko);
        sb0 = *(const uint4*)(bp0 + ko);
        sb1 = *(const uint4*)(bp1 + ko);
      }
      GT_COMPUTE(as, bs)
    }
  }
#undef GT_COMPUTE
  epi.begin();
  {
    typename Epi::Pre pre[4][NI];
#pragma unroll
    for (int mi = 0; mi < 4; ++mi)
#pragma unroll
      for (int ni = 0; ni < NI; ++ni) {
        const int m = m0 + wr * 64 + mi * 16 + fr;
        const int n = n0 + wc * WN + ni * 16 + fq * 4;
        if (n < N) pre[mi][ni] = epi.load(m, n);
      }
#pragma unroll
    for (int mi = 0; mi < 4; ++mi)
#pragma unroll
      for (int ni = 0; ni < NI; ++ni) {
        const int m = m0 + wr * 64 + mi * 16 + fr;
        const int n = n0 + wc * WN + ni * 16 + fq * 4;
        if (n < N) epi.store(m, n, acc[mi][ni], pre[mi][ni]);
      }
  }
  epi.end();
}

constexpr int G_HT = 128 * 64;
DI int lds_byte(int r, int c) {
  const int st = (r >> 4) * 2 + (c >> 5), rr = r & 15, cc = c & 31, ob = rr * 64 + cc * 2;
  return st * 1024 + (ob ^ (((ob >> 9) & 1) << 5));
}
DI void stage_rc(int b, int& R, int& C) {
  const int st = b / 1024, sb = b % 1024, swz = sb ^ (((sb >> 9) & 1) << 5);
  R = (st >> 1) * 16 + swz / 64;
  C = (st & 1) * 32 + (swz % 64) / 2;
}
template <bool HALF = false, class Epi>
DI void gemm256_tile(u16* shm, const u16* __restrict__ A, const u16* __restrict__ Bt, int K, int ld, int brow, int bcol, Epi epi) {
  const int TIDX = tid_opaque();
#define SA(b, h) (shm + ((b) * 2 + (h)) * G_HT)
#define SB(b, h) (shm + (4 + (b) * 2 + (h)) * G_HT)
#define STAGE(P, BASE, br, kt)                                                                          \
  do {                                                                                                  \
    const char* _ub = (const char*)((BASE) + (long)(br) * ld + (long)(kt) * 64);                         \
    __builtin_amdgcn_global_load_lds((const unsigned*)(_ub + voff0),                                    \
                                     (__attribute__((address_space(3))) unsigned*)((char*)(P) + TIDX * 16), 16, 0, 0); \
    __builtin_amdgcn_global_load_lds((const unsigned*)(_ub + voff1),                                    \
                                     (__attribute__((address_space(3))) unsigned*)((char*)(P) + TIDX * 16 + 8192), 16, 0, 0); \
  } while (0)
#define LDA(dst, b, h)                                                                                  \
  for (int m = 0; m < 4; ++m)                                                                           \
    for (int k = 0; k < 2; ++k)                                                                         \
      dst[m][k] = *reinterpret_cast<const bf16x8*>(lds_a + (((b) * 2 + (h)) * 16384 + m * 2048 + k * 1024))
#define LDB(dst, b, h)                                                                                  \
  for (int n = 0; n < 2; ++n)                                                                           \
    for (int k = 0; k < 2; ++k)                                                                         \
      dst[n][k] = *reinterpret_cast<const bf16x8*>(lds_b + (((b) * 2 + (h)) * 16384 + n * 2048 + k * 1024))
#define MMA(ai, bj, At, Bv)                                                                             \
  if (!(HALF && (bj) == 1)) do {                                                                        \
    __builtin_amdgcn_s_setprio(1);                                                                      \
    for (int m = 0; m < 4; ++m)                                                                         \
      for (int n = 0; n < 2; ++n)                                                                       \
        for (int k = 0; k < 2; ++k)                                                                     \
          acc[ai][bj][m][n] = __builtin_amdgcn_mfma_f32_16x16x32_bf16(Bv[n][k], At[m][k], acc[ai][bj][m][n], 0, 0, 0); \
    __builtin_amdgcn_s_setprio(0);                                                                      \
  } while (0)
#define WAIT_V(n) asm volatile("s_waitcnt vmcnt(" #n ")" ::: "memory")
#define WAIT_L(n) asm volatile("s_waitcnt lgkmcnt(" #n ")" ::: "memory")
#define BAR __builtin_amdgcn_s_barrier()
#define SCHED __builtin_amdgcn_sched_barrier(0)
  const int wid = TIDX >> 6, lane = TIDX & 63, wr = wid >> 2, wc = wid & 3, fr = lane & 15, fq = lane >> 4;
  f32x4 acc[2][2][4][2];
#pragma unroll
  for (int a = 0; a < 2; ++a)
#pragma unroll
    for (int b = 0; b < 2; ++b)
#pragma unroll
      for (int m = 0; m < 4; ++m)
#pragma unroll
        for (int n = 0; n < 2; ++n) acc[a][b][m][n] = (f32x4){0.f, 0.f, 0.f, 0.f};
  bf16x8 At[4][2], B0[2][2], B1[2][2];
  const int nt = K / 64;
  const int swz_ = (fr * 64 + fq * 16) ^ ((((fr * 64 + fq * 16) >> 9) & 1) << 5);
  const char* lds_a = (const char*)shm + wr * 8192 + swz_;
  const char* lds_b = (const char*)shm + 65536 + wc * 4096 + swz_;
  unsigned voff0, voff1;
  {
    int r_, c_;
    stage_rc(TIDX * 16, r_, c_);
    voff0 = (unsigned)(r_ * ld + c_) * 2u;
    stage_rc(TIDX * 16 + 8192, r_, c_);
    voff1 = (unsigned)(r_ * ld + c_) * 2u;
  }
  STAGE(SB(0, 0), Bt, bcol, 0); STAGE(SA(0, 0), A, brow, 0);
  STAGE(SB(0, 1), Bt, bcol + 128, 0); STAGE(SA(0, 1), A, brow + 128, 0);
  if (wr == 1) BAR;
  WAIT_V(4); BAR;
  STAGE(SB(1, 0), Bt, bcol, 1); STAGE(SA(1, 0), A, brow, 1); STAGE(SB(1, 1), Bt, bcol + 128, 1);
  WAIT_V(6); BAR;
  for (int t = 0; t < nt - 2; t += 2) {
    LDB(B0, 0, 0); SCHED; LDA(At, 0, 0); STAGE(SA(1, 1), A, brow + 128, t + 1);
    WAIT_L(8); BAR; WAIT_L(0); MMA(0, 0, At, B0); BAR; SCHED;
    LDB(B1, 0, 1); STAGE(SB(0, 0), Bt, bcol, t + 2);
    BAR; WAIT_L(0); MMA(0, 1, At, B1); BAR;
    LDA(At, 0, 1); STAGE(SA(0, 0), A, brow, t + 2);
    BAR; WAIT_L(0); MMA(1, 0, At, B0); BAR; SCHED;
    STAGE(SB(0, 1), Bt, bcol + 128, t + 2);
    WAIT_V(6); BAR; MMA(1, 1, At, B1); BAR;
    LDB(B0, 1, 0); SCHED; LDA(At, 1, 0); STAGE(SA(0, 1), A, brow + 128, t + 2);
    WAIT_L(8); BAR; WAIT_L(0); MMA(0, 0, At, B0); BAR; SCHED;
    LDB(B1, 1, 1); STAGE(SB(1, 0), Bt, bcol, t + 3);
    BAR; WAIT_L(0); MMA(0, 1, At, B1); BAR;
    LDA(At, 1, 1); STAGE(SA(1, 0), A, brow, t + 3);
    BAR; WAIT_L(0); MMA(1, 0, At, B0); BAR; SCHED;
    STAGE(SB(1, 1), Bt, bcol + 128, t + 3);
    WAIT_V(6); BAR; MMA(1, 1, At, B1); BAR;
  }
  { LDB(B0, 0, 0); LDA(At, 0, 0); STAGE(SA(1, 1), A, brow + 128, nt - 1);
    BAR; WAIT_L(0); MMA(0, 0, At, B0); BAR;
    LDB(B1, 0, 1); BAR; WAIT_L(0); MMA(0, 1, At, B1); BAR;
    LDA(At, 0, 1); WAIT_V(4); BAR; WAIT_L(0); MMA(1, 0, At, B0); MMA(1, 1, At, B1); BAR; }
  { LDB(B0, 1, 0); LDA(At, 1, 0); WAIT_V(2); BAR; WAIT_L(0); MMA(0, 0, At, B0); BAR;
    LDB(B1, 1, 1); WAIT_V(0); BAR; WAIT_L(0); MMA(0, 1, At, B1); BAR;
    LDA(At, 1, 1); BAR; WAIT_L(0); MMA(1, 0, At, B0); MMA(1, 1, At, B1); BAR; }
  if (wr == 0) BAR;
  epi.begin();
#pragma unroll
  for (int ai = 0; ai < 2; ++ai)
#pragma unroll
    for (int m = 0; m < 4; ++m) {
      const int row = brow + ai * 128 + wr * 64 + m * 16 + fr;
      typename Epi::Pre pre[2][2];
#pragma unroll
      for (int bj = 0; bj < (HALF ? 1 : 2); ++bj)
#pragma unroll
        for (int n = 0; n < 2; ++n) pre[bj][n] = epi.load(row, bcol + bj * 128 + wc * 32 + n * 16 + fq * 4);
#pragma unroll
      for (int bj = 0; bj < (HALF ? 1 : 2); ++bj)
#pragma unroll
        for (int n = 0; n < 2; ++n) epi.store(row, bcol + bj * 128 + wc * 32 + n * 16 + fq * 4, acc[ai][bj][m][n], pre[bj][n]);
    }
  epi.end();
#undef SA
#undef SB
#undef STAGE
#undef LDA
#undef LDB
#undef MMA
}

struct EpiBf16 {
  u16* C;
  int ldc;
  float scale;
  struct Pre {};
  DI void begin() const {}
  DI void end() const {}
  DI Pre load(int, int) const { return Pre{}; }
  DI void store(int m, int n, f32x4 v, Pre) const {
    uint2 r;
    r.x = pack2(v[0] * scale, v[1] * scale);
    r.y = pack2(v[2] * scale, v[3] * scale);
    *(uint2*)(C + (size_t)m * ldc + n) = r;
  }
};

struct EpiBf16P {
  u16* C;
  int ldc;
  struct Pre {};
  DI void begin() const {}
  DI void end() const {}
  DI Pre load(int, int) const { return Pre{}; }
  DI void store(int m, int n, f32x4 v, Pre) const {
    const int np = (n & ~12) | ((n & 4) << 1) | ((n & 8) >> 1);
    uint2 r;
    r.x = pack2(v[0], v[1]);
    r.y = pack2(v[2], v[3]);
    *(uint2*)(C + (size_t)m * ldc + np) = r;
  }
};

struct EpiLdsF32 {
  float* lds;
  int m0;
  struct Pre {};
  DI void begin() const {}
  DI void end() const {}
  DI Pre load(int, int) const { return Pre{}; }
  DI void store(int m, int n, f32x4 v, Pre) const { *(f32x4*)(lds + (m - m0) * 128 + n) = v; }
};
struct EpiDftSym {
  const float* lds;
  int m0, S;
  u16* obase;
  int ldo;
  float scale;
  struct Pre { f32x4 pv; };
  DI void begin() const {}
  DI void end() const {}
  DI Pre load(int m, int n) const { Pre q; q.pv = *(const f32x4*)(lds + (m - m0) * 128 + n); return q; }
  DI void store(int m, int n, f32x4 v, const Pre& q) const {
    uint2 r;
    r.x = pack2((q.pv[0] + v[0]) * scale, (q.pv[1] + v[1]) * scale);
    r.y = pack2((q.pv[2] + v[2]) * scale, (q.pv[3] + v[3]) * scale);
    *(uint2*)(obase + (size_t)m * ldo + n) = r;
    if (m > 0) {
      r.x = pack2((q.pv[0] - v[0]) * scale, (q.pv[1] - v[1]) * scale);
      r.y = pack2((q.pv[2] - v[2]) * scale, (q.pv[3] - v[3]) * scale);
      *(uint2*)(obase + (size_t)(S - m) * ldo + n) = r;
    }
  }
};

DI void tile_decode(int t, int tilesN, int& tm, int& tn) {
  const int per = 8 * tilesN;
  const int grp = t / per, r = t - grp * per;
  tm = grp * 8 + (r & 7);
  tn = r >> 3;
}
DI void tile256_decode(int L, int nM, int nN, int& pm, int& pn) {
  const int nwg = nM * nN;
  int wgid = L;
  {
    const int q = nwg / 8, r = nwg % 8, xcd = wgid % 8, off = wgid / 8;
    wgid = (xcd < r ? xcd * (q + 1) : r * (q + 1) + (xcd - r) * q) + off;
  }
  const int nig = 4 * nM, gid = wgid / nig, fn = gid * 4, gsz = min(nN - fn, 4);
  pn = fn + ((wgid % nig) % gsz);
  pm = (wgid % nig) / gsz;
}

DI void prep_mod_item(const Params& p, u16* smem_u, int it) {
  const int TIDX = tid_opaque();
  float* sm = (float*)smem_u;
  float* red = sm + 5 * 2048;
  const int tid = TIDX;
  const int l = it / 384, n0 = (it % 384) * 32;
  for (int e = tid; e < 5 * 2048; e += NTHR) {
    const int j = e >> 11, k = e & 2047;
    const float v = j == 0 ? p.c_ctx[k] : p.c[(j - 1) * DM + k];
    sm[e] = v / (1.f + __expf(-v));
  }
  __syncthreads();
  const int cgp = tid & 7, kg = tid >> 3;
  float acc[5][4];
#pragma unroll
  for (int j = 0; j < 5; ++j)
#pragma unroll
    for (int q = 0; q < 4; ++q) acc[j][q] = 0.f;
  const float* wp = p.w_mod + (size_t)l * DM * (6 * DM) + (size_t)(kg * 32) * (6 * DM) + n0 + cgp * 4;
#pragma unroll 1
  for (int k0 = 0; k0 < 32; k0 += 16) {
    float4 w[16];
#pragma unroll
    for (int k = 0; k < 16; ++k) { const f32x4 t_ = __builtin_nontemporal_load((const f32x4*)(wp + (size_t)(k0 + k) * (6 * DM))); w[k] = make_float4(t_[0], t_[1], t_[2], t_[3]); }
#pragma unroll
    for (int k = 0; k < 16; ++k)
#pragma unroll
      for (int j = 0; j < 5; ++j) {
        const float s = sm[j * 2048 + kg * 32 + k0 + k];
        acc[j][0] += s * w[k].x; acc[j][1] += s * w[k].y; acc[j][2] += s * w[k].z; acc[j][3] += s * w[k].w;
      }
  }
#pragma unroll
  for (int j = 0; j < 5; ++j)
#pragma unroll
    for (int q = 0; q < 4; ++q) red[(kg * 8 + cgp) * 20 + j * 4 + q] = acc[j][q];
  __syncthreads();
  if (tid < 160) {
    const int j = tid >> 5, n = tid & 31;
    float s = p.b_mod[l * (6 * DM) + n0 + n];
#pragma unroll 8
    for (int g = 0; g < 64; ++g) s += red[(g * 8 + (n >> 2)) * 20 + j * 4 + (n & 3)];
    p.mod[((size_t)l * 5 + j) * (6 * DM) + n0 + n] = s;
  }
}

struct TrDesc { const float* src; u16* dst; int K, N, k0, n0; };
DI void transpose_load(const TrDesc& d, int tid, float4 (&v)[8]) {
  const int r = tid >> 4, c4 = tid & 15;
#pragma unroll
  for (int ps = 0; ps < 8; ++ps) {
    const f32x4 t_ = __builtin_nontemporal_load((const f32x4*)(d.src + (size_t)(d.k0 + r + 16 * ps) * d.N + d.n0 + c4 * 4));
    v[ps] = make_float4(t_[0], t_[1], t_[2], t_[3]);
  }
}
DI void transpose_finish(u16* smem_u, const TrDesc& d, int tid, const float4 (&v)[8]) {
  float* tile = (float*)smem_u;
  const int r = tid >> 4, c4 = tid & 15;
#pragma unroll
  for (int ps = 0; ps < 8; ++ps) {
    const int k = r + 16 * ps;
    tile[k * 65 + c4 * 4 + 0] = v[ps].x; tile[k * 65 + c4 * 4 + 1] = v[ps].y;
    tile[k * 65 + c4 * 4 + 2] = v[ps].z; tile[k * 65 + c4 * 4 + 3] = v[ps].w;
  }
  __syncthreads();
  const int n = tid >> 2, kq = tid & 3;
  unsigned w[16];
#pragma unroll
  for (int i = 0; i < 16; ++i) w[i] = pack2(tile[(kq * 32 + 2 * i) * 65 + n], tile[(kq * 32 + 2 * i + 1) * 65 + n]);
  uint4* o = (uint4*)(d.dst + (size_t)(d.n0 + n) * d.K + d.k0 + kq * 32);
  o[0] = make_uint4(w[0], w[1], w[2], w[3]);
  o[1] = make_uint4(w[4], w[5], w[6], w[7]);
  o[2] = make_uint4(w[8], w[9], w[10], w[11]);
  o[3] = make_uint4(w[12], w[13], w[14], w[15]);
}

DI void phase_prep(const Params& p, u16* smem_all) {
  const int TIDX = tid_opaque();
  constexpr int N_MOD = 768;
  constexpr int T_IN = 16 * 53, T_QUP = 3 * 12, T_KVUP = 1 * 16, T_OUT = 16 * 32, T_G = 16 * 88, T_D = 44 * 32;
  constexpr int T_LAYER = T_IN + T_QUP + T_KVUP + T_OUT + 2 * T_G + T_D;
  constexpr int N_TR = 2 * T_LAYER;
  constexpr int N_TRIG = 2088 + 192;
  const int total = N_MOD + N_TR + N_TRIG;
  const int half = TIDX >> 8, tid = TIDX & 255;
  u16* smem = smem_all + half * 32768;
  if (blockIdx.x == 0 && TIDX < 32) p.ctr[TIDX] = 0;
  if (blockIdx.x == 0) p.flags[TIDX] = 0u;
  for (int it = blockIdx.x; it < N_MOD; it += gridDim.x) {
    __syncthreads();
    prep_mod_item(p, smem_all, it);
  }
  {
    auto decode = [&](int t) {
      TrDesc d;
      const int l = t / T_LAYER;
      t -= l * T_LAYER;
      if (t < T_IN) { d.src = p.w_in + (size_t)l * DM * INC; d.dst = p.WinT + (size_t)l * RLD * DM; d.K = DM; d.N = INC; }
      else if ((t -= T_IN) < T_QUP) { d.src = p.w_q_up + (size_t)l * 384 * 768; d.dst = p.WqupT + (size_t)l * 768 * 384; d.K = 384; d.N = 768; }
      else if ((t -= T_QUP) < T_KVUP) { d.src = p.w_kv_up + (size_t)l * 128 * 1024; d.dst = p.WkvupT + (size_t)l * 1024 * 128; d.K = 128; d.N = 1024; }
      else if ((t -= T_KVUP) < T_OUT) { d.src = p.w_out + (size_t)l * DM * DM; d.dst = p.WoutT + (size_t)l * DM * DM; d.K = DM; d.N = DM; }
      else if ((t -= T_OUT) < T_G) { d.src = p.w_gate + (size_t)l * DM * DFF; d.dst = p.WgateT + (size_t)l * DFF * DM; d.K = DM; d.N = DFF; }
      else if ((t -= T_G) < T_G) { d.src = p.w_up + (size_t)l * DM * DFF; d.dst = p.WupT + (size_t)l * DFF * DM; d.K = DM; d.N = DFF; }
      else { t -= T_G; d.src = p.w_down + (size_t)l * DFF * DM; d.dst = p.WdownT + (size_t)l * DM * DFF; d.K = DFF; d.N = DM; }
      const int tilesN = d.N >> 6;
      const int tk = t / tilesN, tn = t - tk * tilesN;
      d.k0 = tk * 128;
      d.n0 = tn * 64;
      return d;
    };
    int t = blockIdx.x * 2 + half;
    const int tstep = gridDim.x * 2;
    float4 va[8], vb[8];
    TrDesc da, db;
    if (t < N_TR) { da = decode(t); transpose_load(da, tid, va); }
#pragma unroll 1
    for (; t < N_TR; t += 2 * tstep) {
      const bool hb = t + tstep < N_TR;
      if (hb) { db = decode(t + tstep); transpose_load(db, tid, vb); }
      __syncthreads();
      transpose_finish(smem, da, tid, va);
      if (hb) {
        const bool ha = t + 2 * tstep < N_TR;
        if (ha) { da = decode(t + 2 * tstep); transpose_load(da, tid, va); }
        __syncthreads();
        transpose_finish(smem, db, tid, vb);
      }
    }
  }
  for (int it = N_MOD + N_TR + blockIdx.x * 2 + half; it < total; it += gridDim.x * 2) {
    {
      const int t = it - N_MOD - N_TR;
#pragma unroll 1
      for (int q = 0; q < 16; ++q) {
        int e = t * 4096 + q * 256 + tid;
        if (e < 32768) {
          const int j = e >> 7, c = e & 127;
          const int jj = j & 127;
          const float x = (float)((jj * c) & 127) * (1.f / 64.f);
          float sn, cs;
          sincospif(x, &sn, &cs);
          p.trig128[e] = f2bf(j < 128 ? cs : sn);
        } else if ((e -= 32768) < 131072) {
          const int k = e >> 9, s2 = e & 511, s = s2 & 255;
          const float x = (float)((k * s) & 255) * (1.f / 128.f);
          float sn, cs;
          sincospif(x, &sn, &cs);
          p.W256[e] = f2bf(s2 < 256 ? cs : -sn);
        } else if ((e -= 131072) < 8388608) {
          const int k = e >> 12, s2 = e & 4095, s = s2 & 2047;
          const float x = (float)((k * s) & 2047) * (1.f / 1024.f);
          float sn, cs;
          sincospif(x, &sn, &cs);
          p.W2048[e] = f2bf(s2 < 2048 ? cs : -sn);
        } else {
          e -= 8388608;
          const int l = e / (192 * 2048), r = e - l * (192 * 2048);
          p.WinT[(size_t)l * RLD * DM + (size_t)INC * DM + r] = 0;
        }
      }
    }
  }
}

DI void load_row32(const float* xf, const u16* xb, int lane, float4 (&v)[8]) {
  if (xb) {
#pragma unroll
    for (int i = 0; i < 4; ++i) {
      const uint4 r = *(const uint4*)(xb + i * 512 + lane * 8);
      v[2 * i] = make_float4(bf2f((u16)(r.x & 0xffff)), bf2f((u16)(r.x >> 16)), bf2f((u16)(r.y & 0xffff)), bf2f((u16)(r.y >> 16)));
      v[2 * i + 1] = make_float4(bf2f((u16)(r.z & 0xffff)), bf2f((u16)(r.z >> 16)), bf2f((u16)(r.w & 0xffff)), bf2f((u16)(r.w >> 16)));
    }
  } else {
#pragma unroll
    for (int i = 0; i < 4; ++i) {
      v[2 * i] = *(const float4*)(xf + i * 512 + lane * 8);
      v[2 * i + 1] = *(const float4*)(xf + i * 512 + lane * 8 + 4);
    }
  }
}
DI void phase_modulate(const Params& p, int l, int which) {
  const int TIDX = tid_opaque();
  const int lane = TIDX & 63, wid = TIDX >> 6;
  const float* gain = (which ? p.g_ffn : p.g_mix) + l * DM;
  const u16* xbsrc = which ? p.x1b : (l == 0 ? nullptr : p.x2b);
  for (int it = blockIdx.x; it < NT / 16; it += gridDim.x) {
    const int row0 = it * 16 + wid * 2;
    float4 va[8], vb[8];
    load_row32(xbsrc ? nullptr : xin_row(p, 0, row0), xbsrc ? xbsrc + (size_t)row0 * DM : nullptr, lane, va);
    load_row32(xbsrc ? nullptr : xin_row(p, 0, row0 + 1), xbsrc ? xbsrc + (size_t)(row0 + 1) * DM : nullptr, lane, vb);
    float sa = 0.f, sb = 0.f;
#pragma unroll
    for (int i = 0; i < 8; ++i) {
      sa += va[i].x * va[i].x + va[i].y * va[i].y + va[i].z * va[i].z + va[i].w * va[i].w;
      sb += vb[i].x * vb[i].x + vb[i].y * vb[i].y + vb[i].z * vb[i].z + vb[i].w * vb[i].w;
    }
    sa = wave_sum(sa);
    sb = wave_sum(sb);
    const float ra = rsqrtf(sa * (1.f / DM) + EPSV), rb = rsqrtf(sb * (1.f / DM) + EPSV);
    const float* md = p.mod + ((size_t)l * 5 + mod_index(row0)) * (6 * DM);
    const float* sh = md + (which ? 3 : 0) * DM;
    const float* sc = md + (which ? 4 : 1) * DM;
#pragma unroll
    for (int i = 0; i < 4; ++i) {
      const int c = i * 512 + lane * 8;
      uint4 oa, ob;
#pragma unroll
      for (int hf = 0; hf < 2; ++hf) {
        const int cc = c + hf * 4;
        const float4 g = *(const float4*)(gain + cc), s1 = *(const float4*)(sc + cc), s0 = *(const float4*)(sh + cc);
        const float gx = g.x * (1.f + s1.x), gy = g.y * (1.f + s1.y), gz = g.z * (1.f + s1.z), gw = g.w * (1.f + s1.w);
        const float4 a = va[2 * i + hf], b = vb[2 * i + hf];
        const unsigned a0 = pack2(a.x * ra * gx + s0.x, a.y * ra * gy + s0.y), a1 = pack2(a.z * ra * gz + s0.z, a.w * ra * gw + s0.w);
        const unsigned b0 = pack2(b.x * rb * gx + s0.x, b.y * rb * gy + s0.y), b1 = pack2(b.z * rb * gz + s0.z, b.w * rb * gw + s0.w);
        if (hf == 0) { oa.x = a0; oa.y = a1; ob.x = b0; ob.y = b1; } else { oa.z = a0; oa.w = a1; ob.z = b0; ob.w = b1; }
      }
      *(uint4*)(p.h + (size_t)row0 * DM + c) = oa;
      *(uint4*)(p.h + (size_t)(row0 + 1) * DM + c) = ob;
    }
  }
}

DI void phase_qkv(const Params& p, u16* smem, int l) {
  const u16* W = p.WinT + (size_t)l * RLD * DM;
#pragma unroll 1
  for (int it = blockIdx.x; it < 48 * 14; it += gridDim.x) {
    __syncthreads();
    int pm, pn;
    tile256_decode(it, 48, 14, pm, pn);
    gemm256_tile(smem, p.h, W, DM, DM, pm * 256, pn * 256, EpiBf16{p.raw, RLD, 1.f});
  }
}

DI float rope_apply(float y, float sn, float cs, int lane) {
  const float pr = __shfl_xor(y, 16);
  return (lane & 16) ? (pr * sn + y * cs) : (y * cs - pr * sn);
}
DI void rope_trig(int lane, int pos_row, int pos_col, float& sn, float& cs) {
  const int i = lane & 15;
  const float inv = exp2f(-(float)i * (13.287712379549449f / 16.f));
  const float ang = (float)((lane < 32) ? pos_row : pos_col) * inv;
  sincosf(ang, &sn, &cs);
}

DI void phase_post1(const Params& p, u16* smem, int l) {
  const int TIDX = tid_opaque();
  const int lane = TIDX & 63, wid = TIDX >> 6;
  float* o_nak = p.out + 25165824;
  float* o_nav = o_nak + 4194304;
  float* o_ckv = o_nav + 4194304;
  float* o_kr = o_ckv + 1048576;
  float* o_wk = o_kr + 524288;
  float* o_wv = o_wk + 1048576;
  for (int it = blockIdx.x; it < NTA / 8; it += gridDim.x) {
    const int tok = it * 8 + wid;
    if (tok < NT) {
      const u16* rp = p.raw + (size_t)tok * RLD + lane;
      u16 r[45];
#pragma unroll
      for (int i = 0; i < 45; ++i) r[i] = rp[i * 64];
      asm volatile("" ::: "memory");
      const bool ctx = tok < NTC;
      size_t ob = 0;
      float sn = 0.f, cs = 1.f;
      if (ctx) {
        const int b = tok >> 8, s = tok & 255;
        ob = (size_t)(b * 2 + l) * 256 + s;
      } else {
        const int pos = (tok - NTC) & 2047;
        rope_trig(lane, pos >> 6, pos & 63, sn, cs);
      }
      const float gq = p.g_qn_na[l * 64 + lane], gk = p.g_kn_na[l * 64 + lane];
#pragma unroll
      for (int h = 0; h < 8; ++h) {
        float v = bf2f(r[h]);
        float ss = wave_sum(v * v);
        p.Qa[(size_t)tok * 512 + h * 64 + lane] = f2bf(v * rsqrtf(ss * (1.f / 64.f) + EPSV) * gq * (0.125f * LOG2E));
        v = bf2f(r[8 + h]);
        ss = wave_sum(v * v);
        const float y = v * rsqrtf(ss * (1.f / 64.f) + EPSV) * gk;
        p.Ka[(size_t)tok * 512 + h * 64 + lane] = f2bf(y);
        if (ctx) {
          o_nak[(ob * 8 + h) * 64 + lane] = y;
          o_nav[(ob * 8 + h) * 64 + lane] = bf2f(r[16 + h]);
        }
      }
      {
        float v[6], ss = 0.f;
#pragma unroll
        for (int i = 0; i < 6; ++i) { v[i] = bf2f(r[24 + i]); ss += v[i] * v[i]; }
        ss = wave_sum(ss);
        const float rs = rsqrtf(ss * (1.f / 384.f) + EPSV);
#pragma unroll
        for (int i = 0; i < 6; ++i) p.cq[(size_t)tok * 384 + i * 64 + lane] = f2bf(v[i] * rs * p.g_q_lora[l * 384 + i * 64 + lane]);
      }
      {
        const float v0 = bf2f(r[30]), v1 = bf2f(r[31]);
        const float ss = wave_sum(v0 * v0 + v1 * v1);
        const float rs = rsqrtf(ss * (1.f / 128.f) + EPSV);
        const float y0 = v0 * rs * p.g_kv_lora[l * 128 + lane], y1 = v1 * rs * p.g_kv_lora[l * 128 + 64 + lane];
        p.ckv[(size_t)tok * 128 + lane] = f2bf(y0);
        p.ckv[(size_t)tok * 128 + 64 + lane] = f2bf(y1);
        if (ctx) { o_ckv[ob * 128 + lane] = y0; o_ckv[ob * 128 + 64 + lane] = y1; }
      }
      {
        p.krope[(size_t)tok * 64 + lane] = r[32];
        if (ctx) o_kr[ob * 64 + lane] = bf2f(r[32]);
      }
      const float gqw = p.g_qn_win[l * 64 + lane], gkw = p.g_kn_win[l * 64 + lane];
#pragma unroll
      for (int hq = 0; hq < 8; ++hq) {
        const float v = bf2f(r[33 + hq]);
        const float ss = wave_sum(v * v);
        float y = v * rsqrtf(ss * (1.f / 64.f) + EPSV) * gqw;
        if (!ctx) y = rope_apply(y, sn, cs, lane);
        p.Qw[(size_t)tok * 512 + hq * 64 + lane] = f2bf(y * (0.125f * LOG2E));
      }
#pragma unroll
      for (int kh = 0; kh < 2; ++kh) {
        const float v = bf2f(r[41 + kh]);
        const float ss = wave_sum(v * v);
        float y = v * rsqrtf(ss * (1.f / 64.f) + EPSV) * gkw;
        if (ctx) {
          o_wk[(ob * 2 + kh) * 64 + lane] = y;
          o_wv[(ob * 2 + kh) * 64 + lane] = bf2f(r[43 + kh]);
        } else {
          y = rope_apply(y, sn, cs, lane);
        }
        p.Kw[(size_t)tok * 128 + kh * 64 + lane] = f2bf(y);
      }
    } else {
      const int cr = tok - NT, b = cr >> 9, key = cr & 511;
      const size_t cb = (size_t)(b * 2 + l) * 512 + key;
      const int tokp = (tok & ~12) | ((tok & 4) << 1) | ((tok & 8) >> 1);
      float ck[8], cv[8], c0, c1, c2, wk[2], wv[2];
#pragma unroll
      for (int h = 0; h < 8; ++h) {
        ck[h] = p.cache_na_k[(cb * 8 + h) * 64 + lane];
        cv[h] = p.cache_na_v[(cb * 8 + h) * 64 + lane];
      }
      c0 = p.cache_mla_ckv[cb * 128 + lane];
      c1 = p.cache_mla_ckv[cb * 128 + 64 + lane];
      c2 = p.cache_mla_krope[cb * 64 + lane];
#pragma unroll
      for (int kh = 0; kh < 2; ++kh) {
        wk[kh] = p.cache_win_k[(cb * 2 + kh) * 64 + lane];
        wv[kh] = p.cache_win_v[(cb * 2 + kh) * 64 + lane];
      }
      asm volatile("" ::: "memory");
#pragma unroll
      for (int h = 0; h < 8; ++h) {
        p.Ka[(size_t)tok * 512 + h * 64 + lane] = f2bf(ck[h]);
        p.VaT[(size_t)(h * 64 + lane) * NTA + tokp] = f2bf(cv[h]);
      }
      p.ckv[(size_t)tok * 128 + lane] = f2bf(c0);
      p.ckv[(size_t)tok * 128 + 64 + lane] = f2bf(c1);
      p.krope[(size_t)tok * 64 + lane] = f2bf(c2);
#pragma unroll
      for (int kh = 0; kh < 2; ++kh) {
        p.Kw[(size_t)tok * 128 + kh * 64 + lane] = f2bf(wk[kh]);
        p.VwT[(size_t)(kh * 64 + lane) * NTA + tokp] = f2bf(wv[kh]);
      }
    }
  }
  for (int it = blockIdx.x; it < NT / 64; it += gridDim.x) {
    __syncthreads();
    const int tok0 = it * 64;
    for (int e = TIDX; e < 64 * 80; e += NTHR) {
      const int row = e / 80, ch = e - row * 80;
      const int col = ch < 64 ? C_AV + ch * 8 : C_CV + (ch - 64) * 8;
      const uint4 v = *(const uint4*)(p.raw + (size_t)(tok0 + row) * RLD + col);
      *(uint4*)(smem + row * 648 + ch * 8) = v;
    }
    __syncthreads();
    for (int e = TIDX; e < 640 * 4; e += NTHR) {
      const int vc = e >> 2, tg = e & 3;
      u16 t[16];
#pragma unroll
      for (int i = 0; i < 16; ++i) t[i] = smem[(tg * 16 + i) * 648 + vc];
      uint4 a, b;
      a.x = t[0] | ((unsigned)t[1] << 16); a.y = t[2] | ((unsigned)t[3] << 16);
      a.z = t[8] | ((unsigned)t[9] << 16); a.w = t[10] | ((unsigned)t[11] << 16);
      b.x = t[4] | ((unsigned)t[5] << 16); b.y = t[6] | ((unsigned)t[7] << 16);
      b.z = t[12] | ((unsigned)t[13] << 16); b.w = t[14] | ((unsigned)t[15] << 16);
      u16* d = (vc < 512 ? p.VaT + (size_t)vc * NTA : p.VwT + (size_t)(vc - 512) * NTA) + tok0 + tg * 16;
      *(uint4*)d = a;
      *(uint4*)(d + 8) = b;
    }
  }
}

DI void phase_up(const Params& p, u16* smem, int l) {
  constexpr int T1 = 96 * 6, T2 = 112 * 4, T3 = 4 * 112, T4 = 256, T5 = 512;
  const u16* Wq = p.WqupT + (size_t)l * 768 * 384;
  const u16* Wkv = p.WkvupT + (size_t)l * 1024 * 128;
  for (int it = blockIdx.x; it < T1 + T2 + T3 + T4 + T5; it += gridDim.x) {
    __syncthreads();
    int t = it;
    if (t < T1) {
      const int tm = t / 6, tn = t - tm * 6;
      gemm_tile(smem, p.cq, 384, Wq, 384, 384, tm * 128, tn * 128, 768, EpiBf16{p.qmraw, 768, 1.f});
    } else if ((t -= T1) < T2) {
      const int tm = t >> 2, hd = t & 3;
      gemm_tile(smem, p.ckv, 128, Wkv, 128, 128, tm * 128, hd * 256, 1024, EpiBf16{p.kvraw, 1024, 1.f});
    } else if ((t -= T2) < T3) {
      const int hd = t & 3, tn = t >> 2;
      gemm_tile(smem, Wkv + (size_t)(hd * 256 + 128) * 128, 128, p.ckv, 128, 128, 0, tn * 128, NTA,
                EpiBf16P{p.VmT + (size_t)hd * 128 * NTA, NTA});
    } else if ((t -= T3) < T4) {
      const int tn = t & 1, pr = t >> 1, csn = pr & 1, bg = pr >> 1, b = bg >> 2, g = bg & 3;
      gemm_tile(smem, p.trig128 + csn * 128 * 128, 128, p.raw + (size_t)(b * 256) * RLD + C_FV + g * 128, RLD, 128, 0,
                tn * 128, 256, EpiBf16{p.ZtC + (size_t)bg * 128 * 512 + csn * 256, 512, 1.f});
    } else {
      t -= T4;
      const int tn = t & 15, pr = t >> 4, csn = pr & 1, bg = pr >> 1, b = bg >> 2, g = bg & 3;
      gemm_tile(smem, p.trig128 + csn * 128 * 128, 128, p.raw + (size_t)(NTC + b * 2048) * RLD + C_FV + g * 128, RLD, 128,
                0, tn * 128, 2048, EpiBf16{p.ZtL + (size_t)bg * 128 * 4096 + csn * 2048, 4096, 1.f});
    }
  }
}

DI void phase_post2(const Params& p, int l) {
  const int TIDX = tid_opaque();
  const int lane = TIDX & 63, wid = TIDX >> 6;
  const float SCM = 0.07216878364870322f * LOG2E;
  const float gq0 = p.g_qn_mla[l * 192 + lane], gq1 = p.g_qn_mla[l * 192 + 64 + lane], gq2 = p.g_qn_mla[l * 192 + 128 + lane];
  const float gk0 = p.g_kn_mla[l * 192 + lane], gk1 = p.g_kn_mla[l * 192 + 64 + lane], gk2 = p.g_kn_mla[l * 192 + 128 + lane];
  for (int it = blockIdx.x; it < NTA / 8; it += gridDim.x) {
    const int tok = it * 8 + wid;
    const bool lat = tok >= NTC && tok < NT;
    const bool hasq = tok < NT;
    u16 qv[12], kv[8], kr;
    {
      const u16* qp = p.qmraw + (size_t)(hasq ? tok : 0) * 768 + lane;
#pragma unroll
      for (int i = 0; i < 12; ++i) qv[i] = qp[i * 64];
      const u16* kp = p.kvraw + (size_t)tok * 1024 + lane;
#pragma unroll
      for (int h = 0; h < 4; ++h) { kv[2 * h] = kp[h * 256]; kv[2 * h + 1] = kp[h * 256 + 64]; }
      kr = p.krope[(size_t)tok * 64 + lane];
    }
    asm volatile("" ::: "memory");
    float sn = 0.f, cs = 1.f;
    if (lat) {
      const int pos = (tok - NTC) & 2047;
      rope_trig(lane, pos >> 6, pos & 63, sn, cs);
    }
    if (hasq) {
#pragma unroll
      for (int h = 0; h < 4; ++h) {
        const float v0 = bf2f(qv[3 * h]), v1 = bf2f(qv[3 * h + 1]), v2 = bf2f(qv[3 * h + 2]);
        const float ss = wave_sum(v0 * v0 + v1 * v1 + v2 * v2);
        const float rs = rsqrtf(ss * (1.f / 192.f) + EPSV);
        float y2 = v2 * rs * gq2;
        if (lat) y2 = rope_apply(y2, sn, cs, lane);
        u16* q = p.Qm + (size_t)tok * 768 + h * 192;
        q[lane] = f2bf(v0 * rs * gq0 * SCM);
        q[64 + lane] = f2bf(v1 * rs * gq1 * SCM);
        q[128 + lane] = f2bf(y2 * SCM);
      }
    }
    {
      const float v2 = bf2f(kr);
#pragma unroll
      for (int h = 0; h < 4; ++h) {
        const float v0 = bf2f(kv[2 * h]), v1 = bf2f(kv[2 * h + 1]);
        const float ss = wave_sum(v0 * v0 + v1 * v1 + v2 * v2);
        const float rs = rsqrtf(ss * (1.f / 192.f) + EPSV);
        float y2 = v2 * rs * gk2;
        if (lat) y2 = rope_apply(y2, sn, cs, lane);
        u16* k = p.Km + (size_t)tok * 768 + h * 192;
        k[lane] = f2bf(v0 * rs * gk0);
        k[64 + lane] = f2bf(v1 * rs * gk1);
        k[128 + lane] = f2bf(y2);
      }
    }
  }
}

DI void attn_mla_block(u16* smem, const u16* __restrict__ Qp, const u16* __restrict__ Kh, const u16* __restrict__ Vh,
                       u16* __restrict__ Op, int lk0, int nl, int ck0, int nc) {
  const int TIDX = tid_opaque();
  const int lane = TIDX & 63, qi = lane & 31, hh = lane >> 5;
  char* lds = (char*)smem;
  unsigned ko0, ko1, ko2, vo0, vo1;
  {
    int L = TIDX * 16, row = L / 384, pc = (L % 384) >> 4;
    ko0 = (unsigned)(row * 768 + ((pc & ~7) | ((pc & 7) ^ ((row >> 1) & 7))) * 8) * 2u;
    L += 8192; row = L / 384; pc = (L % 384) >> 4;
    ko1 = (unsigned)(row * 768 + ((pc & ~7) | ((pc & 7) ^ ((row >> 1) & 7))) * 8) * 2u;
    L += 8192; row = L / 384; pc = (L % 384) >> 4;
    ko2 = (unsigned)(row * 768 + ((pc & ~7) | ((pc & 7) ^ ((row >> 1) & 7))) * 8) * 2u;
    L = TIDX * 16; row = L >> 7; pc = (L & 127) >> 4;
    vo0 = (unsigned)(row * NTA + (pc ^ ((row >> 1) & 7)) * 8) * 2u;
    L += 8192; row = L >> 7; pc = (L & 127) >> 4;
    vo1 = (unsigned)(row * NTA + (pc ^ ((row >> 1) & 7)) * 8) * 2u;
  }
  const int xk = (qi >> 1) & 7;
  int kx[4], vx[4];
#pragma unroll
  for (int q = 0; q < 4; ++q) {
    kx[q] = qi * 384 + (((q * 2 + hh) ^ xk) << 4);
    vx[q] = qi * 128 + (((q * 2 + hh) ^ xk) << 4);
  }
  bf16x8 qf[12];
#pragma unroll
  for (int kk = 0; kk < 12; ++kk) qf[kk] = *(const bf16x8*)(Qp + (size_t)qi * 768 + kk * 16 + hh * 8);
  f32x16 o[4];
#pragma unroll
  for (int mt = 0; mt < 4; ++mt)
#pragma unroll
    for (int i = 0; i < 16; ++i) o[mt][i] = 0.f;
  float m = -1e30f, lsum = 0.f;
  const int nt = nl + nc;
#define MLA_LDS(p_) ((__attribute__((address_space(3))) unsigned*)(p_))
#define MLA_ISSUE(j_, st_)                                                                        \
  do {                                                                                            \
    const int kt_ = (j_) < nl ? lk0 + (j_) * 64 : ck0 + ((j_) - nl) * 64;                         \
    const char* kb_ = (const char*)(Kh + (size_t)kt_ * 768);                                      \
    const char* vb_ = (const char*)(Vh + kt_);                                                    \
    char* d_ = lds + (st_) * 40960 + TIDX * 16;                                                   \
    __builtin_amdgcn_global_load_lds((const unsigned*)(kb_ + ko0), MLA_LDS(d_), 16, 0, 0);        \
    __builtin_amdgcn_global_load_lds((const unsigned*)(kb_ + ko1), MLA_LDS(d_ + 8192), 16, 0, 0); \
    __builtin_amdgcn_global_load_lds((const unsigned*)(kb_ + ko2), MLA_LDS(d_ + 16384), 16, 0, 0); \
    __builtin_amdgcn_global_load_lds((const unsigned*)(vb_ + vo0), MLA_LDS(d_ + 24576), 16, 0, 0); \
    __builtin_amdgcn_global_load_lds((const unsigned*)(vb_ + vo1), MLA_LDS(d_ + 32768), 16, 0, 0); \
  } while (0)
#define MLA_BAR                                \
  do {                                         \
    asm volatile("" ::: "memory");             \
    __builtin_amdgcn_s_barrier();              \
    asm volatile("" ::: "memory");             \
  } while (0)
  MLA_ISSUE(0, 0);
  if (nt > 1) MLA_ISSUE(1, 1);
  int st = 0, stn = 2;
#pragma unroll 1
  for (int j = 0; j < nt; ++j) {
    if (j + 1 < nt) {
      asm volatile("s_waitcnt vmcnt(5)" ::: "memory");
    } else {
      asm volatile("s_waitcnt vmcnt(0)" ::: "memory");
    }
    MLA_BAR;
    if (j + 2 < nt) MLA_ISSUE(j + 2, stn);
    const char* ks = lds + st * 40960;
    const char* vs = ks + 24576;
    f32x16 s0, s1;
#pragma unroll
    for (int i = 0; i < 16; ++i) { s0[i] = 0.f; s1[i] = 0.f; }
#pragma unroll
    for (int kk = 0; kk < 12; ++kk) {
      const int off = (kk >> 2) * 128 + kx[kk & 3];
      const bf16x8 k0 = *(const bf16x8*)(ks + off);
      const bf16x8 k1 = *(const bf16x8*)(ks + 12288 + off);
      s0 = __builtin_amdgcn_mfma_f32_32x32x16_bf16(k0, qf[kk], s0, 0, 0, 0);
      s1 = __builtin_amdgcn_mfma_f32_32x32x16_bf16(k1, qf[kk], s1, 0, 0, 0);
    }
    float mx = fmaxf(s0[0], s1[0]);
#pragma unroll
    for (int i = 1; i < 16; ++i) mx = fmaxf(mx, fmaxf(s0[i], s1[i]));
    mx = fmaxf(mx, __shfl_xor(mx, 32));
    const float mn = fmaxf(m, mx);
    const float alpha = __builtin_amdgcn_exp2f(m - mn);
    m = mn;
    float rs = 0.f;
#pragma unroll
    for (int i = 0; i < 16; ++i) {
      s0[i] = __builtin_amdgcn_exp2f(s0[i] - mn);
      s1[i] = __builtin_amdgcn_exp2f(s1[i] - mn);
      rs += s0[i] + s1[i];
    }
    rs += __shfl_xor(rs, 32);
    lsum = lsum * alpha + rs;
    if (__builtin_amdgcn_ballot_w64(alpha != 1.f) != 0ull) {
#pragma unroll
      for (int mt = 0; mt < 4; ++mt)
#pragma unroll
        for (int i = 0; i < 16; ++i) o[mt][i] *= alpha;
    }
    union { bf16x8 v; unsigned u[4]; } pf[4];
#pragma unroll
    for (int q = 0; q < 4; ++q) {
      pf[0].u[q] = pack2(s0[2 * q], s0[2 * q + 1]);
      pf[1].u[q] = pack2(s0[8 + 2 * q], s0[8 + 2 * q + 1]);
      pf[2].u[q] = pack2(s1[2 * q], s1[2 * q + 1]);
      pf[3].u[q] = pack2(s1[8 + 2 * q], s1[8 + 2 * q + 1]);
    }
#pragma unroll
    for (int mt = 0; mt < 4; ++mt)
#pragma unroll
      for (int q = 0; q < 4; ++q) {
        const bf16x8 vfr = *(const bf16x8*)(vs + mt * 4096 + vx[q]);
        o[mt] = __builtin_amdgcn_mfma_f32_32x32x16_bf16(vfr, pf[q].v, o[mt], 0, 0, 0);
      }
    st = st == 2 ? 0 : st + 1;
    stn = stn == 2 ? 0 : stn + 1;
  }
#undef MLA_ISSUE
#undef MLA_BAR
#undef MLA_LDS
  const float inv = 1.f / lsum;
#pragma unroll
  for (int mt = 0; mt < 4; ++mt)
#pragma unroll
    for (int g = 0; g < 4; ++g) {
      uint2 r;
      r.x = pack2(o[mt][4 * g] * inv, o[mt][4 * g + 1] * inv);
      r.y = pack2(o[mt][4 * g + 2] * inv, o[mt][4 * g + 3] * inv);
      *(uint2*)(Op + (size_t)qi * DM + mt * 32 + 8 * g + 4 * hh) = r;
    }
}

DI void attn64_block(u16* smem, const u16* __restrict__ Qp, const u16* __restrict__ Kh, int ldk, const u16* __restrict__ Vh,
                     u16* __restrict__ Op, int lk0, int nl, int ck0, int nc, int mode, int qpos0, int seq0, int jlo, int jhi,
                     const float* rpb, float sink2, bool has_sink) {
  const int TIDX = tid_opaque();
  const int lane = TIDX & 63, qi = lane & 31, hh = lane >> 5;
  char* lds = (char*)smem;
  unsigned ko, vo;
  {
    const int L = TIDX * 16, row = L >> 7, pc = (L & 127) >> 4, c = pc ^ ((row >> 1) & 7);
    ko = (unsigned)(row * ldk + c * 8) * 2u;
    vo = (unsigned)(row * NTA + c * 8) * 2u;
  }
  const int xk = (qi >> 1) & 7;
  int kx[4];
#pragma unroll
  for (int q = 0; q < 4; ++q) kx[q] = qi * 128 + (((q * 2 + hh) ^ xk) << 4);
  bf16x8 qf[4];
#pragma unroll
  for (int kk = 0; kk < 4; ++kk) qf[kk] = *(const bf16x8*)(Qp + (size_t)qi * 512 + kk * 16 + hh * 8);
  f32x16 o[2];
#pragma unroll
  for (int mt = 0; mt < 2; ++mt)
#pragma unroll
    for (int i = 0; i < 16; ++i) o[mt][i] = 0.f;
  float m = -1e30f, lsum = 0.f;
  const int qp = qpos0 + qi, qr = qp >> 6, qc = qp & 63;
  const int cs = min(max(qc - 8, 0), 48);
  const float NINF = -__builtin_inff();
  const int nt = nl + nc;
#define A64_LDS(p_) ((__attribute__((address_space(3))) unsigned*)(p_))
#define A64_ISSUE(j_, st_)                                                                    \
  do {                                                                                        \
    const int kt_ = (j_) < nl ? lk0 + (j_) * 64 : ck0 + ((j_) - nl) * 64;                     \
    const char* kb_ = (const char*)(Kh + (size_t)kt_ * ldk);                                  \
    const char* vb_ = (const char*)(Vh + kt_);                                                \
    char* d_ = lds + (st_) * 16384 + TIDX * 16;                                               \
    __builtin_amdgcn_global_load_lds((const unsigned*)(kb_ + ko), A64_LDS(d_), 16, 0, 0);     \
    __builtin_amdgcn_global_load_lds((const unsigned*)(vb_ + vo), A64_LDS(d_ + 8192), 16, 0, 0); \
  } while (0)
#define A64_BAR                                \
  do {                                         \
    asm volatile("" ::: "memory");             \
    __builtin_amdgcn_s_barrier();              \
    asm volatile("" ::: "memory");             \
  } while (0)
  A64_ISSUE(0, 0);
  if (nt > 1) A64_ISSUE(1, 1);
  if (nt > 2) A64_ISSUE(2, 2);
#pragma unroll 1
  for (int j = 0; j < nt; ++j) {
    const int st = j & 3;
    if (j + 2 < nt) {
      asm volatile("s_waitcnt vmcnt(4)" ::: "memory");
    } else if (j + 1 < nt) {
      asm volatile("s_waitcnt vmcnt(2)" ::: "memory");
    } else {
      asm volatile("s_waitcnt vmcnt(0)" ::: "memory");
    }
    A64_BAR;
    if (j + 3 < nt) A64_ISSUE(j + 3, (j + 3) & 3);
    const bool active = (j >= nl) || (j >= jlo && j < jhi);
    if (active) {
      const int kt = j < nl ? lk0 + j * 64 : ck0 + (j - nl) * 64;
      const int md = j < nl ? mode : 0;
      const char* ks = lds + st * 16384;
      const char* vs = ks + 8192;
      f32x16 s0, s1;
#pragma unroll
      for (int i = 0; i < 16; ++i) { s0[i] = 0.f; s1[i] = 0.f; }
#pragma unroll
      for (int kk = 0; kk < 4; ++kk) {
        const bf16x8 k0 = *(const bf16x8*)(ks + kx[kk]);
        const bf16x8 k1 = *(const bf16x8*)(ks + 4096 + kx[kk]);
        s0 = __builtin_amdgcn_mfma_f32_32x32x16_bf16(k0, qf[kk], s0, 0, 0, 0);
        s1 = __builtin_amdgcn_mfma_f32_32x32x16_bf16(k1, qf[kk], s1, 0, 0, 0);
      }
      if (md == 1) {
        const int kr = (kt - seq0) >> 6;
        const float* rl = rpb + (kr - qr + 7) * 31 + (15 - qc);
#pragma unroll
        for (int i = 0; i < 16; ++i) {
          const int kc0 = (i & 3) + 8 * (i >> 2) + 4 * hh, kc1 = kc0 + 32;
          const float b0 = rl[kc0], b1 = rl[kc1];
          s0[i] = ((unsigned)(kc0 - cs) < 16u) ? s0[i] + b0 : NINF;
          s1[i] = ((unsigned)(kc1 - cs) < 16u) ? s1[i] + b1 : NINF;
        }
      } else if (md == 2) {
        const int q0w = qpos0, kb = kt - seq0;
        if (kb + 63 - q0w > 128 || q0w + 31 - kb > 128) {
          const int base = kb - qp + 128;
#pragma unroll
          for (int i = 0; i < 16; ++i) {
            const int c0 = (i & 3) + 8 * (i >> 2) + 4 * hh;
            if ((unsigned)(base + c0) > 256u) s0[i] = NINF;
            if ((unsigned)(base + c0 + 32) > 256u) s1[i] = NINF;
          }
        }
      }
      float mx = fmaxf(s0[0], s1[0]);
#pragma unroll
      for (int i = 1; i < 16; ++i) mx = fmaxf(mx, fmaxf(s0[i], s1[i]));
      mx = fmaxf(mx, __shfl_xor(mx, 32));
      const float mn = fmaxf(m, mx);
      const float alpha = __builtin_amdgcn_exp2f(m - mn);
      m = mn;
      float rs = 0.f;
#pragma unroll
      for (int i = 0; i < 16; ++i) {
        s0[i] = __builtin_amdgcn_exp2f(s0[i] - mn);
        s1[i] = __builtin_amdgcn_exp2f(s1[i] - mn);
        rs += s0[i] + s1[i];
      }
      rs += __shfl_xor(rs, 32);
      lsum = lsum * alpha + rs;
      if (__builtin_amdgcn_ballot_w64(alpha != 1.f) != 0ull) {
#pragma unroll
        for (int mt = 0; mt < 2; ++mt)
#pragma unroll
          for (int i = 0; i < 16; ++i) o[mt][i] *= alpha;
      }
      union { bf16x8 v; unsigned u[4]; } pf[4];
#pragma unroll
      for (int q = 0; q < 4; ++q) {
        pf[0].u[q] = pack2(s0[2 * q], s0[2 * q + 1]);
        pf[1].u[q] = pack2(s0[8 + 2 * q], s0[8 + 2 * q + 1]);
        pf[2].u[q] = pack2(s1[2 * q], s1[2 * q + 1]);
        pf[3].u[q] = pack2(s1[8 + 2 * q], s1[8 + 2 * q + 1]);
      }
#pragma unroll
      for (int mt = 0; mt < 2; ++mt)
#pragma unroll
        for (int q = 0; q < 4; ++q) {
          const bf16x8 vfr = *(const bf16x8*)(vs + mt * 4096 + kx[q]);
          o[mt] = __builtin_amdgcn_mfma_f32_32x32x16_bf16(vfr, pf[q].v, o[mt], 0, 0, 0);
        }
    }
  }
#undef A64_ISSUE
#undef A64_BAR
#undef A64_LDS
  if (has_sink) lsum += __builtin_amdgcn_exp2f(sink2 - m);
  const float inv = 1.f / lsum;
#pragma unroll
  for (int mt = 0; mt < 2; ++mt)
#pragma unroll
    for (int g = 0; g < 4; ++g) {
      uint2 r;
      r.x = pack2(o[mt][4 * g] * inv, o[mt][4 * g + 1] * inv);
      r.y = pack2(o[mt][4 * g + 2] * inv, o[mt][4 * g + 3] * inv);
      *(uint2*)(Op + (size_t)qi * DM + mt * 32 + 8 * g + 4 * hh) = r;
    }
}

DI void phase_attn(const Params& p, u16* smem, int l, int* s_item, int rep) {
  const int TIDX = tid_opaque();
  constexpr int S0 = 128;
  constexpr int D_L = 128;
  constexpr int NYQ = 32;
  constexpr int S1 = 256, S2 = 256;
  constexpr int D_C = 128;
  constexpr int S3 = 128, S4 = 64, S5 = 128;
  constexpr int TOTAL = S0 + D_L + S1 + S2 + D_C + S3 + S4 + S5 + NYQ;
  const int wid = TIDX >> 6, lane = TIDX & 63;
  float* rpb_l = (float*)smem + 24576 + wid * 512;
  int* ctr = p.ctr + l + 2 * rep;
  for (;;) {
    __syncthreads();
    if (TIDX == 0) *s_item = atomicAdd(ctr, 1);
    __syncthreads();
    int t = *s_item;
    if (t >= TOTAL) break;
    if (t >= TOTAL - NYQ) {
      const int r0 = (t - (TOTAL - NYQ)) * 64 + wid * 8;
#pragma unroll 1
      for (int rr = 0; rr < 8; ++rr) {
        const int row = r0 + rr, bg = row >> 7, lcol = row & 127, b = bg >> 2, g = bg & 3;
        const u16* z = p.ZtL + (size_t)row * 4096;
        float acc = 0.f;
#pragma unroll
        for (int i = 0; i < 4; ++i) {
          const uint4 v = *(const uint4*)(z + i * 512 + lane * 8);
          acc += bf2f((u16)(v.x & 0xffff)) - bf2f((u16)(v.x >> 16)) + bf2f((u16)(v.y & 0xffff)) - bf2f((u16)(v.y >> 16)) +
                 bf2f((u16)(v.z & 0xffff)) - bf2f((u16)(v.z >> 16)) + bf2f((u16)(v.w & 0xffff)) - bf2f((u16)(v.w >> 16));
        }
        acc = wave_sum(acc);
        if (lane == 0) p.o[(size_t)(NTC + b * 2048 + 1024) * DM + 1536 + g * 128 + lcol] = f2bf(acc * (1.f / 512.f));
      }
    } else if (t < S0) {
      const int head = t & 3, qt = (t >> 2) * 8 + wid, b = qt >> 6;
      const int tok0 = NTC + qt * 32, seq0 = NTC + b * 2048;
      attn_mla_block(smem, p.Qm + (size_t)tok0 * 768 + head * 192, p.Km + head * 192, p.VmT + (size_t)head * 128 * NTA,
                     p.o + (size_t)tok0 * DM + 512 + head * 128, seq0, 32, NT + b * 512, 8);
    } else if ((t -= S0) < D_L) {
      const int tm = t & 7, bg = t >> 3, b = bg >> 2, g = bg & 3;
      float* pl = (float*)smem + 16384;
      const u16* Z = p.ZtL + (size_t)bg * 128 * 4096;
      gemm_tile(smem, p.W2048, 4096, Z, 4096, 2048, tm * 128, 0, 128, EpiLdsF32{pl, tm * 128});
      __syncthreads();
      gemm_tile(smem, p.W2048 + 2048, 4096, Z + 2048, 4096, 2048, tm * 128, 0, 128,
                EpiDftSym{pl, tm * 128, 2048, p.o + (size_t)(NTC + b * 2048) * DM + 1536 + g * 128, DM, 1.f / 512.f});
    } else if ((t -= D_L) < S1) {
      const int head = t & 7, rg = (t >> 3) & 7, b = t >> 6;
      const int r0 = rg * 4, r = r0 + (wid >> 1);
      const int seq0 = NTC + b * 2048, qpos0 = r * 64 + (wid & 1) * 32, tok0 = seq0 + qpos0;
      const float* rp = p.rpb_na + ((size_t)l * 8 + head) * 465;
      for (int e = lane; e < 465; e += 64) rpb_l[e] = rp[e] * LOG2E;
      const int lrow0 = min(max(r0 - 4, 0), 24), lrow1 = min(max(r0 + 3 - 4, 0), 24) + 8;
      const int jlo = min(max(r - 4, 0), 24) - lrow0;
      attn64_block(smem, p.Qa + (size_t)tok0 * 512 + head * 64, p.Ka + head * 64, 512, p.VaT + (size_t)head * 64 * NTA,
                   p.o + (size_t)tok0 * DM + head * 64, seq0 + lrow0 * 64, lrow1 - lrow0, NT + b * 512, 8, 1, qpos0, seq0,
                   jlo, jlo + 8, rpb_l, 0.f, false);
    } else if ((t -= S1) < S2) {
      const int kvh = t & 1, rest = t >> 1, b = rest >> 5, q0 = (rest & 31) * 64;
      const int hq = kvh * 4 + (wid & 3), qpos0 = q0 + (wid >> 2) * 32;
      const int seq0 = NTC + b * 2048, tok0 = seq0 + qpos0;
      const int k0 = max(q0 - 128, 0), k1 = min(q0 + 192, 2048);
      attn64_block(smem, p.Qw + (size_t)tok0 * 512 + hq * 64, p.Kw + kvh * 64, 128, p.VwT + (size_t)kvh * 64 * NTA,
                   p.o + (size_t)tok0 * DM + 1024 + hq * 64, seq0 + k0, (k1 - k0) >> 6, NT + b * 512, 8, 2, qpos0, seq0, 0,
                   64, nullptr, p.sink_win[l * 8 + hq] * LOG2E, true);
    } else if ((t -= S2) < D_C) {
      const int tm = t & 1, bg = t >> 1, b = bg >> 2, g = bg & 3;
      gemm_tile(smem, p.W256, 512, p.ZtC + (size_t)bg * 128 * 512, 512, 512, tm * 128, 0, 128,
                EpiBf16{p.o + (size_t)(b * 256) * DM + 1536 + g * 128, DM, 0.005524271728019903f});
    } else if ((t -= D_C) < S3) {
      const int head = t & 7, b = t >> 3;
      const int seq0 = b * 256, qpos0 = wid * 32, tok0 = seq0 + qpos0;
      attn64_block(smem, p.Qa + (size_t)tok0 * 512 + head * 64, p.Ka + head * 64, 512, p.VaT + (size_t)head * 64 * NTA,
                   p.o + (size_t)tok0 * DM + head * 64, seq0, 4, 0, 0, 0, qpos0, seq0, 0, 64, nullptr, 0.f, false);
    } else if ((t -= S3) < S4) {
      const int head = t & 3, b = t >> 2, qt = b * 8 + wid;
      const int tok0 = qt * 32, seq0 = b * 256;
      attn_mla_block(smem, p.Qm + (size_t)tok0 * 768 + head * 192, p.Km + head * 192, p.VmT + (size_t)head * 128 * NTA,
                     p.o + (size_t)tok0 * DM + 512 + head * 128, seq0, 4, 0, 0);
    } else {
      t -= S4;
      const int kvh = t & 1, rest = t >> 1, b = rest >> 2, q0 = (rest & 3) * 64;
      const int hq = kvh * 4 + (wid & 3), qpos0 = q0 + (wid >> 2) * 32;
      const int seq0 = b * 256, tok0 = seq0 + qpos0;
      attn64_block(smem, p.Qw + (size_t)tok0 * 512 + hq * 64, p.Kw + kvh * 64, 128, p.VwT + (size_t)kvh * 64 * NTA,
                   p.o + (size_t)tok0 * DM + 1024 + hq * 64, seq0, 4, 0, 0, 0, qpos0, seq0, 0, 64, nullptr,
                   p.sink_win[l * 8 + hq] * LOG2E, true);
    }
  }
}

struct EpiResid {
  const float* mod_l;
  const void* res_c;
  const void* res_l;
  void* dstp;
  int res_bf, dst_bf;
  int mode;
  float* part;
  unsigned* flag;
  int brow, bcol;
  DI void begin() const {
    if (mode == 2) {
      if (threadIdx.x == 0) {
        while (__hip_atomic_load(flag, __ATOMIC_RELAXED, __HIP_MEMORY_SCOPE_AGENT) == 0u) __builtin_amdgcn_s_sleep(1);
        __builtin_amdgcn_fence(__ATOMIC_ACQUIRE, "agent");
        asm volatile("s_waitcnt vmcnt(0)" ::: "memory");
      }
      __syncthreads();
    }
  }
  DI void end() const {
    if (mode == 1) {
      asm volatile("s_waitcnt vmcnt(0)" ::: "memory");
      __syncthreads();
      if (threadIdx.x == 0) {
        __builtin_amdgcn_fence(__ATOMIC_RELEASE, "agent");
        asm volatile("s_waitcnt vmcnt(0)" ::: "memory");
        __hip_atomic_store(flag, 1u, __ATOMIC_RELAXED, __HIP_MEMORY_SCOPE_AGENT);
      }
    }
  }
  struct Pre { float4 g, x; f32x4 pv; };
  DI Pre load(int m, int n) const {
    Pre q;
    q.pv = (f32x4){0.f, 0.f, 0.f, 0.f};
    if (mode == 1) { q.g = make_float4(0.f, 0.f, 0.f, 0.f); q.x = q.g; return q; }
    if (mode == 2) q.pv = *(const f32x4*)(part + (size_t)(m - brow) * 256 + (n - bcol));
    q.g = *(const float4*)(mod_l + (size_t)mod_index(m) * (6 * DM) + n);
    if (res_bf) {
      const u16* xr = m < NTC ? (const u16*)res_c + (size_t)m * DM : (const u16*)res_l + (size_t)(m - NTC) * DM;
      const uint2 r = *(const uint2*)(xr + n);
      q.x = make_float4(bf2f((u16)(r.x & 0xffff)), bf2f((u16)(r.x >> 16)), bf2f((u16)(r.y & 0xffff)), bf2f((u16)(r.y >> 16)));
    } else {
      const float* xr = m < NTC ? (const float*)res_c + (size_t)m * DM : (const float*)res_l + (size_t)(m - NTC) * DM;
      q.x = *(const float4*)(xr + n);
    }
    return q;
  }
  DI void store(int m, int n, f32x4 v, const Pre& q) const {
    if (mode == 1) {
      *(f32x4*)(part + (size_t)(m - brow) * 256 + (n - bcol)) = v;
      return;
    }
    v += q.pv;
    float4 r;
    r.x = q.x.x + q.g.x * v[0]; r.y = q.x.y + q.g.y * v[1]; r.z = q.x.z + q.g.z * v[2]; r.w = q.x.w + q.g.w * v[3];
    if (dst_bf) {
      uint2 o;
      o.x = pack2(r.x, r.y);
      o.y = pack2(r.z, r.w);
      *(uint2*)((u16*)dstp + (size_t)m * DM + n) = o;
    } else {
      *(float4*)((float*)dstp + (size_t)m * DM + n) = r;
    }
  }
};
DI void gemm_n2048(const Params& p, u16* smem, const u16* A, const u16* W, int K, EpiResid epi, unsigned* flags) {
#pragma unroll 1
  for (int it = blockIdx.x; it < 256; it += gridDim.x) {
    __syncthreads();
    int pm, pn;
    tile256_decode(it, 48, 8, pm, pn);
    gemm256_tile<false>(smem, A, W, K, K, pm * 256, pn * 256, epi);
  }
#pragma unroll 1
  for (int it = blockIdx.x; it < 256; it += gridDim.x) {
    __syncthreads();
    int pm, pn;
    tile256_decode(256 + (it >> 1), 48, 8, pm, pn);
    gemm256_tile<true>(smem, A, W, K, K, pm * 256, pn * 256 + (it & 1) * 128, epi);
  }
}
DI void phase_outproj(const Params& p, u16* smem, int l) {
  const EpiResid epi{p.mod + (size_t)l * 5 * 6 * DM + 2 * DM,
                     l == 0 ? (const void*)p.x_prompt : (const void*)p.x2b,
                     l == 0 ? (const void*)p.x_sample : (const void*)(p.x2b + (size_t)NTC * DM),
                     (void*)p.x1b, l == 0 ? 0 : 1, 1, 0, nullptr, nullptr, 0, 0};
  gemm_n2048(p, smem, p.o, p.WoutT + (size_t)l * DM * DM, DM, epi, p.flags + (l * 2 + 0) * 128);
}
DI void phase_gate(const Params& p, u16* smem, int l) {
  const u16* W = p.WgateT + (size_t)l * DFF * DM;
#pragma unroll 1
  for (int it = blockIdx.x; it < 256; it += gridDim.x) {
    __syncthreads();
    int pm, pn;
    tile256_decode(1024 + (it >> 3), 48, 22, pm, pn);
    const int n0p = pn * 256 + ((it >> 1) & 3) * 64;
    gemm_tile<1>(smem, p.h, DM, W, DM, DM, pm * 256 + (it & 1) * 128, n0p, n0p + 64, EpiBf16{p.g, DFF, 1.f});
  }
#pragma unroll 1
  for (int it = blockIdx.x; it < 1024; it += gridDim.x) {
    __syncthreads();
    int pm, pn;
    tile256_decode(it, 48, 22, pm, pn);
    gemm256_tile(smem, p.h, W, DM, DM, pm * 256, pn * 256, EpiBf16{p.g, DFF, 1.f});
  }
}
struct EpiUp {
  const float* wconv;
  const u16* gbuf;
  u16* abuf;
  struct Pre { uint2 c0, c1, c2; float4 w0, w1, w2; };
  DI void begin() const {}
  DI void end() const {}
  DI Pre load(int m, int n) const {
    Pre q;
    const float* wc = wconv + n;
    q.w0 = *(const float4*)wc; q.w1 = *(const float4*)(wc + DFF); q.w2 = *(const float4*)(wc + 2 * DFF);
    const int pos = m < NTC ? (m & 255) : ((m - NTC) & 2047);
    const int last = m < NTC ? 255 : 2047;
    const u16* gp = gbuf + (size_t)m * DFF + n;
    q.c1 = *(const uint2*)gp;
    q.c0 = make_uint2(0u, 0u);
    q.c2 = make_uint2(0u, 0u);
    if (pos > 0) q.c0 = *(const uint2*)(gp - DFF);
    if (pos < last) q.c2 = *(const uint2*)(gp + DFF);
    return q;
  }
  DI void store(int m, int n, f32x4 v, const Pre& q) const {
    float gg[4];
    gg[0] = bf2f((u16)(q.c0.x & 0xffff)) * q.w0.x + bf2f((u16)(q.c1.x & 0xffff)) * q.w1.x + bf2f((u16)(q.c2.x & 0xffff)) * q.w2.x;
    gg[1] = bf2f((u16)(q.c0.x >> 16)) * q.w0.y + bf2f((u16)(q.c1.x >> 16)) * q.w1.y + bf2f((u16)(q.c2.x >> 16)) * q.w2.y;
    gg[2] = bf2f((u16)(q.c0.y & 0xffff)) * q.w0.z + bf2f((u16)(q.c1.y & 0xffff)) * q.w1.z + bf2f((u16)(q.c2.y & 0xffff)) * q.w2.z;
    gg[3] = bf2f((u16)(q.c0.y >> 16)) * q.w0.w + bf2f((u16)(q.c1.y >> 16)) * q.w1.w + bf2f((u16)(q.c2.y >> 16)) * q.w2.w;
    float r[4];
#pragma unroll
    for (int i = 0; i < 4; ++i) r[i] = gg[i] / (1.f + __expf(-gg[i])) * v[i];
    uint2 o;
    o.x = pack2(r[0], r[1]);
    o.y = pack2(r[2], r[3]);
    *(uint2*)(abuf + (size_t)m * DFF + n) = o;
  }
};
DI void phase_up_ffn(const Params& p, u16* smem, int l) {
  const u16* W = p.WupT + (size_t)l * DFF * DM;
#pragma unroll 1
  for (int it = blockIdx.x; it < 256; it += gridDim.x) {
    __syncthreads();
    int pm, pn;
    tile256_decode(1024 + (it >> 3), 48, 22, pm, pn);
    const int n0p = pn * 256 + ((it >> 1) & 3) * 64;
    gemm_tile<1>(smem, p.h, DM, W, DM, DM, pm * 256 + (it & 1) * 128, n0p, n0p + 64, EpiUp{p.w_conv + (size_t)l * 3 * DFF, p.g, p.a});
  }
#pragma unroll 1
  for (int it = blockIdx.x; it < 1024; it += gridDim.x) {
    __syncthreads();
    int pm, pn;
    tile256_decode(it, 48, 22, pm, pn);
    gemm256_tile(smem, p.h, W, DM, DM, pm * 256, pn * 256, EpiUp{p.w_conv + (size_t)l * 3 * DFF, p.g, p.a});
  }
}
DI void phase_down(const Params& p, u16* smem, int l) {
  const EpiResid epi{p.mod + (size_t)l * 5 * 6 * DM + 5 * DM, (const void*)p.x1b, (const void*)(p.x1b + (size_t)NTC * DM),
                     l == 0 ? (void*)p.x2b : (void*)p.out, 1, l == 0 ? 1 : 0, 0, nullptr, nullptr, 0, 0};
  gemm_n2048(p, smem, p.a, p.WdownT + (size_t)l * DM * DFF, DFF, epi, p.flags + (l * 2 + 1) * 128);
}

constexpr int N_PHASES = 1 + 2 * 11;
DI void run_phase(const Params& p, u16* smem, int* s_item, int ph, int rep) {
#ifdef ONLY
  if (ONLY == 11) { phase_prep(p, smem); return; }
  const int l = ph & 1, s = ONLY;
#else
  if (ph == 0) { phase_prep(p, smem); return; }
  const int l = (ph - 1) / 11, s = (ph - 1) % 11;
#endif
  switch (s) {
    case 0: phase_modulate(p, l, 0); break;
    case 1: phase_qkv(p, smem, l); break;
    case 2: phase_post1(p, smem, l); break;
    case 3: phase_up(p, smem, l); break;
    case 4: phase_post2(p, l); break;
    case 5: phase_attn(p, smem, l, s_item, rep); break;
    case 6: phase_outproj(p, smem, l); break;
    case 7: phase_modulate(p, l, 1); break;
    case 8: phase_gate(p, smem, l); break;
    case 9: phase_up_ffn(p, smem, l); break;
    default: phase_down(p, smem, l); break;
  }
}

#if MEGA
DI void grid_bar(unsigned* bw, unsigned gen, lds_uint* s_nloc_p) {
  asm volatile("s_waitcnt vmcnt(0)" ::: "memory");
  __syncthreads();
  if (threadIdx.x == 0) {
    const unsigned xc = (unsigned)__builtin_amdgcn_s_getreg((3 << 11) | 20) & 0xFu;
    const unsigned nloc = *(volatile lds_uint*)s_nloc_p;
    const unsigned old = __hip_atomic_fetch_add(bw + 64 + 64 * xc, 1u, __ATOMIC_RELAXED, __HIP_MEMORY_SCOPE_AGENT);
    if (old + 1u == gen * nloc) {
      __builtin_amdgcn_fence(__ATOMIC_RELEASE, "agent");
      asm volatile("s_waitcnt vmcnt(0)" ::: "memory");
      __hip_atomic_fetch_add(bw, nloc, __ATOMIC_RELAXED, __HIP_MEMORY_SCOPE_AGENT);
    }
    const unsigned target = gen * gridDim.x;
    while (__hip_atomic_load(bw, __ATOMIC_RELAXED, __HIP_MEMORY_SCOPE_AGENT) < target) __builtin_amdgcn_s_sleep(1);
    __builtin_amdgcn_fence(__ATOMIC_ACQUIRE, "agent");
    asm volatile("s_waitcnt vmcnt(0)" ::: "memory");
  }
  __syncthreads();
}

__global__ void __launch_bounds__(NTHR) mega_kernel(Params p) {
  __shared__ __attribute__((aligned(16))) u16 smem[65536];
  __shared__ int s_item;
  cg::grid_group grid = cg::this_grid();
  unsigned* bar = p.barw;
  __shared__ unsigned s_nloc;
  if (threadIdx.x == 0) {
    const unsigned xc = (unsigned)__builtin_amdgcn_s_getreg((3 << 11) | 20) & 0xFu;
    __hip_atomic_fetch_add(bar + 1536 + 16 * xc, 1u, __ATOMIC_RELAXED, __HIP_MEMORY_SCOPE_AGENT);
  }
  unsigned nbar = 0;
#pragma unroll 1
  for (int ph = 0; ph < N_PHASES; ++ph) {
    run_phase(p, smem, &s_item, ph, 0);
#ifdef DUP_MASK
    {
      const int ty = ph == 0 ? 11 : (ph - 1) % 11;
      if ((DUP_MASK >> ty) & 1) { ++nbar; grid_bar(bar, nbar, (lds_uint*)&s_nloc); run_phase(p, smem, &s_item, ph, 1); }
    }
#endif
    if (ph == 0) {
      grid.sync();
      if (threadIdx.x == 0) {
        const unsigned xc = (unsigned)__builtin_amdgcn_s_getreg((3 << 11) | 20) & 0xFu;
        s_nloc = __hip_atomic_load(bar + 1536 + 16 * xc, __ATOMIC_RELAXED, __HIP_MEMORY_SCOPE_AGENT);
      }
      __syncthreads();
    } else if (ph + 1 < N_PHASES) { ++nbar; grid_bar(bar, nbar, (lds_uint*)&s_nloc); }
  }
}
#else
__global__ void __launch_bounds__(NTHR) phase_kernel(Params p, int ph) {
  __shared__ __attribute__((aligned(16))) u16 smem[65536];
  __shared__ int s_item;
  run_phase(p, smem, &s_item, ph, 0);
}
#endif

extern "C" void kernel_launch(void* const* d_in, const int* in_sizes, int n_in, void* d_out, int out_size, void* d_ws,
                              size_t ws_size, hipStream_t stream) {
  Params p{};
  const float** pi = (const float**)&p;
  for (int i = 0; i < 32; ++i) pi[i] = (const float*)d_in[i];
  p.out = (float*)d_out;
  char* w = (char*)d_ws;
  size_t off = 0;
  auto take = [&](size_t bytes) { char* r = w + off; off += (bytes + 255) & ~(size_t)255; return r; };
  p.WinT = (u16*)take((size_t)2 * RLD * DM * 2);
  p.WqupT = (u16*)take((size_t)2 * 768 * 384 * 2);
  p.WkvupT = (u16*)take((size_t)2 * 1024 * 128 * 2);
  p.WoutT = (u16*)take((size_t)2 * DM * DM * 2);
  p.WgateT = (u16*)take((size_t)2 * DFF * DM * 2);
  p.WupT = (u16*)take((size_t)2 * DFF * DM * 2);
  p.WdownT = (u16*)take((size_t)2 * DM * DFF * 2);
  p.trig128 = (u16*)take(256 * 128 * 2);
  p.W256 = (u16*)take(256 * 512 * 2);
  p.W2048 = (u16*)take((size_t)2048 * 4096 * 2);
  p.mod = (float*)take((size_t)2 * 5 * 6 * DM * 4);
  p.ctr = (int*)take(256);
  p.flags = (unsigned*)take(512 * 4);
  p.barw = (unsigned*)take(2048 * 4);
  p.x1b = (u16*)take((size_t)NT * DM * 2);
  p.x2b = (u16*)take((size_t)NT * DM * 2);
  p.h = (u16*)take((size_t)NT * DM * 2);
  const size_t att0 = off;
  p.raw = (u16*)take((size_t)NT * RLD * 2);
  p.Qa = (u16*)take((size_t)NT * 512 * 2);
  p.Ka = (u16*)take((size_t)NTA * 512 * 2);
  p.VaT = (u16*)take((size_t)512 * NTA * 2);
  p.Qw = (u16*)take((size_t)NT * 512 * 2);
  p.Kw = (u16*)take((size_t)NTA * 128 * 2);
  p.VwT = (u16*)take((size_t)128 * NTA * 2);
  p.cq = (u16*)take((size_t)NT * 384 * 2);
  p.ckv = (u16*)take((size_t)NTA * 128 * 2);
  p.krope = (u16*)take((size_t)NTA * 64 * 2);
  p.qmraw = (u16*)take((size_t)NT * 768 * 2);
  p.kvraw = (u16*)take((size_t)NTA * 1024 * 2);
  p.Qm = (u16*)take((size_t)NT * 768 * 2);
  p.Km = (u16*)take((size_t)NTA * 768 * 2);
  p.VmT = (u16*)take((size_t)512 * NTA * 2);
  p.ZtC = (u16*)take((size_t)64 * 128 * 512 * 2);
  p.ZtL = (u16*)take((size_t)16 * 128 * 4096 * 2);
  p.o = (u16*)take((size_t)NT * DM * 2);
  const size_t att1 = off;
  off = att0;
  p.g = (u16*)take((size_t)NT * DFF * 2);
  p.a = (u16*)take((size_t)NT * DFF * 2);
  if (off < att1) off = att1;
  p.part = (float*)take((size_t)128 * 65536 * 4);
  if (off > ws_size) fprintf(stderr, "workspace too small: need %zu have %zu\n", off, ws_size);

#if MEGA
  (void)hipMemsetAsync(p.barw, 0, 2048 * 4, stream);
  static int grid_blocks = 0;
  if (!grid_blocks) {
    int dev = 0, cus = 0, per_cu = 0;
    hipGetDevice(&dev);
    hipDeviceGetAttribute(&cus, hipDeviceAttributeMultiprocessorCount, dev);
    (void)hipOccupancyMaxActiveBlocksPerMultiprocessor(&per_cu, mega_kernel, NTHR, 0);
    grid_blocks = cus * per_cu;
  }
  void* args[] = {&p};
  hipError_t e = hipLaunchCooperativeKernel((void*)mega_kernel, dim3(grid_blocks), dim3(NTHR), args, 0, stream);
  if (e != hipSuccess) fprintf(stderr, "cooperative launch failed: %s (grid %d)\n", hipGetErrorString(e), grid_blocks);
#else
  for (int ph = 0; ph < N_PHASES; ++ph) phase_kernel<<<dim3(256), dim3(NTHR), 0, stream>>>(p, ph);
#endif
}
```

```cpp
#include <hip/hip_runtime.h>
#include <hip/hip_cooperative_groups.h>
#include <cstdio>
#include <cstdint>
namespace cg = cooperative_groups;

#ifndef MEGA
#define MEGA 1
#endif

typedef unsigned short u16;
using bf16x8 = __attribute__((ext_vector_type(8))) short;
using bf16x4 = __attribute__((ext_vector_type(4))) short;
using f32x4 = __attribute__((ext_vector_type(4))) float;
using f32x16 = __attribute__((ext_vector_type(16))) float;

#define DI __device__ __forceinline__
typedef __attribute__((address_space(3))) unsigned lds_uint;
#define LOG2E 1.4426950408889634f
#define EPSV 1e-6f

constexpr int NT = 12288;
constexpr int NTC = 4096;
constexpr int NTA = 14336;
constexpr int DM = 2048;
constexpr int INC = 3392;
constexpr int RLD = 3584;
constexpr int NTHR = 512;
constexpr int DFF = 5632;
constexpr int C_AQ = 0, C_AK = 512, C_AV = 1024, C_MQ = 1536, C_CKV = 1920, C_KR = 2048, C_CQ = 2112, C_CK = 2624, C_CV = 2752, C_FV = 2880;

struct Params {
  const float *x_prompt, *x_sample, *cache_na_k, *cache_na_v, *cache_mla_ckv, *cache_mla_krope, *cache_win_k, *cache_win_v,
      *c, *c_ctx, *w_mod, *b_mod, *g_mix, *g_ffn, *w_in, *g_qn_na, *g_kn_na, *rpb_na, *g_q_lora, *w_q_up, *g_kv_lora,
      *w_kv_up, *g_qn_mla, *g_kn_mla, *g_qn_win, *g_kn_win, *sink_win, *w_out, *w_gate, *w_up, *w_conv, *w_down;
  float* out;
  u16 *WinT, *WqupT, *WkvupT, *WoutT, *WgateT, *WupT, *WdownT;
  u16 *trig128, *W2048, *W256;
  float* mod;
  u16 *h, *raw, *Qa, *Ka, *VaT, *Qw, *Kw, *VwT, *cq, *ckv, *krope, *qmraw, *kvraw, *Qm, *Km, *VmT, *ZtC, *ZtL, *o, *g, *a;
  u16* x1b;
  u16* x2b;
  int* ctr;
  unsigned* flags;
  float* part;
  unsigned* barw;
};

typedef __bf16 bf16n2 __attribute__((ext_vector_type(2)));
typedef float f32n2 __attribute__((ext_vector_type(2)));
DI unsigned pack2(float a, float b) {
  const f32n2 v = {a, b};
  return __builtin_bit_cast(unsigned, __builtin_convertvector(v, bf16n2));
}
DI u16 f2bf(float x) { return (u16)(pack2(x, 0.f) & 0xffffu); }
DI float bf2f(u16 b) { return __uint_as_float(((unsigned)b) << 16); }
#define DPP_F(v, ctrl, row_mask) \
  __builtin_bit_cast(float, __builtin_amdgcn_update_dpp(0, __builtin_bit_cast(int, (v)), (ctrl), (row_mask), 0xF, false))
DI float wave_sum(float v) {
  v += DPP_F(v, 0xB1, 0xF);
  v += DPP_F(v, 0x4E, 0xF);
  v += DPP_F(v, 0x141, 0xF);
  v += DPP_F(v, 0x140, 0xF);
  v += DPP_F(v, 0x142, 0xA);
  v += DPP_F(v, 0x143, 0xC);
  return __builtin_bit_cast(float, __builtin_amdgcn_readlane(__builtin_bit_cast(int, v), 63));
}
DI int tid_opaque() { int t = threadIdx.x; asm volatile("" : "+v"(t)); return t; }
DI int mod_index(int row) { return row < NTC ? 0 : 1 + ((row - NTC) >> 11); }
DI const float* xin_row(const Params& p, int l, int row) {
  if (l == 0) return row < NTC ? p.x_prompt + (size_t)row * DM : p.x_sample + (size_t)(row - NTC) * DM;
  return p.out + (size_t)row * DM;
}

template <int NI = 2, class Epi>
DI void gemm_tile(u16* smem, const u16* __restrict__ A, int lda, const u16* __restrict__ Bt, int ldb, int K, int m0,
                  int n0, int N, Epi epi) {
  const int TIDX = tid_opaque();
  const int tid = TIDX, lane = tid & 63, wid = tid >> 6;
  const int wr = wid >> 2, wc = wid & 3, fr = lane & 15, fq = lane >> 4;
  constexpr int WN = 16 * NI;
  const int lr = tid >> 3, lc = tid & 7;
  u16* As = smem;
  u16* Bs = smem + 16384;
  f32x4 acc[4][NI];
#pragma unroll
  for (int i = 0; i < 4; ++i)
#pragma unroll
    for (int j = 0; j < NI; ++j) acc[i][j] = (f32x4){0.f, 0.f, 0.f, 0.f};
  const u16* ap = A + (size_t)(m0 + lr) * lda + lc * 8;
  const size_t a64 = (size_t)64 * lda;
  const int rn0 = min(n0 + lr, N - 1), rn1 = NI == 2 ? min(n0 + lr + 64, N - 1) : rn0;
  const u16* bp0 = Bt + (size_t)rn0 * ldb + lc * 8;
  const u16* bp1 = Bt + (size_t)rn1 * ldb + lc * 8;
  const int nt = K >> 6;
  uint4 ra0 = *(const uint4*)(ap), ra1 = *(const uint4*)(ap + a64);
  uint4 rb0 = *(const uint4*)(bp0), rb1 = *(const uint4*)(bp1);
  uint4 sa0 = ra0, sa1 = ra1, sb0 = rb0, sb1 = rb1;
  if (nt > 1) {
    sa0 = *(const uint4*)(ap + 64); sa1 = *(const uint4*)(ap + a64 + 64);
    sb0 = *(const uint4*)(bp0 + 64); sb1 = *(const uint4*)(bp1 + 64);
  }
  const int st_off = lr * 64 + ((lc ^ ((lr >> 1) & 7)) << 3);
  const int sw = (fr >> 1) & 7;
#define GT_COMPUTE(as, bs)                                                                              \
  _Pragma("unroll") for (int ks = 0; ks < 2; ++ks) {                                                    \
    bf16x8 af[4], bfv[NI];                                                                               \
    const int pc = ((ks * 4 + fq) ^ sw) << 3;                                                           \
    _Pragma("unroll") for (int mi = 0; mi < 4; ++mi) af[mi] = *(const bf16x8*)((as) + (wr * 64 + mi * 16 + fr) * 64 + pc); \
    _Pragma("unroll") for (int ni = 0; ni < NI; ++ni) bfv[ni] = *(const bf16x8*)((bs) + (wc * WN + ni * 16 + fr) * 64 + pc); \
    _Pragma("unroll") for (int mi = 0; mi < 4; ++mi)                                                    \
      _Pragma("unroll") for (int ni = 0; ni < NI; ++ni)                                                 \
        acc[mi][ni] = __builtin_amdgcn_mfma_f32_16x16x32_bf16(bfv[ni], af[mi], acc[mi][ni], 0, 0, 0);   \
  }
  for (int t = 0; t < nt; t += 2) {
    {
      u16* as = As;
      u16* bs = Bs;
      *(uint4*)(as + st_off) = ra0;
      *(uint4*)(as + st_off + 4096) = ra1;
      *(uint4*)(bs + st_off) = rb0;
      *(uint4*)(bs + st_off + 4096) = rb1;
      __syncthreads();
      if (t + 2 < nt) {
        const int ko = (t + 2) << 6;
        ra0 = *(const uint4*)(ap + ko);
        ra1 = *(const uint4*)(ap + a64 + ko);
        rb0 = *(const uint4*)(bp0 + ko);
        rb1 = *(const uint4*)(bp1 + ko);
      }
      GT_COMPUTE(as, bs)
    }
    if (t + 1 < nt) {
      u16* as = As + 8192;
      u16* bs = Bs + 8192;
      *(uint4*)(as + st_off) = sa0;
      *(uint4*)(as + st_off + 4096) = sa1;
      *(uint4*)(bs + st_off) = sb0;
      *(uint4*)(bs + st_off + 4096) = sb1;
      __syncthreads();
      if (t + 3 < nt) {
        const int ko = (t + 3) << 6;
        sa0 = *(const uint4*)(ap + ko);
        sa1 = *(const uint4*)(ap + a64 + ko);
        sb0 = *(const uint4*)(bp0 + ko);
        sb1 = *(const uint4*)(bp1 + ko);
      }
      GT_COMPUTE(as, bs)
    }
  }
#undef GT_COMPUTE
  epi.begin();
  {
    typename Epi::Pre pre[4][NI];
#pragma unroll
    for (int mi = 0; mi < 4; ++mi)
#pragma unroll
      for (int ni = 0; ni < NI; ++ni) {
        const int m = m0 + wr * 64 + mi * 16 + fr;
        const int n = n0 + wc * WN + ni * 16 + fq * 4;
        if (n < N) pre[mi][ni] = epi.load(m, n);
      }
#pragma unroll
    for (int mi = 0; mi < 4; ++mi)
#pragma unroll
      for (int ni = 0; ni < NI; ++ni) {
        const int m = m0 + wr * 64 + mi * 16 + fr;
        const int n = n0 + wc * WN + ni * 16 + fq * 4;
        if (n < N) epi.store(m, n, acc[mi][ni], pre[mi][ni]);
      }
  }
  epi.end();
}

constexpr int G_HT = 128 * 64;
DI int lds_byte(int r, int c) {
  const int st = (r >> 4) * 2 + (c >> 5), rr = r & 15, cc = c & 31, ob = rr * 64 + cc * 2;
  return st * 1024 + (ob ^ (((ob >> 9) & 1) << 5));
}
DI void stage_rc(int b, int& R, int& C) {
  const int st = b / 1024, sb = b % 1024, swz = sb ^ (((sb >> 9) & 1) << 5);
  R = (st >> 1) * 16 + swz / 64;
  C = (st & 1) * 32 + (swz % 64) / 2;
}
template <bool HALF = false, class Epi>
DI void gemm256_tile(u16* shm, const u16* __restrict__ A, const u16* __restrict__ Bt, int K, int ld, int brow, int bcol, Epi epi) {
  const int TIDX = tid_opaque();
#define SA(b, h) (shm + ((b) * 2 + (h)) * G_HT)
#define SB(b, h) (shm + (4 + (b) * 2 + (h)) * G_HT)
#define STAGE(P, BASE, br, kt)                                                                          \
  do {                                                                                                  \
    const char* _ub = (const char*)((BASE) + (long)(br) * ld + (long)(kt) * 64);                         \
    __builtin_amdgcn_global_load_lds((const unsigned*)(_ub + voff0),                                    \
                                     (__attribute__((address_space(3))) unsigned*)((char*)(P) + TIDX * 16), 16, 0, 0); \
    __builtin_amdgcn_global_load_lds((const unsigned*)(_ub + voff1),                                    \
                                     (__attribute__((address_space(3))) unsigned*)((char*)(P) + TIDX * 16 + 8192), 16, 0, 0); \
  } while (0)
#define LDA(dst, b, h)                                                                                  \
  for (int m = 0; m < 4; ++m)                                                                           \
    for (int k = 0; k < 2; ++k)                                                                         \
      dst[m][k] = *reinterpret_cast<const bf16x8*>(lds_a + (((b) * 2 + (h)) * 16384 + m * 2048 + k * 1024))
#define LDB(dst, b, h)                                                                                  \
  for (int n = 0; n < 2; ++n)                                                                           \
    for (int k = 0; k < 2; ++k)                                                                         \
      dst[n][k] = *reinterpret_cast<const bf16x8*>(lds_b + (((b) * 2 + (h)) * 16384 + n * 2048 + k * 1024))
#define MMA(ai, bj, At, Bv)                                                                             \
  if (!(HALF && (bj) == 1)) do {                                                                        \
    __builtin_amdgcn_s_setprio(1);                                                                      \
    for (int m = 0; m < 4; ++m)                                                                         \
      for (int n = 0; n < 2; ++n)                                                                       \
        for (int k = 0; k < 2; ++k)                                                                     \
          acc[ai][bj][m][n] = __builtin_amdgcn_mfma_f32_16x16x32_bf16(Bv[n][k], At[m][k], acc[ai][bj][m][n], 0, 0, 0); \
    __builtin_amdgcn_s_setprio(0);                                                                      \
  } while (0)
#define WAIT_V(n) asm volatile("s_waitcnt vmcnt(" #n ")" ::: "memory")
#define WAIT_L(n) asm volatile("s_waitcnt lgkmcnt(" #n ")" ::: "memory")
#define BAR __builtin_amdgcn_s_barrier()
#define SCHED __builtin_amdgcn_sched_barrier(0)
  const int wid = TIDX >> 6, lane = TIDX & 63, wr = wid >> 2, wc = wid & 3, fr = lane & 15, fq = lane >> 4;
  f32x4 acc[2][2][4][2];
#pragma unroll
  for (int a = 0; a < 2; ++a)
#pragma unroll
    for (int b = 0; b < 2; ++b)
#pragma unroll
      for (int m = 0; m < 4; ++m)
#pragma unroll
        for (int n = 0; n < 2; ++n) acc[a][b][m][n] = (f32x4){0.f, 0.f, 0.f, 0.f};
  bf16x8 At[4][2], B0[2][2], B1[2][2];
  const int nt = K / 64;
  const int swz_ = (fr * 64 + fq * 16) ^ ((((fr * 64 + fq * 16) >> 9) & 1) << 5);
  const char* lds_a = (const char*)shm + wr * 8192 + swz_;
  const char* lds_b = (const char*)shm + 65536 + wc * 4096 + swz_;
  unsigned voff0, voff1;
  {
    int r_, c_;
    stage_rc(TIDX * 16, r_, c_);
    voff0 = (unsigned)(r_ * ld + c_) * 2u;
    stage_rc(TIDX * 16 + 8192, r_, c_);
    voff1 = (unsigned)(r_ * ld + c_) * 2u;
  }
  STAGE(SB(0, 0), Bt, bcol, 0); STAGE(SA(0, 0), A, brow, 0);
  STAGE(SB(0, 1), Bt, bcol + 128, 0); STAGE(SA(0, 1), A, brow + 128, 0);
  if (wr == 1) BAR;
  WAIT_V(4); BAR;
  STAGE(SB(1, 0), Bt, bcol, 1); STAGE(SA(1, 0), A, brow, 1); STAGE(SB(1, 1), Bt, bcol + 128, 1);
  WAIT_V(6); BAR;
  for (int t = 0; t < nt - 2; t += 2) {
    LDB(B0, 0, 0); SCHED; LDA(At, 0, 0); STAGE(SA(1, 1), A, brow + 128, t + 1);
    WAIT_L(8); BAR; WAIT_L(0); MMA(0, 0, At, B0); BAR; SCHED;
    LDB(B1, 0, 1); STAGE(SB(0, 0), Bt, bcol, t + 2);
    BAR; WAIT_L(0); MMA(0, 1, At, B1); BAR;
    LDA(At, 0, 1); STAGE(SA(0, 0), A, brow, t + 2);
    BAR; WAIT_L(0); MMA(1, 0, At, B0); BAR; SCHED;
    STAGE(SB(0, 1), Bt, bcol + 128, t + 2);
    WAIT_V(6); BAR; MMA(1, 1, At, B1); BAR;
    LDB(B0, 1, 0); SCHED; LDA(At, 1, 0); STAGE(SA(0, 1), A, brow + 128, t + 2);
    WAIT_L(8); BAR; WAIT_L(0); MMA(0, 0, At, B0); BAR; SCHED;
    LDB(B1, 1, 1); STAGE(SB(1, 0), Bt, bcol, t + 3);
    BAR; WAIT_L(0); MMA(0, 1, At, B1); BAR;
    LDA(At, 1, 1); STAGE(SA(1, 0), A, brow, t + 3);
    BAR; WAIT_L(0); MMA(1, 0, At, B0); BAR; SCHED;
    STAGE(SB(1, 1), Bt, bcol + 128, t + 3);
    WAIT_V(6); BAR; MMA(1, 1, At, B1); BAR;
  }
  { LDB(B0, 0, 0); LDA(At, 0, 0); STAGE(SA(1, 1), A, brow + 128, nt - 1);
    BAR; WAIT_L(0); MMA(0, 0, At, B0); BAR;
    LDB(B1, 0, 1); BAR; WAIT_L(0); MMA(0, 1, At, B1); BAR;
    LDA(At, 0, 1); WAIT_V(4); BAR; WAIT_L(0); MMA(1, 0, At, B0); MMA(1, 1, At, B1); BAR; }
  { LDB(B0, 1, 0); LDA(At, 1, 0); WAIT_V(2); BAR; WAIT_L(0); MMA(0, 0, At, B0); BAR;
    LDB(B1, 1, 1); WAIT_V(0); BAR; WAIT_L(0); MMA(0, 1, At, B1); BAR;
    LDA(At, 1, 1); BAR; WAIT_L(0); MMA(1, 0, At, B0); MMA(1, 1, At, B1); BAR; }
  if (wr == 0) BAR;
  epi.begin();
#pragma unroll
  for (int ai = 0; ai < 2; ++ai)
#pragma unroll
    for (int m = 0; m < 4; ++m) {
      const int row = brow + ai * 128 + wr * 64 + m * 16 + fr;
      typename Epi::Pre pre[2][2];
#pragma unroll
      for (int bj = 0; bj < (HALF ? 1 : 2); ++bj)
#pragma unroll
        for (int n = 0; n < 2; ++n) pre[bj][n] = epi.load(row, bcol + bj * 128 + wc * 32 + n * 16 + fq * 4);
#pragma unroll
      for (int bj = 0; bj < (HALF ? 1 : 2); ++bj)
#pragma unroll
        for (int n = 0; n < 2; ++n) epi.store(row, bcol + bj * 128 + wc * 32 + n * 16 + fq * 4, acc[ai][bj][m][n], pre[bj][n]);
    }
  epi.end();
#undef SA
#undef SB
#undef STAGE
#undef LDA
#undef LDB
#undef MMA
}

struct EpiBf16 {
  u16* C;
  int ldc;
  float scale;
  struct Pre {};
  DI void begin() const {}
  DI void end() const {}
  DI Pre load(int, int) const { return Pre{}; }
  DI void store(int m, int n, f32x4 v, Pre) const {
    uint2 r;
    r.x = pack2(v[0] * scale, v[1] * scale);
    r.y = pack2(v[2] * scale, v[3] * scale);
    *(uint2*)(C + (size_t)m * ldc + n) = r;
  }
};

struct EpiBf16P {
  u16* C;
  int ldc;
  struct Pre {};
  DI void begin() const {}
  DI void end() const {}
  DI Pre load(int, int) const { return Pre{}; }
  DI void store(int m, int n, f32x4 v, Pre) const {
    const int np = (n & ~12) | ((n & 4) << 1) | ((n & 8) >> 1);
    uint2 r;
    r.x = pack2(v[0], v[1]);
    r.y = pack2(v[2], v[3]);
    *(uint2*)(C + (size_t)m * ldc + np) = r;
  }
};

struct EpiLdsF32 {
  float* lds;
  int m0;
  struct Pre {};
  DI void begin() const {}
  DI void end() const {}
  DI Pre load(int, int) const { return Pre{}; }
  DI void store(int m, int n, f32x4 v, Pre) const { *(f32x4*)(lds + (m - m0) * 128 + n) = v; }
};
struct EpiDftSym {
  const float* lds;
  int m0, S;
  u16* obase;
  int ldo;
  float scale;
  struct Pre { f32x4 pv; };
  DI void begin() const {}
  DI void end() const {}
  DI Pre load(int m, int n) const { Pre q; q.pv = *(const f32x4*)(lds + (m - m0) * 128 + n); return q; }
  DI void store(int m, int n, f32x4 v, const Pre& q) const {
    uint2 r;
    r.x = pack2((q.pv[0] + v[0]) * scale, (q.pv[1] + v[1]) * scale);
    r.y = pack2((q.pv[2] + v[2]) * scale, (q.pv[3] + v[3]) * scale);
    *(uint2*)(obase + (size_t)m * ldo + n) = r;
    if (m > 0) {
      r.x = pack2((q.pv[0] - v[0]) * scale, (q.pv[1] - v[1]) * scale);
      r.y = pack2((q.pv[2] - v[2]) * scale, (q.pv[3] - v[3]) * scale);
      *(uint2*)(obase + (size_t)(S - m) * ldo + n) = r;
    }
  }
};

DI void tile_decode(int t, int tilesN, int& tm, int& tn) {
  const int per = 8 * tilesN;
  const int grp = t / per, r = t - grp * per;
  tm = grp * 8 + (r & 7);
  tn = r >> 3;
}
DI void tile256_decode(int L, int nM, int nN, int& pm, int& pn) {
  const int nwg = nM * nN;
  int wgid = L;
  {
    const int q = nwg / 8, r = nwg % 8, xcd = wgid % 8, off = wgid / 8;
    wgid = (xcd < r ? xcd * (q + 1) : r * (q + 1) + (xcd - r) * q) + off;
  }
  const int nig = 4 * nM, gid = wgid / nig, fn = gid * 4, gsz = min(nN - fn, 4);
  pn = fn + ((wgid % nig) % gsz);
  pm = (wgid % nig) / gsz;
}

DI void prep_mod_item(const Params& p, u16* smem_u, int it) {
  const int TIDX = tid_opaque();
  float* sm = (float*)smem_u;
  float* red = sm + 5 * 2048;
  const int tid = TIDX;
  const int l = it / 384, n0 = (it % 384) * 32;
  for (int e = tid; e < 5 * 2048; e += NTHR) {
    const int j = e >> 11, k = e & 2047;
    const float v = j == 0 ? p.c_ctx[k] : p.c[(j - 1) * DM + k];
    sm[e] = v / (1.f + __expf(-v));
  }
  __syncthreads();
  const int cgp = tid & 7, kg = tid >> 3;
  float acc[5][4];
#pragma unroll
  for (int j = 0; j < 5; ++j)
#pragma unroll
    for (int q = 0; q < 4; ++q) acc[j][q] = 0.f;
  const float* wp = p.w_mod + (size_t)l * DM * (6 * DM) + (size_t)(kg * 32) * (6 * DM) + n0 + cgp * 4;
#pragma unroll 1
  for (int k0 = 0; k0 < 32; k0 += 16) {
    float4 w[16];
#pragma unroll
    for (int k = 0; k < 16; ++k) { const f32x4 t_ = __builtin_nontemporal_load((const f32x4*)(wp + (size_t)(k0 + k) * (6 * DM))); w[k] = make_float4(t_[0], t_[1], t_[2], t_[3]); }
#pragma unroll
    for (int k = 0; k < 16; ++k)
#pragma unroll
      for (int j = 0; j < 5; ++j) {
        const float s = sm[j * 2048 + kg * 32 + k0 + k];
        acc[j][0] += s * w[k].x; acc[j][1] += s * w[k].y; acc[j][2] += s * w[k].z; acc[j][3] += s * w[k].w;
      }
  }
#pragma unroll
  for (int j = 0; j < 5; ++j)
#pragma unroll
    for (int q = 0; q < 4; ++q) red[(kg * 8 + cgp) * 20 + j * 4 + q] = acc[j][q];
  __syncthreads();
  if (tid < 160) {
    const int j = tid >> 5, n = tid & 31;
    float s = p.b_mod[l * (6 * DM) + n0 + n];
#pragma unroll 8
    for (int g = 0; g < 64; ++g) s += red[(g * 8 + (n >> 2)) * 20 + j * 4 + (n & 3)];
    p.mod[((size_t)l * 5 + j) * (6 * DM) + n0 + n] = s;
  }
}

struct TrDesc { const float* src; u16* dst; int K, N, k0, n0; };
DI void transpose_load(const TrDesc& d, int tid, float4 (&v)[8]) {
  const int r = tid >> 4, c4 = tid & 15;
#pragma unroll
  for (int ps = 0; ps < 8; ++ps) {
    const f32x4 t_ = __builtin_nontemporal_load((const f32x4*)(d.src + (size_t)(d.k0 + r + 16 * ps) * d.N + d.n0 + c4 * 4));
    v[ps] = make_float4(t_[0], t_[1], t_[2], t_[3]);
  }
}
DI void transpose_finish(u16* smem_u, const TrDesc& d, int tid, const float4 (&v)[8]) {
  float* tile = (float*)smem_u;
  const int r = tid >> 4, c4 = tid & 15;
#pragma unroll
  for (int ps = 0; ps < 8; ++ps) {
    const int k = r + 16 * ps;
    tile[k * 65 + c4 * 4 + 0] = v[ps].x; tile[k * 65 + c4 * 4 + 1] = v[ps].y;
    tile[k * 65 + c4 * 4 + 2] = v[ps].z; tile[k * 65 + c4 * 4 + 3] = v[ps].w;
  }
  __syncthreads();
  const int n = tid >> 2, kq = tid & 3;
  unsigned w[16];
#pragma unroll
  for (int i = 0; i < 16; ++i) w[i] = pack2(tile[(kq * 32 + 2 * i) * 65 + n], tile[(kq * 32 + 2 * i + 1) * 65 + n]);
  uint4* o = (uint4*)(d.dst + (size_t)(d.n0 + n) * d.K + d.k0 + kq * 32);
  o[0] = make_uint4(w[0], w[1], w[2], w[3]);
  o[1] = make_uint4(w[4], w[5], w[6], w[7]);
  o[2] = make_uint4(w[8], w[9], w[10], w[11]);
  o[3] = make_uint4(w[12], w[13], w[14], w[15]);
}

DI void phase_prep(const Params& p, u16* smem_all) {
  const int TIDX = tid_opaque();
  constexpr int N_MOD = 768;
  constexpr int T_IN = 16 * 53, T_QUP = 3 * 12, T_KVUP = 1 * 16, T_OUT = 16 * 32, T_G = 16 * 88, T_D = 44 * 32;
  constexpr int T_LAYER = T_IN + T_QUP + T_KVUP + T_OUT + 2 * T_G + T_D;
  constexpr int N_TR = 2 * T_LAYER;
  constexpr int N_TRIG = 2088 + 192;
  const int total = N_MOD + N_TR + N_TRIG;
  const int half = TIDX >> 8, tid = TIDX & 255;
  u16* smem = smem_all + half * 32768;
  if (blockIdx.x == 0 && TIDX < 32) p.ctr[TIDX] = 0;
  if (blockIdx.x == 0) p.flags[TIDX] = 0u;
  for (int it = blockIdx.x; it < N_MOD; it += gridDim.x) {
    __syncthreads();
    prep_mod_item(p, smem_all, it);
  }
  {
    auto decode = [&](int t) {
      TrDesc d;
      const int l = t / T_LAYER;
      t -= l * T_LAYER;
      if (t < T_IN) { d.src = p.w_in + (size_t)l * DM * INC; d.dst = p.WinT + (size_t)l * RLD * DM; d.K = DM; d.N = INC; }
      else if ((t -= T_IN) < T_QUP) { d.src = p.w_q_up + (size_t)l * 384 * 768; d.dst = p.WqupT + (size_t)l * 768 * 384; d.K = 384; d.N = 768; }
      else if ((t -= T_QUP) < T_KVUP) { d.src = p.w_kv_up + (size_t)l * 128 * 1024; d.dst = p.WkvupT + (size_t)l * 1024 * 128; d.K = 128; d.N = 1024; }
      else if ((t -= T_KVUP) < T_OUT) { d.src = p.w_out + (size_t)l * DM * DM; d.dst = p.WoutT + (size_t)l * DM * DM; d.K = DM; d.N = DM; }
      else if ((t -= T_OUT) < T_G) { d.src = p.w_gate + (size_t)l * DM * DFF; d.dst = p.WgateT + (size_t)l * DFF * DM; d.K = DM; d.N = DFF; }
      else if ((t -= T_G) < T_G) { d.src = p.w_up + (size_t)l * DM * DFF; d.dst = p.WupT + (size_t)l * DFF * DM; d.K = DM; d.N = DFF; }
      else { t -= T_G; d.src = p.w_down + (size_t)l * DFF * DM; d.dst = p.WdownT + (size_t)l * DM * DFF; d.K = DFF; d.N = DM; }
      const int tilesN = d.N >> 6;
      const int tk = t / tilesN, tn = t - tk * tilesN;
      d.k0 = tk * 128;
      d.n0 = tn * 64;
      return d;
    };
    int t = blockIdx.x * 2 + half;
    const int tstep = gridDim.x * 2;
    float4 va[8], vb[8];
    TrDesc da, db;
    if (t < N_TR) { da = decode(t); transpose_load(da, tid, va); }
#pragma unroll 1
    for (; t < N_TR; t += 2 * tstep) {
      const bool hb = t + tstep < N_TR;
      if (hb) { db = decode(t + tstep); transpose_load(db, tid, vb); }
      __syncthreads();
      transpose_finish(smem, da, tid, va);
      if (hb) {
        const bool ha = t + 2 * tstep < N_TR;
        if (ha) { da = decode(t + 2 * tstep); transpose_load(da, tid, va); }
        __syncthreads();
        transpose_finish(smem, db, tid, vb);
      }
    }
  }
  for (int it = N_MOD + N_TR + blockIdx.x * 2 + half; it < total; it += gridDim.x * 2) {
    {
      const int t = it - N_MOD - N_TR;
#pragma unroll 1
      for (int q = 0; q < 16; ++q) {
        int e = t * 4096 + q * 256 + tid;
        if (e < 32768) {
          const int j = e >> 7, c = e & 127;
          const int jj = j & 127;
          const float x = (float)((jj * c) & 127) * (1.f / 64.f);
          float sn, cs;
          sincospif(x, &sn, &cs);
          p.trig128[e] = f2bf(j < 128 ? cs : sn);
        } else if ((e -= 32768) < 131072) {
          const int k = e >> 9, s2 = e & 511, s = s2 & 255;
          const float x = (float)((k * s) & 255) * (1.f / 128.f);
          float sn, cs;
          sincospif(x, &sn, &cs);
          p.W256[e] = f2bf(s2 < 256 ? cs : -sn);
        } else if ((e -= 131072) < 8388608) {
          const int k = e >> 12, s2 = e & 4095, s = s2 & 2047;
          const float x = (float)((k * s) & 2047) * (1.f / 1024.f);
          float sn, cs;
          sincospif(x, &sn, &cs);
          p.W2048[e] = f2bf(s2 < 2048 ? cs : -sn);
        } else {
          e -= 8388608;
          const int l = e / (192 * 2048), r = e - l * (192 * 2048);
          p.WinT[(size_t)l * RLD * DM + (size_t)INC * DM + r] = 0;
        }
      }
    }
  }
}

DI void load_row32(const float* xf, const u16* xb, int lane, float4 (&v)[8]) {
  if (xb) {
#pragma unroll
    for (int i = 0; i < 4; ++i) {
      const uint4 r = *(const uint4*)(xb + i * 512 + lane * 8);
      v[2 * i] = make_float4(bf2f((u16)(r.x & 0xffff)), bf2f((u16)(r.x >> 16)), bf2f((u16)(r.y & 0xffff)), bf2f((u16)(r.y >> 16)));
      v[2 * i + 1] = make_float4(bf2f((u16)(r.z & 0xffff)), bf2f((u16)(r.z >> 16)), bf2f((u16)(r.w & 0xffff)), bf2f((u16)(r.w >> 16)));
    }
  } else {
#pragma unroll
    for (int i = 0; i < 4; ++i) {
      v[2 * i] = *(const float4*)(xf + i * 512 + lane * 8);
      v[2 * i + 1] = *(const float4*)(xf + i * 512 + lane * 8 + 4);
    }
  }
}
DI void phase_modulate(const Params& p, int l, int which) {
  const int TIDX = tid_opaque();
  const int lane = TIDX & 63, wid = TIDX >> 6;
  const float* gain = (which ? p.g_ffn : p.g_mix) + l * DM;
  const u16* xbsrc = which ? p.x1b : (l == 0 ? nullptr : p.x2b);
  for (int it = blockIdx.x; it < NT / 16; it += gridDim.x) {
    const int row0 = it * 16 + wid * 2;
    float4 va[8], vb[8];
    load_row32(xbsrc ? nullptr : xin_row(p, 0, row0), xbsrc ? xbsrc + (size_t)row0 * DM : nullptr, lane, va);
    load_row32(xbsrc ? nullptr : xin_row(p, 0, row0 + 1), xbsrc ? xbsrc + (size_t)(row0 + 1) * DM : nullptr, lane, vb);
    float sa = 0.f, sb = 0.f;
#pragma unroll
    for (int i = 0; i < 8; ++i) {
      sa += va[i].x * va[i].x + va[i].y * va[i].y + va[i].z * va[i].z + va[i].w * va[i].w;
      sb += vb[i].x * vb[i].x + vb[i].y * vb[i].y + vb[i].z * vb[i].z + vb[i].w * vb[i].w;
    }
    sa = wave_sum(sa);
    sb = wave_sum(sb);
    const float ra = rsqrtf(sa * (1.f / DM) + EPSV), rb = rsqrtf(sb * (1.f / DM) + EPSV);
    const float* md = p.mod + ((size_t)l * 5 + mod_index(row0)) * (6 * DM);
    const float* sh = md + (which ? 3 : 0) * DM;
    const float* sc = md + (which ? 4 : 1) * DM;
#pragma unroll
    for (int i = 0; i < 4; ++i) {
      const int c = i * 512 + lane * 8;
      uint4 oa, ob;
#pragma unroll
      for (int hf = 0; hf < 2; ++hf) {
        const int cc = c + hf * 4;
        const float4 g = *(const float4*)(gain + cc), s1 = *(const float4*)(sc + cc), s0 = *(const float4*)(sh + cc);
        const float gx = g.x * (1.f + s1.x), gy = g.y * (1.f + s1.y), gz = g.z * (1.f + s1.z), gw = g.w * (1.f + s1.w);
        const float4 a = va[2 * i + hf], b = vb[2 * i + hf];
        const unsigned a0 = pack2(a.x * ra * gx + s0.x, a.y * ra * gy + s0.y), a1 = pack2(a.z * ra * gz + s0.z, a.w * ra * gw + s0.w);
        const unsigned b0 = pack2(b.x * rb * gx + s0.x, b.y * rb * gy + s0.y), b1 = pack2(b.z * rb * gz + s0.z, b.w * rb * gw + s0.w);
        if (hf == 0) { oa.x = a0; oa.y = a1; ob.x = b0; ob.y = b1; } else { oa.z = a0; oa.w = a1; ob.z = b0; ob.w = b1; }
      }
      *(uint4*)(p.h + (size_t)row0 * DM + c) = oa;
      *(uint4*)(p.h + (size_t)(row0 + 1) * DM + c) = ob;
    }
  }
}

DI void phase_qkv(const Params& p, u16* smem, int l) {
  const u16* W = p.WinT + (size_t)l * RLD * DM;
#pragma unroll 1
  for (int it = blockIdx.x; it < 48 * 14; it += gridDim.x) {
    __syncthreads();
    int pm, pn;
    tile256_decode(it, 48, 14, pm, pn);
    gemm256_tile(smem, p.h, W, DM, DM, pm * 256, pn * 256, EpiBf16{p.raw, RLD, 1.f});
  }
}

DI float rope_apply(float y, float sn, float cs, int lane) {
  const float pr = __shfl_xor(y, 16);
  return (lane & 16) ? (pr * sn + y * cs) : (y * cs - pr * sn);
}
DI void rope_trig(int lane, int pos_row, int pos_col, float& sn, float& cs) {
  const int i = lane & 15;
  const float inv = exp2f(-(float)i * (13.287712379549449f / 16.f));
  const float ang = (float)((lane < 32) ? pos_row : pos_col) * inv;
  sincosf(ang, &sn, &cs);
}

DI void phase_post1(const Params& p, u16* smem, int l) {
  const int TIDX = tid_opaque();
  const int lane = TIDX & 63, wid = TIDX >> 6;
  float* o_nak = p.out + 25165824;
  float* o_nav = o_nak + 4194304;
  float* o_ckv = o_nav + 4194304;
  float* o_kr = o_ckv + 1048576;
  float* o_wk = o_kr + 524288;
  float* o_wv = o_wk + 1048576;
  for (int it = blockIdx.x; it < NTA / 8; it += gridDim.x) {
    const int tok = it * 8 + wid;
    if (tok < NT) {
      const u16* rp = p.raw + (size_t)tok * RLD + lane;
      u16 r[45];
#pragma unroll
      for (int i = 0; i < 45; ++i) r[i] = rp[i * 64];
      asm volatile("" ::: "memory");
      const bool ctx = tok < NTC;
      size_t ob = 0;
      float sn = 0.f, cs = 1.f;
      if (ctx) {
        const int b = tok >> 8, s = tok & 255;
        ob = (size_t)(b * 2 + l) * 256 + s;
      } else {
        const int pos = (tok - NTC) & 2047;
        rope_trig(lane, pos >> 6, pos & 63, sn, cs);
      }
      const float gq = p.g_qn_na[l * 64 + lane], gk = p.g_kn_na[l * 64 + lane];
#pragma unroll
      for (int h = 0; h < 8; ++h) {
        float v = bf2f(r[h]);
        float ss = wave_sum(v * v);
        p.Qa[(size_t)tok * 512 + h * 64 + lane] = f2bf(v * rsqrtf(ss * (1.f / 64.f) + EPSV) * gq * (0.125f * LOG2E));
        v = bf2f(r[8 + h]);
        ss = wave_sum(v * v);
        const float y = v * rsqrtf(ss * (1.f / 64.f) + EPSV) * gk;
        p.Ka[(size_t)tok * 512 + h * 64 + lane] = f2bf(y);
        if (ctx) {
          o_nak[(ob * 8 + h) * 64 + lane] = y;
          o_nav[(ob * 8 + h) * 64 + lane] = bf2f(r[16 + h]);
        }
      }
      {
        float v[6], ss = 0.f;
#pragma unroll
        for (int i = 0; i < 6; ++i) { v[i] = bf2f(r[24 + i]); ss += v[i] * v[i]; }
        ss = wave_sum(ss);
        const float rs = rsqrtf(ss * (1.f / 384.f) + EPSV);
#pragma unroll
        for (int i = 0; i < 6; ++i) p.cq[(size_t)tok * 384 + i * 64 + lane] = f2bf(v[i] * rs * p.g_q_lora[l * 384 + i * 64 + lane]);
      }
      {
        const float v0 = bf2f(r[30]), v1 = bf2f(r[31]);
        const float ss = wave_sum(v0 * v0 + v1 * v1);
        const float rs = rsqrtf(ss * (1.f / 128.f) + EPSV);
        const float y0 = v0 * rs * p.g_kv_lora[l * 128 + lane], y1 = v1 * rs * p.g_kv_lora[l * 128 + 64 + lane];
        p.ckv[(size_t)tok * 128 + lane] = f2bf(y0);
        p.ckv[(size_t)tok * 128 + 64 + lane] = f2bf(y1);
        if (ctx) { o_ckv[ob * 128 + lane] = y0; o_ckv[ob * 128 + 64 + lane] = y1; }
      }
      {
        p.krope[(size_t)tok * 64 + lane] = r[32];
        if (ctx) o_kr[ob * 64 + lane] = bf2f(r[32]);
      }
      const float gqw = p.g_qn_win[l * 64 + lane], gkw = p.g_kn_win[l * 64 + lane];
#pragma unroll
      for (int hq = 0; hq < 8; ++hq) {
        const float v = bf2f(r[33 + hq]);
        const float ss = wave_sum(v * v);
        float y = v * rsqrtf(ss * (1.f / 64.f) + EPSV) * gqw;
        if (!ctx) y = rope_apply(y, sn, cs, lane);
        p.Qw[(size_t)tok * 512 + hq * 64 + lane] = f2bf(y * (0.125f * LOG2E));
      }
#pragma unroll
      for (int kh = 0; kh < 2; ++kh) {
        const float v = bf2f(r[41 + kh]);
        const float ss = wave_sum(v * v);
        float y = v * rsqrtf(ss * (1.f / 64.f) + EPSV) * gkw;
        if (ctx) {
          o_wk[(ob * 2 + kh) * 64 + lane] = y;
          o_wv[(ob * 2 + kh) * 64 + lane] = bf2f(r[43 + kh]);
        } else {
          y = rope_apply(y, sn, cs, lane);
        }
        p.Kw[(size_t)tok * 128 + kh * 64 + lane] = f2bf(y);
      }
    } else {
      const int cr = tok - NT, b = cr >> 9, key = cr & 511;
      const size_t cb = (size_t)(b * 2 + l) * 512 + key;
      const int tokp = (tok & ~12) | ((tok & 4) << 1) | ((tok & 8) >> 1);
      float ck[8], cv[8], c0, c1, c2, wk[2], wv[2];
#pragma unroll
      for (int h = 0; h < 8; ++h) {
        ck[h] = p.cache_na_k[(cb * 8 + h) * 64 + lane];
        cv[h] = p.cache_na_v[(cb * 8 + h) * 64 + lane];
      }
      c0 = p.cache_mla_ckv[cb * 128 + lane];
      c1 = p.cache_mla_ckv[cb * 128 + 64 + lane];
      c2 = p.cache_mla_krope[cb * 64 + lane];
#pragma unroll
      for (int kh = 0; kh < 2; ++kh) {
        wk[kh] = p.cache_win_k[(cb * 2 + kh) * 64 + lane];
        wv[kh] = p.cache_win_v[(cb * 2 + kh) * 64 + lane];
      }
      asm volatile("" ::: "memory");
#pragma unroll
      for (int h = 0; h < 8; ++h) {
        p.Ka[(size_t)tok * 512 + h * 64 + lane] = f2bf(ck[h]);
        p.VaT[(size_t)(h * 64 + lane) * NTA + tokp] = f2bf(cv[h]);
      }
      p.ckv[(size_t)tok * 128 + lane] = f2bf(c0);
      p.ckv[(size_t)tok * 128 + 64 + lane] = f2bf(c1);
      p.krope[(size_t)tok * 64 + lane] = f2bf(c2);
#pragma unroll
      for (int kh = 0; kh < 2; ++kh) {
        p.Kw[(size_t)tok * 128 + kh * 64 + lane] = f2bf(wk[kh]);
        p.VwT[(size_t)(kh * 64 + lane) * NTA + tokp] = f2bf(wv[kh]);
      }
    }
  }
  for (int it = blockIdx.x; it < NT / 64; it += gridDim.x) {
    __syncthreads();
    const int tok0 = it * 64;
    for (int e = TIDX; e < 64 * 80; e += NTHR) {
      const int row = e / 80, ch = e - row * 80;
      const int col = ch < 64 ? C_AV + ch * 8 : C_CV + (ch - 64) * 8;
      const uint4 v = *(const uint4*)(p.raw + (size_t)(tok0 + row) * RLD + col);
      *(uint4*)(smem + row * 648 + ch * 8) = v;
    }
    __syncthreads();
    for (int e = TIDX; e < 640 * 4; e += NTHR) {
      const int vc = e >> 2, tg = e & 3;
      u16 t[16];
#pragma unroll
      for (int i = 0; i < 16; ++i) t[i] = smem[(tg * 16 + i) * 648 + vc];
      uint4 a, b;
      a.x = t[0] | ((unsigned)t[1] << 16); a.y = t[2] | ((unsigned)t[3] << 16);
      a.z = t[8] | ((unsigned)t[9] << 16); a.w = t[10] | ((unsigned)t[11] << 16);
      b.x = t[4] | ((unsigned)t[5] << 16); b.y = t[6] | ((unsigned)t[7] << 16);
      b.z = t[12] | ((unsigned)t[13] << 16); b.w = t[14] | ((unsigned)t[15] << 16);
      u16* d = (vc < 512 ? p.VaT + (size_t)vc * NTA : p.VwT + (size_t)(vc - 512) * NTA) + tok0 + tg * 16;
      *(uint4*)d = a;
      *(uint4*)(d + 8) = b;
    }
  }
}

DI void phase_up(const Params& p, u16* smem, int l) {
  constexpr int T1 = 96 * 6, T2 = 112 * 4, T3 = 4 * 112, T4 = 256, T5 = 512;
  const u16* Wq = p.WqupT + (size_t)l * 768 * 384;
  const u16* Wkv = p.WkvupT + (size_t)l * 1024 * 128;
  for (int it = blockIdx.x; it < T1 + T2 + T3 + T4 + T5; it += gridDim.x) {
    __syncthreads();
    int t = it;
    if (t < T1) {
      const int tm = t / 6, tn = t - tm * 6;
      gemm_tile(smem, p.cq, 384, Wq, 384, 384, tm * 128, tn * 128, 768, EpiBf16{p.qmraw, 768, 1.f});
    } else if ((t -= T1) < T2) {
      const int tm = t >> 2, hd = t & 3;
      gemm_tile(smem, p.ckv, 128, Wkv, 128, 128, tm * 128, hd * 256, 1024, EpiBf16{p.kvraw, 1024, 1.f});
    } else if ((t -= T2) < T3) {
      const int hd = t & 3, tn = t >> 2;
      gemm_tile(smem, Wkv + (size_t)(hd * 256 + 128) * 128, 128, p.ckv, 128, 128, 0, tn * 128, NTA,
                EpiBf16P{p.VmT + (size_t)hd * 128 * NTA, NTA});
    } else if ((t -= T3) < T4) {
      const int tn = t & 1, pr = t >> 1, csn = pr & 1, bg = pr >> 1, b = bg >> 2, g = bg & 3;
      gemm_tile(smem, p.trig128 + csn * 128 * 128, 128, p.raw + (size_t)(b * 256) * RLD + C_FV + g * 128, RLD, 128, 0,
                tn * 128, 256, EpiBf16{p.ZtC + (size_t)bg * 128 * 512 + csn * 256, 512, 1.f});
    } else {
      t -= T4;
      const int tn = t & 15, pr = t >> 4, csn = pr & 1, bg = pr >> 1, b = bg >> 2, g = bg & 3;
      gemm_tile(smem, p.trig128 + csn * 128 * 128, 128, p.raw + (size_t)(NTC + b * 2048) * RLD + C_FV + g * 128, RLD, 128,
                0, tn * 128, 2048, EpiBf16{p.ZtL + (size_t)bg * 128 * 4096 + csn * 2048, 4096, 1.f});
    }
  }
}

DI void phase_post2(const Params& p, int l) {
  const int TIDX = tid_opaque();
  const int lane = TIDX & 63, wid = TIDX >> 6;
  const float SCM = 0.07216878364870322f * LOG2E;
  const float gq0 = p.g_qn_mla[l * 192 + lane], gq1 = p.g_qn_mla[l * 192 + 64 + lane], gq2 = p.g_qn_mla[l * 192 + 128 + lane];
  const float gk0 = p.g_kn_mla[l * 192 + lane], gk1 = p.g_kn_mla[l * 192 + 64 + lane], gk2 = p.g_kn_mla[l * 192 + 128 + lane];
  for (int it = blockIdx.x; it < NTA / 8; it += gridDim.x) {
    const int tok = it * 8 + wid;
    const bool lat = tok >= NTC && tok < NT;
    const bool hasq = tok < NT;
    u16 qv[12], kv[8], kr;
    {
      const u16* qp = p.qmraw + (size_t)(hasq ? tok : 0) * 768 + lane;
#pragma unroll
      for (int i = 0; i < 12; ++i) qv[i] = qp[i * 64];
      const u16* kp = p.kvraw + (size_t)tok * 1024 + lane;
#pragma unroll
      for (int h = 0; h < 4; ++h) { kv[2 * h] = kp[h * 256]; kv[2 * h + 1] = kp[h * 256 + 64]; }
      kr = p.krope[(size_t)tok * 64 + lane];
    }
    asm volatile("" ::: "memory");
    float sn = 0.f, cs = 1.f;
    if (lat) {
      const int pos = (tok - NTC) & 2047;
      rope_trig(lane, pos >> 6, pos & 63, sn, cs);
    }
    if (hasq) {
#pragma unroll
      for (int h = 0; h < 4; ++h) {
        const float v0 = bf2f(qv[3 * h]), v1 = bf2f(qv[3 * h + 1]), v2 = bf2f(qv[3 * h + 2]);
        const float ss = wave_sum(v0 * v0 + v1 * v1 + v2 * v2);
        const float rs = rsqrtf(ss * (1.f / 192.f) + EPSV);
        float y2 = v2 * rs * gq2;
        if (lat) y2 = rope_apply(y2, sn, cs, lane);
        u16* q = p.Qm + (size_t)tok * 768 + h * 192;
        q[lane] = f2bf(v0 * rs * gq0 * SCM);
        q[64 + lane] = f2bf(v1 * rs * gq1 * SCM);
        q[128 + lane] = f2bf(y2 * SCM);
      }
    }
    {
      const float v2 = bf2f(kr);
#pragma unroll
      for (int h = 0; h < 4; ++h) {
        const float v0 = bf2f(kv[2 * h]), v1 = bf2f(kv[2 * h + 1]);
        const float ss = wave_sum(v0 * v0 + v1 * v1 + v2 * v2);
        const float rs = rsqrtf(ss * (1.f / 192.f) + EPSV);
        float y2 = v2 * rs * gk2;
        if (lat) y2 = rope_apply(y2, sn, cs, lane);
        u16* k = p.Km + (size_t)tok * 768 + h * 192;
        k[lane] = f2bf(v0 * rs * gk0);
        k[64 + lane] = f2bf(v1 * rs * gk1);
        k[128 + lane] = f2bf(y2);
      }
    }
  }
}

DI void attn_mla_block(u16* smem, const u16* __restrict__ Qp, const u16* __restrict__ Kh, const u16* __restrict__ Vh,
                       u16* __restrict__ Op, int lk0, int nl, int ck0, int nc) {
  const int TIDX = tid_opaque();
  const int lane = TIDX & 63, qi = lane & 31, hh = lane >> 5;
  char* lds = (char*)smem;
  unsigned ko0, ko1, ko2, vo0, vo1;
  {
    int L = TIDX * 16, row = L / 384, pc = (L % 384) >> 4;
    ko0 = (unsigned)(row * 768 + ((pc & ~7) | ((pc & 7) ^ ((row >> 1) & 7))) * 8) * 2u;
    L += 8192; row = L / 384; pc = (L % 384) >> 4;
    ko1 = (unsigned)(row * 768 + ((pc & ~7) | ((pc & 7) ^ ((row >> 1) & 7))) * 8) * 2u;
    L += 8192; row = L / 384; pc = (L % 384) >> 4;
    ko2 = (unsigned)(row * 768 + ((pc & ~7) | ((pc & 7) ^ ((row >> 1) & 7))) * 8) * 2u;
    L = TIDX * 16; row = L >> 7; pc = (L & 127) >> 4;
    vo0 = (unsigned)(row * NTA + (pc ^ ((row >> 1) & 7)) * 8) * 2u;
    L += 8192; row = L >> 7; pc = (L & 127) >> 4;
    vo1 = (unsigned)(row * NTA + (pc ^ ((row >> 1) & 7)) * 8) * 2u;
  }
  const int xk = (qi >> 1) & 7;
  int kx[4], vx[4];
#pragma unroll
  for (int q = 0; q < 4; ++q) {
    kx[q] = qi * 384 + (((q * 2 + hh) ^ xk) << 4);
    vx[q] = qi * 128 + (((q * 2 + hh) ^ xk) << 4);
  }
  bf16x8 qf[12];
#pragma unroll
  for (int kk = 0; kk < 12; ++kk) qf[kk] = *(const bf16x8*)(Qp + (size_t)qi * 768 + kk * 16 + hh * 8);
  f32x16 o[4];
#pragma unroll
  for (int mt = 0; mt < 4; ++mt)
#pragma unroll
    for (int i = 0; i < 16; ++i) o[mt][i] = 0.f;
  float m = -1e30f, lsum = 0.f;
  const int nt = nl + nc;
#define MLA_LDS(p_) ((__attribute__((address_space(3))) unsigned*)(p_))
#define MLA_ISSUE(j_, st_)                                                                        \
  do {                                                                                            \
    const int kt_ = (j_) < nl ? lk0 + (j_) * 64 : ck0 + ((j_) - nl) * 64;                         \
    const char* kb_ = (const char*)(Kh + (size_t)kt_ * 768);                                      \
    const char* vb_ = (const char*)(Vh + kt_);                                                    \
    char* d_ = lds + (st_) * 40960 + TIDX * 16;                                                   \
    __builtin_amdgcn_global_load_lds((const unsigned*)(kb_ + ko0), MLA_LDS(d_), 16, 0, 0);        \
    __builtin_amdgcn_global_load_lds((const unsigned*)(kb_ + ko1), MLA_LDS(d_ + 8192), 16, 0, 0); \
    __builtin_amdgcn_global_load_lds((const unsigned*)(kb_ + ko2), MLA_LDS(d_ + 16384), 16, 0, 0); \
    __builtin_amdgcn_global_load_lds((const unsigned*)(vb_ + vo0), MLA_LDS(d_ + 24576), 16, 0, 0); \
    __builtin_amdgcn_global_load_lds((const unsigned*)(vb_ + vo1), MLA_LDS(d_ + 32768), 16, 0, 0); \
  } while (0)
#define MLA_BAR                                \
  do {                                         \
    asm volatile("" ::: "memory");             \
    __builtin_amdgcn_s_barrier();              \
    asm volatile("" ::: "memory");             \
  } while (0)
  MLA_ISSUE(0, 0);
  if (nt > 1) MLA_ISSUE(1, 1);
  int st = 0, stn = 2;
#pragma unroll 1
  for (int j = 0; j < nt; ++j) {
    if (j + 1 < nt) {
      asm volatile("s_waitcnt vmcnt(5)" ::: "memory");
    } else {
      asm volatile("s_waitcnt vmcnt(0)" ::: "memory");
    }
    MLA_BAR;
    if (j + 2 < nt) MLA_ISSUE(j + 2, stn);
    const char* ks = lds + st * 40960;
    const char* vs = ks + 24576;
    f32x16 s0, s1;
#pragma unroll
    for (int i = 0; i < 16; ++i) { s0[i] = 0.f; s1[i] = 0.f; }
#pragma unroll
    for (int kk = 0; kk < 12; ++kk) {
      const int off = (kk >> 2) * 128 + kx[kk & 3];
      const bf16x8 k0 = *(const bf16x8*)(ks + off);
      const bf16x8 k1 = *(const bf16x8*)(ks + 12288 + off);
      s0 = __builtin_amdgcn_mfma_f32_32x32x16_bf16(k0, qf[kk], s0, 0, 0, 0);
      s1 = __builtin_amdgcn_mfma_f32_32x32x16_bf16(k1, qf[kk], s1, 0, 0, 0);
    }
    float mx = fmaxf(s0[0], s1[0]);
#pragma unroll
    for (int i = 1; i < 16; ++i) mx = fmaxf(mx, fmaxf(s0[i], s1[i]));
    mx = fmaxf(mx, __shfl_xor(mx, 32));
    const float mn = fmaxf(m, mx);
    const float alpha = __builtin_amdgcn_exp2f(m - mn);
    m = mn;
    float rs = 0.f;
#pragma unroll
    for (int i = 0; i < 16; ++i) {
      s0[i] = __builtin_amdgcn_exp2f(s0[i] - mn);
      s1[i] = __builtin_amdgcn_exp2f(s1[i] - mn);
      rs += s0[i] + s1[i];
    }
    rs += __shfl_xor(rs, 32);
    lsum = lsum * alpha + rs;
    if (__builtin_amdgcn_ballot_w64(alpha != 1.f) != 0ull) {
#pragma unroll
      for (int mt = 0; mt < 4; ++mt)
#pragma unroll
        for (int i = 0; i < 16; ++i) o[mt][i] *= alpha;
    }
    union { bf16x8 v; unsigned u[4]; } pf[4];
#pragma unroll
    for (int q = 0; q < 4; ++q) {
      pf[0].u[q] = pack2(s0[2 * q], s0[2 * q + 1]);
      pf[1].u[q] = pack2(s0[8 + 2 * q], s0[8 + 2 * q + 1]);
      pf[2].u[q] = pack2(s1[2 * q], s1[2 * q + 1]);
      pf[3].u[q] = pack2(s1[8 + 2 * q], s1[8 + 2 * q + 1]);
    }
#pragma unroll
    for (int mt = 0; mt < 4; ++mt)
#pragma unroll
      for (int q = 0; q < 4; ++q) {
        const bf16x8 vfr = *(const bf16x8*)(vs + mt * 4096 + vx[q]);
        o[mt] = __builtin_amdgcn_mfma_f32_32x32x16_bf16(vfr, pf[q].v, o[mt], 0, 0, 0);
      }
    st = st == 2 ? 0 : st + 1;
    stn = stn == 2 ? 0 : stn + 1;
  }
#undef MLA_ISSUE
#undef MLA_BAR
#undef MLA_LDS
  const float inv = 1.f / lsum;
#pragma unroll
  for (int mt = 0; mt < 4; ++mt)
#pragma unroll
    for (int g = 0; g < 4; ++g) {
      uint2 r;
      r.x = pack2(o[mt][4 * g] * inv, o[mt][4 * g + 1] * inv);
      r.y = pack2(o[mt][4 * g + 2] * inv, o[mt][4 * g + 3] * inv);
      *(uint2*)(Op + (size_t)qi * DM + mt * 32 + 8 * g + 4 * hh) = r;
    }
}

DI void attn64_block(u16* smem, const u16* __restrict__ Qp, const u16* __restrict__ Kh, int ldk, const u16* __restrict__ Vh,
                     u16* __restrict__ Op, int lk0, int nl, int ck0, int nc, int mode, int qpos0, int seq0, int jlo, int jhi,
                     const float* rpb, float sink2, bool has_sink) {
  const int TIDX = tid_opaque();
  const int lane = TIDX & 63, qi = lane & 31, hh = lane >> 5;
  char* lds = (char*)smem;
  unsigned ko, vo;
  {
    const int L = TIDX * 16, row = L >> 7, pc = (L & 127) >> 4, c = pc ^ ((row >> 1) & 7);
    ko = (unsigned)(row * ldk + c * 8) * 2u;
    vo = (unsigned)(row * NTA + c * 8) * 2u;
  }
  const int xk = (qi >> 1) & 7;
  int kx[4];
#pragma unroll
  for (int q = 0; q < 4; ++q) kx[q] = qi * 128 + (((q * 2 + hh) ^ xk) << 4);
  bf16x8 qf[4];
#pragma unroll
  for (int kk = 0; kk < 4; ++kk) qf[kk] = *(const bf16x8*)(Qp + (size_t)qi * 512 + kk * 16 + hh * 8);
  f32x16 o[2];
#pragma unroll
  for (int mt = 0; mt < 2; ++mt)
#pragma unroll
    for (int i = 0; i < 16; ++i) o[mt][i] = 0.f;
  float m = -1e30f, lsum = 0.f;
  const int qp = qpos0 + qi, qr = qp >> 6, qc = qp & 63;
  const int cs = min(max(qc - 8, 0), 48);
  const float NINF = -__builtin_inff();
  const int nt = nl + nc;
#define A64_LDS(p_) ((__attribute__((address_space(3))) unsigned*)(p_))
#define A64_ISSUE(j_, st_)                                                                    \
  do {                                                                                        \
    const int kt_ = (j_) < nl ? lk0 + (j_) * 64 : ck0 + ((j_) - nl) * 64;                     \
    const char* kb_ = (const char*)(Kh + (size_t)kt_ * ldk);                                  \
    const char* vb_ = (const char*)(Vh + kt_);                                                \
    char* d_ = lds + (st_) * 16384 + TIDX * 16;                                               \
    __builtin_amdgcn_global_load_lds((const unsigned*)(kb_ + ko), A64_LDS(d_), 16, 0, 0);     \
    __builtin_amdgcn_global_load_lds((const unsigned*)(vb_ + vo), A64_LDS(d_ + 8192), 16, 0, 0); \
  } while (0)
#define A64_BAR                                \
  do {                                         \
    asm volatile("" ::: "memory");             \
    __builtin_amdgcn_s_barrier();              \
    asm volatile("" ::: "memory");             \
  } while (0)
  A64_ISSUE(0, 0);
  if (nt > 1) A64_ISSUE(1, 1);
  if (nt > 2) A64_ISSUE(2, 2);
#pragma unroll 1
  for (int j = 0; j < nt; ++j) {
    const int st = j & 3;
    if (j + 2 < nt) {
      asm volatile("s_waitcnt vmcnt(4)" ::: "memory");
    } else if (j + 1 < nt) {
      asm volatile("s_waitcnt vmcnt(2)" ::: "memory");
    } else {
      asm volatile("s_waitcnt vmcnt(0)" ::: "memory");
    }
    A64_BAR;
    if (j + 3 < nt) A64_ISSUE(j + 3, (j + 3) & 3);
    const bool active = (j >= nl) || (j >= jlo && j < jhi);
    if (active) {
      const int kt = j < nl ? lk0 + j * 64 : ck0 + (j - nl) * 64;
      const int md = j < nl ? mode : 0;
      const char* ks = lds + st * 16384;
      const char* vs = ks + 8192;
      f32x16 s0, s1;
#pragma unroll
      for (int i = 0; i < 16; ++i) { s0[i] = 0.f; s1[i] = 0.f; }
#pragma unroll
      for (int kk = 0; kk < 4; ++kk) {
        const bf16x8 k0 = *(const bf16x8*)(ks + kx[kk]);
        const bf16x8 k1 = *(const bf16x8*)(ks + 4096 + kx[kk]);
        s0 = __builtin_amdgcn_mfma_f32_32x32x16_bf16(k0, qf[kk], s0, 0, 0, 0);
        s1 = __builtin_amdgcn_mfma_f32_32x32x16_bf16(k1, qf[kk], s1, 0, 0, 0);
      }
      if (md == 1) {
        const int kr = (kt - seq0) >> 6;
        const float* rl = rpb + (kr - qr + 7) * 31 + (15 - qc);
#pragma unroll
        for (int i = 0; i < 16; ++i) {
          const int kc0 = (i & 3) + 8 * (i >> 2) + 4 * hh, kc1 = kc0 + 32;
          const float b0 = rl[kc0], b1 = rl[kc1];
          s0[i] = ((unsigned)(kc0 - cs) < 16u) ? s0[i] + b0 : NINF;
          s1[i] = ((unsigned)(kc1 - cs) < 16u) ? s1[i] + b1 : NINF;
        }
      } else if (md == 2) {
        const int q0w = qpos0, kb = kt - seq0;
        if (kb + 63 - q0w > 128 || q0w + 31 - kb > 128) {
          const int base = kb - qp + 128;
#pragma unroll
          for (int i = 0; i < 16; ++i) {
            const int c0 = (i & 3) + 8 * (i >> 2) + 4 * hh;
            if ((unsigned)(base + c0) > 256u) s0[i] = NINF;
            if ((unsigned)(base + c0 + 32) > 256u) s1[i] = NINF;
          }
        }
      }
      float mx = fmaxf(s0[0], s1[0]);
#pragma unroll
      for (int i = 1; i < 16; ++i) mx = fmaxf(mx, fmaxf(s0[i], s1[i]));
      mx = fmaxf(mx, __shfl_xor(mx, 32));
      const float mn = fmaxf(m, mx);
      const float alpha = __builtin_amdgcn_exp2f(m - mn);
      m = mn;
      float rs = 0.f;
#pragma unroll
      for (int i = 0; i < 16; ++i) {
        s0[i] = __builtin_amdgcn_exp2f(s0[i] - mn);
        s1[i] = __builtin_amdgcn_exp2f(s1[i] - mn);
        rs += s0[i] + s1[i];
      }
      rs += __shfl_xor(rs, 32);
      lsum = lsum * alpha + rs;
      if (__builtin_amdgcn_ballot_w64(alpha != 1.f) != 0ull) {
#pragma unroll
        for (int mt = 0; mt < 2; ++mt)
#pragma unroll
          for (int i = 0; i < 16; ++i) o[mt][i] *= alpha;
      }
      union { bf16x8 v; unsigned u[4]; } pf[4];
#pragma unroll
      for (int q = 0; q < 4; ++q) {
        pf[0].u[q] = pack2(s0[2 * q], s0[2 * q + 1]);
        pf[1].u[q] = pack2(s0[8 + 2 * q], s0[8 + 2 * q + 1]);
        pf[2].u[q] = pack2(s1[2 * q], s1[2 * q + 1]);
        pf[3].u[q] = pack2(s1[8 + 2 * q], s1[8 + 2 * q + 1]);
      }
#pragma unroll
      for (int mt = 0; mt < 2; ++mt)
#pragma unroll
        for (int q = 0; q < 4; ++q) {
          const bf16x8 vfr = *(const bf16x8*)(vs + mt * 4096 + kx[q]);
          o[mt] = __builtin_amdgcn_mfma_f32_32x32x16_bf16(vfr, pf[q].v, o[mt], 0, 0, 0);
        }
    }
  }
#undef A64_ISSUE
#undef A64_BAR
#undef A64_LDS
  if (has_sink) lsum += __builtin_amdgcn_exp2f(sink2 - m);
  const float inv = 1.f / lsum;
#pragma unroll
  for (int mt = 0; mt < 2; ++mt)
#pragma unroll
    for (int g = 0; g < 4; ++g) {
      uint2 r;
      r.x = pack2(o[mt][4 * g] * inv, o[mt][4 * g + 1] * inv);
      r.y = pack2(o[mt][4 * g + 2] * inv, o[mt][4 * g + 3] * inv);
      *(uint2*)(Op + (size_t)qi * DM + mt * 32 + 8 * g + 4 * hh) = r;
    }
}

DI void phase_attn(const Params& p, u16* smem, int l, int* s_item, int rep) {
  const int TIDX = tid_opaque();
  constexpr int S0 = 128;
  constexpr int D_L = 128;
  constexpr int NYQ = 32;
  constexpr int S1 = 256, S2 = 256;
  constexpr int D_C = 128;
  constexpr int S3 = 128, S4 = 64, S5 = 128;
  constexpr int TOTAL = S0 + D_L + S1 + S2 + D_C + S3 + S4 + S5 + NYQ;
  const int wid = TIDX >> 6, lane = TIDX & 63;
  float* rpb_l = (float*)smem + 24576 + wid * 512;
  int* ctr = p.ctr + l + 2 * rep;
  for (;;) {
    __syncthreads();
    if (TIDX == 0) *s_item = atomicAdd(ctr, 1);
    __syncthreads();
    int t = *s_item;
    if (t >= TOTAL) break;
    if (t >= TOTAL - NYQ) {
      const int r0 = (t - (TOTAL - NYQ)) * 64 + wid * 8;
#pragma unroll 1
      for (int rr = 0; rr < 8; ++rr) {
        const int row = r0 + rr, bg = row >> 7, lcol = row & 127, b = bg >> 2, g = bg & 3;
        const u16* z = p.ZtL + (size_t)row * 4096;
        float acc = 0.f;
#pragma unroll
        for (int i = 0; i < 4; ++i) {
          const uint4 v = *(const uint4*)(z + i * 512 + lane * 8);
          acc += bf2f((u16)(v.x & 0xffff)) - bf2f((u16)(v.x >> 16)) + bf2f((u16)(v.y & 0xffff)) - bf2f((u16)(v.y >> 16)) +
                 bf2f((u16)(v.z & 0xffff)) - bf2f((u16)(v.z >> 16)) + bf2f((u16)(v.w & 0xffff)) - bf2f((u16)(v.w >> 16));
        }
        acc = wave_sum(acc);
        if (lane == 0) p.o[(size_t)(NTC + b * 2048 + 1024) * DM + 1536 + g * 128 + lcol] = f2bf(acc * (1.f / 512.f));
      }
    } else if (t < S0) {
      const int head = (t >> 3) & 3, qt = ((t >> 5) * 8 + (t & 7)) * 8 + wid, b = qt >> 6;
      const int tok0 = NTC + qt * 32, seq0 = NTC + b * 2048;
      attn_mla_block(smem, p.Qm + (size_t)tok0 * 768 + head * 192, p.Km + head * 192, p.VmT + (size_t)head * 128 * NTA,
                     p.o + (size_t)tok0 * DM + 512 + head * 128, seq0, 32, NT + b * 512, 8);
    } else if ((t -= S0) < D_L) {
      const int tm = t & 7, bg = t >> 3, b = bg >> 2, g = bg & 3;
      float* pl = (float*)smem + 16384;
      const u16* Z = p.ZtL + (size_t)bg * 128 * 4096;
      gemm_tile(smem, p.W2048, 4096, Z, 4096, 2048, tm * 128, 0, 128, EpiLdsF32{pl, tm * 128});
      __syncthreads();
      gemm_tile(smem, p.W2048 + 2048, 4096, Z + 2048, 4096, 2048, tm * 128, 0, 128,
                EpiDftSym{pl, tm * 128, 2048, p.o + (size_t)(NTC + b * 2048) * DM + 1536 + g * 128, DM, 1.f / 512.f});
    } else if ((t -= D_L) < S1) {
      const int rg = t & 7, head = (t >> 3) & 7, b = t >> 6;
      const int r0 = rg * 4, r = r0 + (wid >> 1);
      const int seq0 = NTC + b * 2048, qpos0 = r * 64 + (wid & 1) * 32, tok0 = seq0 + qpos0;
      const float* rp = p.rpb_na + ((size_t)l * 8 + head) * 465;
      for (int e = lane; e < 465; e += 64) rpb_l[e] = rp[e] * LOG2E;
      const int lrow0 = min(max(r0 - 4, 0), 24), lrow1 = min(max(r0 + 3 - 4, 0), 24) + 8;
      const int jlo = min(max(r - 4, 0), 24) - lrow0;
      attn64_block(smem, p.Qa + (size_t)tok0 * 512 + head * 64, p.Ka + head * 64, 512, p.VaT + (size_t)head * 64 * NTA,
                   p.o + (size_t)tok0 * DM + head * 64, seq0 + lrow0 * 64, lrow1 - lrow0, NT + b * 512, 8, 1, qpos0, seq0,
                   jlo, jlo + 8, rpb_l, 0.f, false);
    } else if ((t -= S1) < S2) {
      const int kvh = (t >> 5) & 1, b = t >> 6, q0 = (t & 31) * 64;
      const int hq = kvh * 4 + (wid & 3), qpos0 = q0 + (wid >> 2) * 32;
      const int seq0 = NTC + b * 2048, tok0 = seq0 + qpos0;
      const int k0 = max(q0 - 128, 0), k1 = min(q0 + 192, 2048);
      attn64_block(smem, p.Qw + (size_t)tok0 * 512 + hq * 64, p.Kw + kvh * 64, 128, p.VwT + (size_t)kvh * 64 * NTA,
                   p.o + (size_t)tok0 * DM + 1024 + hq * 64, seq0 + k0, (k1 - k0) >> 6, NT + b * 512, 8, 2, qpos0, seq0, 0,
                   64, nullptr, p.sink_win[l * 8 + hq] * LOG2E, true);
    } else if ((t -= S2) < D_C) {
      const int tm = t & 1, bg = t >> 1, b = bg >> 2, g = bg & 3;
      gemm_tile(smem, p.W256, 512, p.ZtC + (size_t)bg * 128 * 512, 512, 512, tm * 128, 0, 128,
                EpiBf16{p.o + (size_t)(b * 256) * DM + 1536 + g * 128, DM, 0.005524271728019903f});
    } else if ((t -= D_C) < S3) {
      const int head = t & 7, b = t >> 3;
      const int seq0 = b * 256, qpos0 = wid * 32, tok0 = seq0 + qpos0;
      attn64_block(smem, p.Qa + (size_t)tok0 * 512 + head * 64, p.Ka + head * 64, 512, p.VaT + (size_t)head * 64 * NTA,
                   p.o + (size_t)tok0 * DM + head * 64, seq0, 4, 0, 0, 0, qpos0, seq0, 0, 64, nullptr, 0.f, false);
    } else if ((t -= S3) < S4) {
      const int head = t & 3, b = t >> 2, qt = b * 8 + wid;
      const int tok0 = qt * 32, seq0 = b * 256;
      attn_mla_block(smem, p.Qm + (size_t)tok0 * 768 + head * 192, p.Km + head * 192, p.VmT + (size_t)head * 128 * NTA,
                     p.o + (size_t)tok0 * DM + 512 + head * 128, seq0, 4, 0, 0);
    } else {
      t -= S4;
      const int kvh = t & 1, rest = t >> 1, b = rest >> 2, q0 = (rest & 3) * 64;
      const int hq = kvh * 4 + (wid & 3), qpos0 = q0 + (wid >> 2) * 32;
      const int seq0 = b * 256, tok0 = seq0 + qpos0;
      attn64_block(smem, p.Qw + (size_t)tok0 * 512 + hq * 64, p.Kw + kvh * 64, 128, p.VwT + (size_t)kvh * 64 * NTA,
                   p.o + (size_t)tok0 * DM + 1024 + hq * 64, seq0, 4, 0, 0, 0, qpos0, seq0, 0, 64, nullptr,
                   p.sink_win[l * 8 + hq] * LOG2E, true);
    }
  }
}

struct EpiResid {
  const float* mod_l;
  const void* res_c;
  const void* res_l;
  void* dstp;
  int res_bf, dst_bf;
  int mode;
  float* part;
  unsigned* flag;
  int brow, bcol;
  DI void begin() const {
    if (mode == 2) {
      if (threadIdx.x == 0) {
        while (__hip_atomic_load(flag, __ATOMIC_RELAXED, __HIP_MEMORY_SCOPE_AGENT) == 0u) __builtin_amdgcn_s_sleep(1);
        __builtin_amdgcn_fence(__ATOMIC_ACQUIRE, "agent");
        asm volatile("s_waitcnt vmcnt(0)" ::: "memory");
      }
      __syncthreads();
    }
  }
  DI void end() const {
    if (mode == 1) {
      asm volatile("s_waitcnt vmcnt(0)" ::: "memory");
      __syncthreads();
      if (threadIdx.x == 0) {
        __builtin_amdgcn_fence(__ATOMIC_RELEASE, "agent");
        asm volatile("s_waitcnt vmcnt(0)" ::: "memory");
        __hip_atomic_store(flag, 1u, __ATOMIC_RELAXED, __HIP_MEMORY_SCOPE_AGENT);
      }
    }
  }
  struct Pre { float4 g, x; f32x4 pv; };
  DI Pre load(int m, int n) const {
    Pre q;
    q.pv = (f32x4){0.f, 0.f, 0.f, 0.f};
    if (mode == 1) { q.g = make_float4(0.f, 0.f, 0.f, 0.f); q.x = q.g; return q; }
    if (mode == 2) q.pv = *(const f32x4*)(part + (size_t)(m - brow) * 256 + (n - bcol));
    q.g = *(const float4*)(mod_l + (size_t)mod_index(m) * (6 * DM) + n);
    if (res_bf) {
      const u16* xr = m < NTC ? (const u16*)res_c + (size_t)m * DM : (const u16*)res_l + (size_t)(m - NTC) * DM;
      const uint2 r = *(const uint2*)(xr + n);
      q.x = make_float4(bf2f((u16)(r.x & 0xffff)), bf2f((u16)(r.x >> 16)), bf2f((u16)(r.y & 0xffff)), bf2f((u16)(r.y >> 16)));
    } else {
      const float* xr = m < NTC ? (const float*)res_c + (size_t)m * DM : (const float*)res_l + (size_t)(m - NTC) * DM;
      q.x = *(const float4*)(xr + n);
    }
    return q;
  }
  DI void store(int m, int n, f32x4 v, const Pre& q) const {
    if (mode == 1) {
      *(f32x4*)(part + (size_t)(m - brow) * 256 + (n - bcol)) = v;
      return;
    }
    v += q.pv;
    float4 r;
    r.x = q.x.x + q.g.x * v[0]; r.y = q.x.y + q.g.y * v[1]; r.z = q.x.z + q.g.z * v[2]; r.w = q.x.w + q.g.w * v[3];
    if (dst_bf) {
      uint2 o;
      o.x = pack2(r.x, r.y);
      o.y = pack2(r.z, r.w);
      *(uint2*)((u16*)dstp + (size_t)m * DM + n) = o;
    } else {
      *(float4*)((float*)dstp + (size_t)m * DM + n) = r;
    }
  }
};
DI void gemm_n2048(const Params& p, u16* smem, const u16* A, const u16* W, int K, EpiResid epi, unsigned* flags) {
#pragma unroll 1
  for (int it = blockIdx.x; it < 256; it += gridDim.x) {
    __syncthreads();
    int pm, pn;
    tile256_decode(it, 48, 8, pm, pn);
    gemm256_tile<false>(smem, A, W, K, K, pm * 256, pn * 256, epi);
  }
#pragma unroll 1
  for (int it = blockIdx.x; it < 256; it += gridDim.x) {
    __syncthreads();
    int pm, pn;
    tile256_decode(256 + (it >> 1), 48, 8, pm, pn);
    gemm256_tile<true>(smem, A, W, K, K, pm * 256, pn * 256 + (it & 1) * 128, epi);
  }
}
DI void phase_outproj(const Params& p, u16* smem, int l) {
  const EpiResid epi{p.mod + (size_t)l * 5 * 6 * DM + 2 * DM,
                     l == 0 ? (const void*)p.x_prompt : (const void*)p.x2b,
                     l == 0 ? (const void*)p.x_sample : (const void*)(p.x2b + (size_t)NTC * DM),
                     (void*)p.x1b, l == 0 ? 0 : 1, 1, 0, nullptr, nullptr, 0, 0};
  gemm_n2048(p, smem, p.o, p.WoutT + (size_t)l * DM * DM, DM, epi, p.flags + (l * 2 + 0) * 128);
}
DI void phase_gate(const Params& p, u16* smem, int l) {
  const u16* W = p.WgateT + (size_t)l * DFF * DM;
#pragma unroll 1
  for (int it = blockIdx.x; it < 256; it += gridDim.x) {
    __syncthreads();
    int pm, pn;
    tile256_decode(1024 + (it >> 3), 48, 22, pm, pn);
    const int n0p = pn * 256 + ((it >> 1) & 3) * 64;
    gemm_tile<1>(smem, p.h, DM, W, DM, DM, pm * 256 + (it & 1) * 128, n0p, n0p + 64, EpiBf16{p.g, DFF, 1.f});
  }
#pragma unroll 1
  for (int it = blockIdx.x; it < 1024; it += gridDim.x) {
    __syncthreads();
    int pm, pn;
    tile256_decode(it, 48, 22, pm, pn);
    gemm256_tile(smem, p.h, W, DM, DM, pm * 256, pn * 256, EpiBf16{p.g, DFF, 1.f});
  }
}
struct EpiUp {
  const float* wconv;
  const u16* gbuf;
  u16* abuf;
  struct Pre { uint2 c0, c1, c2; float4 w0, w1, w2; };
  DI void begin() const {}
  DI void end() const {}
  DI Pre load(int m, int n) const {
    Pre q;
    const float* wc = wconv + n;
    q.w0 = *(const float4*)wc; q.w1 = *(const float4*)(wc + DFF); q.w2 = *(const float4*)(wc + 2 * DFF);
    const int pos = m < NTC ? (m & 255) : ((m - NTC) & 2047);
    const int last = m < NTC ? 255 : 2047;
    const u16* gp = gbuf + (size_t)m * DFF + n;
    q.c1 = *(const uint2*)gp;
    q.c0 = make_uint2(0u, 0u);
    q.c2 = make_uint2(0u, 0u);
    if (pos > 0) q.c0 = *(const uint2*)(gp - DFF);
    if (pos < last) q.c2 = *(const uint2*)(gp + DFF);
    return q;
  }
  DI void store(int m, int n, f32x4 v, const Pre& q) const {
    float gg[4];
    gg[0] = bf2f((u16)(q.c0.x & 0xffff)) * q.w0.x + bf2f((u16)(q.c1.x & 0xffff)) * q.w1.x + bf2f((u16)(q.c2.x & 0xffff)) * q.w2.x;
    gg[1] = bf2f((u16)(q.c0.x >> 16)) * q.w0.y + bf2f((u16)(q.c1.x >> 16)) * q.w1.y + bf2f((u16)(q.c2.x >> 16)) * q.w2.y;
    gg[2] = bf2f((u16)(q.c0.y & 0xffff)) * q.w0.z + bf2f((u16)(q.c1.y & 0xffff)) * q.w1.z + bf2f((u16)(q.c2.y & 0xffff)) * q.w2.z;
    gg[3] = bf2f((u16)(q.c0.y >> 16)) * q.w0.w + bf2f((u16)(q.c1.y >> 16)) * q.w1.w + bf2f((u16)(q.c2.y >> 16)) * q.w2.w;
    float r[4];
#pragma unroll
    for (int i = 0; i < 4; ++i) r[i] = gg[i] / (1.f + __expf(-gg[i])) * v[i];
    uint2 o;
    o.x = pack2(r[0], r[1]);
    o.y = pack2(r[2], r[3]);
    *(uint2*)(abuf + (size_t)m * DFF + n) = o;
  }
};
DI void phase_up_ffn(const Params& p, u16* smem, int l) {
  const u16* W = p.WupT + (size_t)l * DFF * DM;
#pragma unroll 1
  for (int it = blockIdx.x; it < 256; it += gridDim.x) {
    __syncthreads();
    int pm, pn;
    tile256_decode(1024 + (it >> 3), 48, 22, pm, pn);
    const int n0p = pn * 256 + ((it >> 1) & 3) * 64;
    gemm_tile<1>(smem, p.h, DM, W, DM, DM, pm * 256 + (it & 1) * 128, n0p, n0p + 64, EpiUp{p.w_conv + (size_t)l * 3 * DFF, p.g, p.a});
  }
#pragma unroll 1
  for (int it = blockIdx.x; it < 1024; it += gridDim.x) {
    __syncthreads();
    int pm, pn;
    tile256_decode(it, 48, 22, pm, pn);
    gemm256_tile(smem, p.h, W, DM, DM, pm * 256, pn * 256, EpiUp{p.w_conv + (size_t)l * 3 * DFF, p.g, p.a});
  }
}
DI void phase_down(const Params& p, u16* smem, int l) {
  const EpiResid epi{p.mod + (size_t)l * 5 * 6 * DM + 5 * DM, (const void*)p.x1b, (const void*)(p.x1b + (size_t)NTC * DM),
                     l == 0 ? (void*)p.x2b : (void*)p.out, 1, l == 0 ? 1 : 0, 0, nullptr, nullptr, 0, 0};
  gemm_n2048(p, smem, p.a, p.WdownT + (size_t)l * DM * DFF, DFF, epi, p.flags + (l * 2 + 1) * 128);
}

constexpr int N_PHASES = 1 + 2 * 11;
DI void run_phase(const Params& p, u16* smem, int* s_item, int ph, int rep) {
#ifdef ONLY
  if (ONLY == 11) { phase_prep(p, smem); return; }
  const int l = ph & 1, s = ONLY;
#else
  if (ph == 0) { phase_prep(p, smem); return; }
  const int l = (ph - 1) / 11, s = (ph - 1) % 11;
#endif
  switch (s) {
    case 0: phase_modulate(p, l, 0); break;
    case 1: phase_qkv(p, smem, l); break;
    case 2: phase_post1(p, smem, l); break;
    case 3: phase_up(p, smem, l); break;
    case 4: phase_post2(p, l); break;
    case 5: phase_attn(p, smem, l, s_item, rep); break;
    case 6: phase_outproj(p, smem, l); break;
    case 7: phase_modulate(p, l, 1); break;
    case 8: phase_gate(p, smem, l); break;
    case 9: phase_up_ffn(p, smem, l); break;
    default: phase_down(p, smem, l); break;
  }
}

#if MEGA
DI void grid_bar(unsigned* bw, unsigned gen, lds_uint* s_nloc_p) {
  asm volatile("s_waitcnt vmcnt(0)" ::: "memory");
  __syncthreads();
  if (threadIdx.x == 0) {
    const unsigned xc = (unsigned)__builtin_amdgcn_s_getreg((3 << 11) | 20) & 0xFu;
    const unsigned nloc = *(volatile lds_uint*)s_nloc_p;
    const unsigned old = __hip_atomic_fetch_add(bw + 64 + 64 * xc, 1u, __ATOMIC_RELAXED, __HIP_MEMORY_SCOPE_AGENT);
    if (old + 1u == gen * nloc) {
      __builtin_amdgcn_fence(__ATOMIC_RELEASE, "agent");
      asm volatile("s_waitcnt vmcnt(0)" ::: "memory");
      __hip_atomic_fetch_add(bw, nloc, __ATOMIC_RELAXED, __HIP_MEMORY_SCOPE_AGENT);
    }
    const unsigned target = gen * gridDim.x;
    while (__hip_atomic_load(bw, __ATOMIC_RELAXED, __HIP_MEMORY_SCOPE_AGENT) < target) __builtin_amdgcn_s_sleep(1);
    __builtin_amdgcn_fence(__ATOMIC_ACQUIRE, "agent");
    asm volatile("s_waitcnt vmcnt(0)" ::: "memory");
  }
  __syncthreads();
}

__global__ void __launch_bounds__(NTHR) mega_kernel(Params p) {
  __shared__ __attribute__((aligned(16))) u16 smem[65536];
  __shared__ int s_item;
  cg::grid_group grid = cg::this_grid();
  unsigned* bar = p.barw;
  __shared__ unsigned s_nloc;
  if (threadIdx.x == 0) {
    const unsigned xc = (unsigned)__builtin_amdgcn_s_getreg((3 << 11) | 20) & 0xFu;
    __hip_atomic_fetch_add(bar + 1536 + 16 * xc, 1u, __ATOMIC_RELAXED, __HIP_MEMORY_SCOPE_AGENT);
  }
  unsigned nbar = 0;
#pragma unroll 1
  for (int ph = 0; ph < N_PHASES; ++ph) {
    run_phase(p, smem, &s_item, ph, 0);
#ifdef DUP_MASK
    {
      const int ty = ph == 0 ? 11 : (ph - 1) % 11;
      if ((DUP_MASK >> ty) & 1) { ++nbar; grid_bar(bar, nbar, (lds_uint*)&s_nloc); run_phase(p, smem, &s_item, ph, 1); }
    }
#endif
    if (ph == 0) {
      grid.sync();
      if (threadIdx.x == 0) {
        const unsigned xc = (unsigned)__builtin_amdgcn_s_getreg((3 << 11) | 20) & 0xFu;
        s_nloc = __hip_atomic_load(bar + 1536 + 16 * xc, __ATOMIC_RELAXED, __HIP_MEMORY_SCOPE_AGENT);
      }
      __syncthreads();
    } else if (ph + 1 < N_PHASES) { ++nbar; grid_bar(bar, nbar, (lds_uint*)&s_nloc); }
  }
}
#else
__global__ void __launch_bounds__(NTHR) phase_kernel(Params p, int ph) {
  __shared__ __attribute__((aligned(16))) u16 smem[65536];
  __shared__ int s_item;
  run_phase(p, smem, &s_item, ph, 0);
}
#endif

extern "C" void kernel_launch(void* const* d_in, const int* in_sizes, int n_in, void* d_out, int out_size, void* d_ws,
                              size_t ws_size, hipStream_t stream) {
  Params p{};
  const float** pi = (const float**)&p;
  for (int i = 0; i < 32; ++i) pi[i] = (const float*)d_in[i];
  p.out = (float*)d_out;
  char* w = (char*)d_ws;
  size_t off = 0;
  auto take = [&](size_t bytes) { char* r = w + off; off += (bytes + 255) & ~(size_t)255; return r; };
  p.WinT = (u16*)take((size_t)2 * RLD * DM * 2);
  p.WqupT = (u16*)take((size_t)2 * 768 * 384 * 2);
  p.WkvupT = (u16*)take((size_t)2 * 1024 * 128 * 2);
  p.WoutT = (u16*)take((size_t)2 * DM * DM * 2);
  p.WgateT = (u16*)take((size_t)2 * DFF * DM * 2);
  p.WupT = (u16*)take((size_t)2 * DFF * DM * 2);
  p.WdownT = (u16*)take((size_t)2 * DM * DFF * 2);
  p.trig128 = (u16*)take(256 * 128 * 2);
  p.W256 = (u16*)take(256 * 512 * 2);
  p.W2048 = (u16*)take((size_t)2048 * 4096 * 2);
  p.mod = (float*)take((size_t)2 * 5 * 6 * DM * 4);
  p.ctr = (int*)take(256);
  p.flags = (unsigned*)take(512 * 4);
  p.barw = (unsigned*)take(2048 * 4);
  p.x1b = (u16*)take((size_t)NT * DM * 2);
  p.x2b = (u16*)take((size_t)NT * DM * 2);
  p.h = (u16*)take((size_t)NT * DM * 2);
  const size_t att0 = off;
  p.raw = (u16*)take((size_t)NT * RLD * 2);
  p.Qa = (u16*)take((size_t)NT * 512 * 2);
  p.Ka = (u16*)take((size_t)NTA * 512 * 2);
  p.VaT = (u16*)take((size_t)512 * NTA * 2);
  p.Qw = (u16*)take((size_t)NT * 512 * 2);
  p.Kw = (u16*)take((size_t)NTA * 128 * 2);
  p.VwT = (u16*)take((size_t)128 * NTA * 2);
  p.cq = (u16*)take((size_t)NT * 384 * 2);
  p.ckv = (u16*)take((size_t)NTA * 128 * 2);
  p.krope = (u16*)take((size_t)NTA * 64 * 2);
  p.qmraw = (u16*)take((size_t)NT * 768 * 2);
  p.kvraw = (u16*)take((size_t)NTA * 1024 * 2);
  p.Qm = (u16*)take((size_t)NT * 768 * 2);
  p.Km = (u16*)take((size_t)NTA * 768 * 2);
  p.VmT = (u16*)take((size_t)512 * NTA * 2);
  p.ZtC = (u16*)take((size_t)64 * 128 * 512 * 2);
  p.ZtL = (u16*)take((size_t)16 * 128 * 4096 * 2);
  p.o = (u16*)take((size_t)NT * DM * 2);
  const size_t att1 = off;
  off = att0;
  p.g = (u16*)take((size_t)NT * DFF * 2);
  p.a = (u16*)take((size_t)NT * DFF * 2);
  if (off < att1) off = att1;
  p.part = (float*)take((size_t)128 * 65536 * 4);
  if (off > ws_size) fprintf(stderr, "workspace too small: need %zu have %zu\n", off, ws_size);

#if MEGA
  (void)hipMemsetAsync(p.barw, 0, 2048 * 4, stream);
  static int grid_blocks = 0;
  if (!grid_blocks) {
    int dev = 0, cus = 0, per_cu = 0;
    hipGetDevice(&dev);
    hipDeviceGetAttribute(&cus, hipDeviceAttributeMultiprocessorCount, dev);
    (void)hipOccupancyMaxActiveBlocksPerMultiprocessor(&per_cu, mega_kernel, NTHR, 0);
    grid_blocks = cus * per_cu;
  }
  void* args[] = {&p};
  hipError_t e = hipLaunchCooperativeKernel((void*)mega_kernel, dim3(grid_blocks), dim3(NTHR), args, 0, stream);
  if (e != hipSuccess) fprintf(stderr, "cooperative launch failed: %s (grid %d)\n", hipGetErrorString(e), grid_blocks);
#else
  for (int ph = 0; ph < N_PHASES; ++ph) phase_kernel<<<dim3(256), dim3(NTHR), 0, stream>>>(p, ph);
#endif
}
```
